# Optimizing an MI355X kernel written in HIP

```python
import math
import jax, jax.numpy as jnp
from jax import lax
import numpy as np

D_MODEL = 1024
BATCH = 16
SEQ = 256
DEPTH = 4
DEC_BATCH = 4
DEC_SEQ = 1024
PAST_LEN = 256

GRID_W = 64
N_MIXERS = 2
MIX_WIDTH = D_MODEL
DA_HEADS = 8
DA_DH = 64
DA_DV = 2 * DA_DH
DA_IN = 2 * DA_HEADS * 2 * DA_DH + DA_HEADS * DA_DV + MIX_WIDTH
MLA_HEADS = 8
MLA_Q_LORA = 384
MLA_KV_LORA = 256
MLA_NOPE = 128
MLA_ROPE = 64
MLA_DV = 128
MLA_IN = MLA_Q_LORA + MLA_KV_LORA + MLA_ROPE + MIX_WIDTH
ROPE_THETA = 10000.0
NORM_EPS = 1e-6
Q_BLOCK = 128

kernel_name = 'diffmla_prefix_diffusion_step'

F32 = jnp.float32


def rmsnorm(x, g):
    xf = x.astype(F32)
    y = xf * lax.rsqrt(jnp.mean(xf * xf, axis=-1, keepdims=True) + NORM_EPS)
    return (y * g.astype(F32)).astype(x.dtype)


def axial_rope(n_tokens, dim):
    rows = n_tokens // GRID_W
    row = jnp.repeat(jnp.arange(rows), GRID_W).astype(F32)
    col = jnp.tile(jnp.arange(GRID_W), rows).astype(F32)
    n_freq = dim // 4
    inv = ROPE_THETA ** (-jnp.arange(n_freq, dtype=F32) / n_freq)
    ang = jnp.concatenate([row[:, None] * inv, col[:, None] * inv], axis=-1)
    return jnp.cos(ang), jnp.sin(ang)


def apply_rope(x, cos, sin):
    shape = (cos.shape[0],) + (1,) * (x.ndim - 3) + (cos.shape[-1],)
    cos = cos.reshape(shape)
    sin = sin.reshape(shape)
    xf = x.astype(F32)
    half = x.shape[-1] // 2
    x1, x2 = xf[..., :half], xf[..., half:]
    out = jnp.concatenate([x1 * cos - x2 * sin, x1 * sin + x2 * cos], axis=-1)
    return out.astype(x.dtype)


def ada_mod(cond, w, b):
    m = jax.nn.silu(cond) @ w + b
    if m.ndim == 2:
        m = m[:, None, :]
    shift, scale, gate = jnp.split(m, 3, axis=-1)
    return shift, scale, gate


def map_query_blocks(fn, q):
    b, s = q.shape[0], q.shape[1]
    if s % Q_BLOCK != 0 or s <= Q_BLOCK:
        return fn(q)
    nb = s // Q_BLOCK
    qb = jnp.swapaxes(q.reshape((b, nb, Q_BLOCK) + q.shape[2:]), 0, 1)
    out = jnp.swapaxes(lax.map(fn, qb), 0, 1)
    return out.reshape((b, s) + out.shape[3:])


def diff_project(h, w_in):
    b, s = h.shape[:2]
    proj = h @ w_in
    nq = DA_HEADS * 2 * DA_DH
    q, k, v, gate = jnp.split(proj, [nq, 2 * nq, 2 * nq + DA_HEADS * DA_DV], axis=-1)
    q = q.reshape(b, s, DA_HEADS, 2, DA_DH)
    k = k.reshape(b, s, DA_HEADS, 2, DA_DH)
    v = v.reshape(b, s, DA_HEADS, DA_DV)
    return q, k, v, gate


def diff_attend(q, k, v, gate, lam, lam_init, g_sub):
    scale = DA_DH ** -0.5

    def block(qb):
        s = jnp.einsum('bqhcd,bkhcd->bhcqk', qb, k, preferred_element_type=F32) * scale
        p = jax.nn.softmax(s, axis=-1)
        w = p[:, :, 0] - lam * p[:, :, 1]
        return jnp.einsum('bhqk,bkhe->bqhe', w.astype(v.dtype), v)

    o = map_query_blocks(block, q)
    o = rmsnorm(o, g_sub) * (1.0 - lam_init)
    b, sq = o.shape[:2]
    return o.reshape(b, sq, MIX_WIDTH) * jax.nn.silu(gate)


def mla_project(h, w_in, g_qa, w_qb, g_kva):
    b, s = h.shape[:2]
    proj = h @ w_in
    q_a, kv_a, k_pe, gate = jnp.split(
        proj, [MLA_Q_LORA, MLA_Q_LORA + MLA_KV_LORA, MLA_Q_LORA + MLA_KV_LORA + MLA_ROPE], axis=-1)
    q = (rmsnorm(q_a, g_qa) @ w_qb).reshape(b, s, MLA_HEADS, MLA_NOPE + MLA_ROPE)
    c_kv = rmsnorm(kv_a, g_kva)
    return q, c_kv, k_pe, gate


def mla_rope(q, k_pe, cos, sin):
    q_pe = apply_rope(q[..., MLA_NOPE:], cos, sin)
    q = jnp.concatenate([q[..., :MLA_NOPE], q_pe], axis=-1)
    return q, apply_rope(k_pe, cos, sin)


def mla_attend(q, c_kv, k_pe, gate, w_kvb):
    b, sk = c_kv.shape[:2]
    kv = (c_kv @ w_kvb).reshape(b, sk, MLA_HEADS, MLA_NOPE + MLA_DV)
    k_nope, v = kv[..., :MLA_NOPE], kv[..., MLA_NOPE:]
    k = jnp.concatenate(
        [k_nope, jnp.broadcast_to(k_pe[:, :, None, :], (b, sk, MLA_HEADS, MLA_ROPE))], axis=-1)
    scale = (MLA_NOPE + MLA_ROPE) ** -0.5

    def block(qb):
        s = jnp.einsum('bqhd,bkhd->bhqk', qb, k, preferred_element_type=F32) * scale
        p = jax.nn.softmax(s, axis=-1)
        return jnp.einsum('bhqk,bkhe->bqhe', p.astype(v.dtype), v)

    o = map_query_blocks(block, q)
    sq = o.shape[1]
    return o.reshape(b, sq, MIX_WIDTH) * jax.nn.silu(gate)


def setup_inputs(seed: int = 0) -> dict:
    key = jax.random.key(seed)
    ks = iter(jax.random.split(key, 32))
    n_diff = (DEPTH + 1) // 2
    n_mla = DEPTH // 2

    def nrm(shape, scale=1.0):
        return jax.random.normal(next(ks), shape, F32) * scale

    def gain(shape):
        return 1.0 + nrm(shape, 0.05)

    return {
        'x_prompt': nrm((BATCH, SEQ, D_MODEL)),
        'x_sample': nrm((DEC_BATCH, DEC_SEQ, D_MODEL)),
        'cache_diff_k': nrm((DEC_BATCH, n_diff, PAST_LEN, DA_HEADS, 2, DA_DH)),
        'cache_diff_v': nrm((DEC_BATCH, n_diff, PAST_LEN, DA_HEADS, DA_DV)),
        'cache_mla_ckv': nrm((DEC_BATCH, n_mla, PAST_LEN, MLA_KV_LORA)),
        'cache_mla_kpe': nrm((DEC_BATCH, n_mla, PAST_LEN, MLA_ROPE)),
        'c': nrm((DEC_BATCH, D_MODEL)),
        'c_ctx': nrm((D_MODEL,)),
        'w_ada': nrm((DEPTH, D_MODEL, 3 * D_MODEL), 0.5 * D_MODEL ** -0.5),
        'b_ada': nrm((DEPTH, 3 * D_MODEL), 0.01),
        'g_pre': gain((DEPTH, D_MODEL)),
        'g_post': gain((DEPTH, D_MODEL)),
        'w_out': nrm((DEPTH, MIX_WIDTH, D_MODEL), MIX_WIDTH ** -0.5),
        'da_w_in': nrm((n_diff, D_MODEL, DA_IN), D_MODEL ** -0.5),
        'da_lam_q1': nrm((n_diff, DA_DH), 0.1),
        'da_lam_k1': nrm((n_diff, DA_DH), 0.1),
        'da_lam_q2': nrm((n_diff, DA_DH), 0.1),
        'da_lam_k2': nrm((n_diff, DA_DH), 0.1),
        'da_g_sub': gain((n_diff, DA_DV)),
        'mla_w_in': nrm((n_mla, D_MODEL, MLA_IN), D_MODEL ** -0.5),
        'mla_g_qa': gain((n_mla, MLA_Q_LORA)),
        'mla_w_qb': nrm((n_mla, MLA_Q_LORA, MLA_HEADS * (MLA_NOPE + MLA_ROPE)), MLA_Q_LORA ** -0.5),
        'mla_g_kva': gain((n_mla, MLA_KV_LORA)),
        'mla_w_kvb': nrm((n_mla, MLA_KV_LORA, MLA_HEADS * (MLA_NOPE + MLA_DV)), MLA_KV_LORA ** -0.5),
    }


def reference(x_prompt, x_sample, cache_diff_k, cache_diff_v, cache_mla_ckv, cache_mla_kpe,
              c, c_ctx, w_ada, b_ada, g_pre, g_post, w_out,
              da_w_in, da_lam_q1, da_lam_k1, da_lam_q2, da_lam_k2, da_g_sub,
              mla_w_in, mla_g_qa, mla_w_qb, mla_g_kva, mla_w_kvb):
    x_ctx = x_prompt
    x_lat = x_sample
    s_lat = x_lat.shape[1]
    rope_da = axial_rope(s_lat, DA_DH)
    rope_mla = axial_rope(s_lat, MLA_ROPE)
    st_dk, st_dv, st_ckv, st_kpe = [], [], [], []

    for i in range(DEPTH):
        j = i // N_MIXERS
        kind = i % N_MIXERS
        sh_c, sc_c, gt_c = ada_mod(c_ctx, w_ada[i], b_ada[i])
        sh_l, sc_l, gt_l = ada_mod(c, w_ada[i], b_ada[i])
        hc = rmsnorm(x_ctx, g_pre[i]) * (1.0 + sc_c) + sh_c
        hl = rmsnorm(x_lat, g_pre[i]) * (1.0 + sc_l) + sh_l

        if kind == 0:
            lam_init = 0.8 - 0.6 * math.exp(-0.3 * i)
            lam = (jnp.exp(jnp.sum(da_lam_q1[j].astype(F32) * da_lam_k1[j].astype(F32)))
                   - jnp.exp(jnp.sum(da_lam_q2[j].astype(F32) * da_lam_k2[j].astype(F32)))
                   + lam_init)
            qc, kc, vc, gc = diff_project(hc, da_w_in[j])
            st_dk.append(kc)
            st_dv.append(vc)
            oc = diff_attend(qc, kc, vc, gc, lam, lam_init, da_g_sub[j])
            ql, kl, vl, gl = diff_project(hl, da_w_in[j])
            ql = apply_rope(ql, *rope_da)
            kl = apply_rope(kl, *rope_da)
            kl = jnp.concatenate([kl, cache_diff_k[:, j]], axis=1)
            vl = jnp.concatenate([vl, cache_diff_v[:, j]], axis=1)
            ol = diff_attend(ql, kl, vl, gl, lam, lam_init, da_g_sub[j])
        else:
            qc, ckv_c, kpe_c, gc = mla_project(hc, mla_w_in[j], mla_g_qa[j], mla_w_qb[j], mla_g_kva[j])
            st_ckv.append(ckv_c)
            st_kpe.append(kpe_c)
            oc = mla_attend(qc, ckv_c, kpe_c, gc, mla_w_kvb[j])
            ql, ckv_l, kpe_l, gl = mla_project(hl, mla_w_in[j], mla_g_qa[j], mla_w_qb[j], mla_g_kva[j])
            ql, kpe_l = mla_rope(ql, kpe_l, *rope_mla)
            ckv_all = jnp.concatenate([ckv_l, cache_mla_ckv[:, j]], axis=1)
            kpe_all = jnp.concatenate([kpe_l, cache_mla_kpe[:, j]], axis=1)
            ol = mla_attend(ql, ckv_all, kpe_all, gl, mla_w_kvb[j])

        x_ctx = x_ctx + gt_c * rmsnorm(oc @ w_out[i], g_post[i])
        x_lat = x_lat + gt_l * rmsnorm(ol @ w_out[i], g_post[i])

    state_diff_k = jnp.stack(st_dk, axis=1)
    state_diff_v = jnp.stack(st_dv, axis=1)
    state_mla_ckv = jnp.stack(st_ckv, axis=1)
    state_mla_kpe = jnp.stack(st_kpe, axis=1)
    return (x_ctx, x_lat, state_diff_k, state_diff_v, state_mla_ckv, state_mla_kpe)
```

```cpp
#include <hip/hip_runtime.h>
#include <hip/hip_cooperative_groups.h>
#include <cstdio>
namespace cg = cooperative_groups;

#ifndef MULTI_LAUNCH
#define MULTI_LAUNCH 0
#endif

typedef unsigned short u16;
typedef __attribute__((ext_vector_type(8))) short bf16x8;
typedef __attribute__((ext_vector_type(4))) float f32x4;
typedef __attribute__((ext_vector_type(4))) unsigned u32x4;
typedef __attribute__((ext_vector_type(2))) unsigned u32x2;

#define DEVI __device__ __forceinline__

struct Params {
  const float* in[24];
  float* out;
  unsigned char* ws;
  int ph_lo, ph_hi;
};

constexpr size_t MBy = 1u << 20;
constexpr size_t WS_WOUT = 0;
constexpr size_t WS_WDAIN = 8 * MBy;
constexpr size_t WS_WMLAIN = 24 * MBy;
constexpr size_t WS_WQB = 31 * MBy;
constexpr size_t WS_WKVB = 34 * MBy;
constexpr size_t WS_WKVBG = 36 * MBy;
constexpr size_t WS_ADA = 38 * MBy;
constexpr size_t WS_ROPE = 39 * MBy;
constexpr size_t WS_MISC = 40 * MBy;
constexpr size_t WS_H = 41 * MBy;
constexpr size_t WS_O = WS_H;
constexpr size_t WS_Q = 57 * MBy;
constexpr size_t WS_T = WS_Q;
constexpr size_t WS_CTXK = 81 * MBy;
constexpr size_t WS_KDLAT = 93 * MBy;
constexpr size_t WS_VTCTX = 113 * MBy;
constexpr size_t WS_VTLATD = 121 * MBy;
constexpr size_t WS_VTLATM = 141 * MBy;
constexpr size_t WS_G = 151 * MBy;
constexpr size_t WS_QA = 167 * MBy;
constexpr size_t WS_CKVA = 173 * MBy;
constexpr size_t WS_SSQQ = 183 * MBy;
constexpr size_t WS_SSQKV = 184 * MBy;
constexpr size_t WS_KMLAT = 185 * MBy;
constexpr size_t KDLAT_J = (size_t)4 * 1280 * 1024;
constexpr size_t VTLATD_J = (size_t)4 * 8 * 128 * 1280;
constexpr size_t CKVA_J = (size_t)9216 * 256;
constexpr size_t KMLAT_J = (size_t)4 * 8 * 1280 * 192;

constexpr size_t OUT_Y = 0;
constexpr size_t OUT_SK = 8388608;
constexpr size_t OUT_SV = 16777216;
constexpr size_t OUT_CKV = 25165824;
constexpr size_t OUT_KPE = 27262976;

constexpr float EPS = 1e-6f;
constexpr float LOG2E = 1.4426950408889634f;

enum { I_XP = 0, I_XS, I_CDK, I_CDV, I_CCKV, I_CKPE, I_C, I_CCTX, I_WADA, I_BADA, I_GPRE, I_GPOST, I_WOUT,
       I_DAWIN, I_LQ1, I_LK1, I_LQ2, I_LK2, I_GSUB, I_MWIN, I_GQA, I_WQB, I_GKVA, I_WKVB };

DEVI int tidx() { int t = threadIdx.x; asm volatile("" : "+v"(t)); return t; }
DEVI u16 f2bf(float f) {
  unsigned u = __float_as_uint(f);
  u += 0x7fffu + ((u >> 16) & 1u);
  return (u16)(u >> 16);
}
DEVI unsigned pk2(float a, float b) { return (unsigned)f2bf(a) | ((unsigned)f2bf(b) << 16); }
DEVI float bf2f(unsigned v) { return __uint_as_float(v << 16); }
DEVI void st_bf4(u16* p, f32x4 v) {
  uint2 u; u.x = pk2(v[0], v[1]); u.y = pk2(v[2], v[3]);
  *(uint2*)p = u;
}
DEVI void st_f4(float* p, f32x4 v) { *(float4*)p = make_float4(v[0], v[1], v[2], v[3]); }
DEVI f32x4 mfma16(bf16x8 a, bf16x8 b, f32x4 c) { return __builtin_amdgcn_mfma_f32_16x16x32_bf16(a, b, c, 0, 0, 0); }
DEVI float silu(float x) { return x / (1.f + __expf(-x)); }
DEVI float xshfl(float v, int m) { return __shfl_xor(v, m, 64); }

DEVI void rope4(f32x4& x1, f32x4& x2, const float* cs, const float* sn) {
  float4 c = *(const float4*)cs; float4 s = *(const float4*)sn;
  f32x4 a = x1, b = x2;
  x1[0] = a[0] * c.x - b[0] * s.x; x2[0] = a[0] * s.x + b[0] * c.x;
  x1[1] = a[1] * c.y - b[1] * s.y; x2[1] = a[1] * s.y + b[1] * c.y;
  x1[2] = a[2] * c.z - b[2] * s.z; x2[2] = a[2] * s.z + b[2] * c.z;
  x1[3] = a[3] * c.w - b[3] * s.w; x2[3] = a[3] * s.w + b[3] * c.w;
}

constexpr int LDT = 72;
constexpr int TILE_ELEMS = 128 * LDT;
constexpr int SMEM_BYTES = 4 * TILE_ELEMS * 2;

template <bool SWAP>
DEVI void gemm_core(const u16* __restrict__ A, int lda, const u16* __restrict__ B, int ldb, int K,
                    int m0, int n0, u16* smem, f32x4 (&acc)[4][4]) {
  const int tid = tidx(), lane = tid & 63, w = tid >> 6;
  const int wm = w >> 1, wn = w & 1;
  const int g = lane >> 4, li = lane & 15;
  u16* As = smem;
  u16* Bs = smem + 2 * TILE_ELEMS;
  const int lr = tid >> 3, lc = (tid & 7) * 8;
  const u16* ap = A + (size_t)(m0 + lr) * lda + lc;
  const u16* bp = B + (size_t)(n0 + lr) * ldb + lc;
  u32x4 ra[4], rb[4];
#pragma unroll
  for (int i = 0; i < 4; ++i) {
    ra[i] = *(const u32x4*)(ap + (size_t)i * 32 * lda);
    rb[i] = *(const u32x4*)(bp + (size_t)i * 32 * ldb);
  }
  __syncthreads();
#pragma unroll
  for (int i = 0; i < 4; ++i) {
    *(u32x4*)(As + (lr + 32 * i) * LDT + lc) = ra[i];
    *(u32x4*)(Bs + (lr + 32 * i) * LDT + lc) = rb[i];
  }
  __syncthreads();
  const int KT = K >> 6;
  for (int kt = 0; kt < KT; ++kt) {
    const int buf = kt & 1;
    if (kt + 1 < KT) {
      const int k0 = (kt + 1) << 6;
#pragma unroll
      for (int i = 0; i < 4; ++i) {
        ra[i] = *(const u32x4*)(ap + (size_t)i * 32 * lda + k0);
        rb[i] = *(const u32x4*)(bp + (size_t)i * 32 * ldb + k0);
      }
    }
    const u16* Ab = As + buf * TILE_ELEMS + (wm * 64 + li) * LDT + g * 8;
    const u16* Bb = Bs + buf * TILE_ELEMS + (wn * 64 + li) * LDT + g * 8;
#pragma unroll
    for (int ks = 0; ks < 2; ++ks) {
      bf16x8 a[4], b[4];
#pragma unroll
      for (int t = 0; t < 4; ++t) {
        a[t] = *(const bf16x8*)(Ab + t * 16 * LDT + ks * 32);
        b[t] = *(const bf16x8*)(Bb + t * 16 * LDT + ks * 32);
      }
#pragma unroll
      for (int mt = 0; mt < 4; ++mt)
#pragma unroll
        for (int nt = 0; nt < 4; ++nt)
          acc[mt][nt] = SWAP ? mfma16(b[nt], a[mt], acc[mt][nt]) : mfma16(a[mt], b[nt], acc[mt][nt]);
    }
    if (kt + 1 < KT) {
      const int nb = buf ^ 1;
#pragma unroll
      for (int i = 0; i < 4; ++i) {
        *(u32x4*)(As + nb * TILE_ELEMS + (lr + 32 * i) * LDT + lc) = ra[i];
        *(u32x4*)(Bs + nb * TILE_ELEMS + (lr + 32 * i) * LDT + lc) = rb[i];
      }
    }
    __syncthreads();
  }
}

DEVI void zero_acc(f32x4 (&acc)[4][4]) {
#pragma unroll
  for (int i = 0; i < 4; ++i)
#pragma unroll
    for (int k = 0; k < 4; ++k) acc[i][k] = (f32x4){0.f, 0.f, 0.f, 0.f};
}

DEVI void tile_diff_in(const Params& P, int j, int tile, u16* smem) {
  const int m0 = (tile >> 5) * 128, n0 = (tile & 31) * 128;
  const int region = n0 >> 10;
  const u16* A = (const u16*)(P.ws + WS_H);
  const u16* B = (const u16*)(P.ws + WS_WDAIN) + (size_t)j * 4096 * 1024;
  f32x4 acc[4][4];
  zero_acc(acc);
  if (region == 2) gemm_core<false>(A, 1024, B, 1024, 1024, m0, n0, smem, acc);
  else gemm_core<true>(A, 1024, B, 1024, 1024, m0, n0, smem, acc);

  const int lane = tidx() & 63, w = tidx() >> 6, wm = w >> 1, wn = w & 1, g = lane >> 4, li = lane & 15;
  const int mb = m0 + wm * 64, nb = n0 + wn * 64;
  const bool isLat = mb >= 4096;
  const int b = mb >> 8, sb = mb & 255, bl = (mb - 4096) >> 10, tb = (mb - 4096) & 1023;
  const float* ropeC = (const float*)(P.ws + WS_ROPE);
  const float* ropeS = ropeC + 1024 * 32;
  if (region == 2) {
    const int cbase = nb - 2048;
    u16* vtc = (u16*)(P.ws + WS_VTCTX);
    u16* vtl = (u16*)(P.ws + WS_VTLATD) + (size_t)j * VTLATD_J;
#pragma unroll
    for (int mt = 0; mt < 4; ++mt) {
      const int r0 = mt * 16 + g * 4;
#pragma unroll
      for (int nt = 0; nt < 4; ++nt) {
        const int col = cbase + nt * 16 + li, h = col >> 7, e = col & 127;
        if (!isLat) {
          const int s = sb + r0;
          float* sv = P.out + OUT_SV + ((size_t)((b * 2 + j) * 256 + s)) * 1024 + col;
#pragma unroll
          for (int jj = 0; jj < 4; ++jj) sv[(size_t)jj * 1024] = acc[mt][nt][jj];
          st_bf4(vtc + ((size_t)((b * 8 + h) * 128 + e)) * 256 + s, acc[mt][nt]);
        } else {
          const int t = tb + r0;
          st_bf4(vtl + ((size_t)((bl * 8 + h) * 128 + e)) * 1280 + t, acc[mt][nt]);
        }
      }
    }
  } else {
    const float qs = 0.125f * LOG2E;
#pragma unroll
    for (int mt = 0; mt < 4; ++mt) {
      const int rl = mt * 16 + li, row = mb + rl;
      if (region <= 1 && isLat) {
        const int t = tb + rl;
#pragma unroll
        for (int nt = 0; nt < 2; ++nt)
          rope4(acc[mt][nt], acc[mt][nt + 2], ropeC + t * 32 + nt * 16 + g * 4, ropeS + t * 32 + nt * 16 + g * 4);
      }
#pragma unroll
      for (int nt = 0; nt < 4; ++nt) {
        const int col = nb + nt * 16 + g * 4;
        f32x4 v = acc[mt][nt];
        if (region == 0) {
          v *= qs;
          st_bf4((u16*)(P.ws + WS_Q) + (size_t)row * 1024 + col, v);
        } else if (region == 1) {
          const int c2 = col - 1024;
          if (!isLat) {
            st_f4(P.out + OUT_SK + ((size_t)((b * 2 + j) * 256 + sb + rl)) * 1024 + c2, v);
            st_bf4((u16*)(P.ws + WS_CTXK) + (size_t)row * 1024 + c2, v);
          } else {
            st_bf4((u16*)(P.ws + WS_KDLAT) + (size_t)j * KDLAT_J + ((size_t)(bl * 1280 + tb + rl)) * 1024 + c2, v);
          }
        } else {
#pragma unroll
          for (int jj = 0; jj < 4; ++jj) v[jj] = silu(v[jj]);
          st_bf4((u16*)(P.ws + WS_G) + (size_t)row * 1024 + (col - 3072), v);
        }
      }
    }
  }
}

DEVI void tile_mla_in(const Params& P, int j, int tile, u16* smem) {
  const int m0 = (tile / 14) * 128, n0 = (tile % 14) * 128;
  const u16* A = (const u16*)(P.ws + WS_H);
  const u16* B = (const u16*)(P.ws + WS_WMLAIN) + (size_t)j * 1792 * 1024;
  f32x4 acc[4][4];
  zero_acc(acc);
  gemm_core<true>(A, 1024, B, 1024, 1024, m0, n0, smem, acc);

  const int lane = tidx() & 63, w = tidx() >> 6, wm = w >> 1, wn = w & 1, g = lane >> 4, li = lane & 15;
  const int mb = m0 + wm * 64, nb = n0 + wn * 64;
  const bool isLat = mb >= 4096;
  const int b = mb >> 8, sb = mb & 255, bl = (mb - 4096) >> 10, tb = (mb - 4096) & 1023;
  const float* ropeC = (const float*)(P.ws + WS_ROPE);
  const float* ropeS = ropeC + 1024 * 32;
  if (nb >= 1728) return;
#pragma unroll
  for (int mt = 0; mt < 4; ++mt) {
    const int rl = mt * 16 + li, row = mb + rl;
    if (nb < 640) {
      float ss = 0.f;
#pragma unroll
      for (int nt = 0; nt < 4; ++nt)
#pragma unroll
        for (int jj = 0; jj < 4; ++jj) ss += acc[mt][nt][jj] * acc[mt][nt][jj];
      ss += xshfl(ss, 16);
      ss += xshfl(ss, 32);
      if (nb < 384) {
        if (g == 0) ((float*)(P.ws + WS_SSQQ))[row * 8 + (nb >> 6)] = ss;
#pragma unroll
        for (int nt = 0; nt < 4; ++nt)
          st_bf4((u16*)(P.ws + WS_QA) + (size_t)row * 384 + nb + nt * 16 + g * 4, acc[mt][nt]);
      } else {
        if (g == 0) ((float*)(P.ws + WS_SSQKV))[row * 4 + ((nb - 384) >> 6)] = ss;
        const int arow = isLat ? (4096 + bl * 1280 + tb + rl) : row;
#pragma unroll
        for (int nt = 0; nt < 4; ++nt) {
          const int c2 = nb - 384 + nt * 16 + g * 4;
          st_bf4((u16*)(P.ws + WS_CKVA) + (size_t)j * CKVA_J + (size_t)arow * 256 + c2, acc[mt][nt]);
          if (!isLat) st_f4(P.out + OUT_CKV + ((size_t)((b * 2 + j) * 256 + sb + rl)) * 256 + c2, acc[mt][nt]);
        }
      }
    } else if (nb == 640) {
      if (isLat) {
        const int t = tb + rl;
#pragma unroll
        for (int nt = 0; nt < 2; ++nt)
          rope4(acc[mt][nt], acc[mt][nt + 2], ropeC + t * 32 + nt * 16 + g * 4, ropeS + t * 32 + nt * 16 + g * 4);
      }
#pragma unroll
      for (int nt = 0; nt < 4; ++nt) {
        const int d = nt * 16 + g * 4;
        if (!isLat) {
          st_f4(P.out + OUT_KPE + ((size_t)((b * 2 + j) * 256 + sb + rl)) * 64 + d, acc[mt][nt]);
          u16* kd = (u16*)(P.ws + WS_CTXK) + ((size_t)(b * 8) * 256 + sb + rl) * 192 + 128 + d;
#pragma unroll
          for (int h = 0; h < 8; ++h) st_bf4(kd + (size_t)h * 256 * 192, acc[mt][nt]);
        } else {
          u16* kd = (u16*)(P.ws + WS_KMLAT) + (size_t)j * KMLAT_J + ((size_t)(bl * 8) * 1280 + tb + rl) * 192 + 128 + d;
#pragma unroll
          for (int h = 0; h < 8; ++h) st_bf4(kd + (size_t)h * 1280 * 192, acc[mt][nt]);
        }
      }
    } else {
#pragma unroll
      for (int nt = 0; nt < 4; ++nt) {
        f32x4 v = acc[mt][nt];
#pragma unroll
        for (int jj = 0; jj < 4; ++jj) v[jj] = silu(v[jj]);
        st_bf4((u16*)(P.ws + WS_G) + (size_t)row * 1024 + (nb - 704 + nt * 16 + g * 4), v);
      }
    }
  }
}

DEVI void tile_qb(const Params& P, int j, int tile, u16* smem) {
  const int m0 = (tile / 12) * 128, n0 = (tile % 12) * 128;
  const u16* A = (const u16*)(P.ws + WS_QA);
  const u16* B = (const u16*)(P.ws + WS_WQB) + (size_t)j * 1536 * 384;
  f32x4 acc[4][4];
  zero_acc(acc);
  gemm_core<true>(A, 384, B, 384, 384, m0, n0, smem, acc);
  const int lane = tidx() & 63, w = tidx() >> 6, wm = w >> 1, wn = w & 1, g = lane >> 4, li = lane & 15;
  const int mb = m0 + wm * 64, nb = n0 + wn * 64;
  const bool isLat = mb >= 4096;
  const int tb = (mb - 4096) & 1023;
  const float* ropeC = (const float*)(P.ws + WS_ROPE);
  const float* ropeS = ropeC + 1024 * 32;
  const float* ssq = (const float*)(P.ws + WS_SSQQ);
  const bool isRope = (nb % 192) == 128;
  const float qs = 0.07216878364870322f * LOG2E;
#pragma unroll
  for (int mt = 0; mt < 4; ++mt) {
    const int rl = mt * 16 + li, row = mb + rl;
    float ss = 0.f;
#pragma unroll
    for (int i = 0; i < 6; ++i) ss += ssq[row * 8 + i];
    const float r = rsqrtf(ss * (1.f / 384.f) + EPS) * qs;
    if (isRope && isLat) {
      const int t = tb + rl;
#pragma unroll
      for (int nt = 0; nt < 2; ++nt)
        rope4(acc[mt][nt], acc[mt][nt + 2], ropeC + t * 32 + nt * 16 + g * 4, ropeS + t * 32 + nt * 16 + g * 4);
    }
#pragma unroll
    for (int nt = 0; nt < 4; ++nt) {
      f32x4 v = acc[mt][nt] * r;
      st_bf4((u16*)(P.ws + WS_Q) + (size_t)row * 1536 + nb + nt * 16 + g * 4, v);
    }
  }
}

DEVI void tile_kvb(const Params& P, int j, int tile, u16* smem) {
  const int m0 = (tile >> 4) * 128, n0 = (tile & 15) * 128;
  const bool tileLat = m0 >= 4096;
  const bool fresh = !tileLat || ((m0 - 4096) % 1280) < 1024;
  const u16* A = (const u16*)(P.ws + WS_CKVA) + (size_t)j * CKVA_J;
  const u16* B = (const u16*)(P.ws + (fresh ? WS_WKVBG : WS_WKVB)) + (size_t)j * 2048 * 256;
  const bool isV = (n0 >> 7) & 1;
  const int h = n0 >> 8;
  f32x4 acc[4][4];
  zero_acc(acc);
  if (isV) gemm_core<false>(A, 256, B, 256, 256, m0, n0, smem, acc);
  else gemm_core<true>(A, 256, B, 256, 256, m0, n0, smem, acc);
  const int lane = tidx() & 63, w = tidx() >> 6, wm = w >> 1, wn = w & 1, g = lane >> 4, li = lane & 15;
  const int mb = m0 + wm * 64;
  int b, keyb, Sk, tokb;
  u16 *Kd, *Vd;
  if (!tileLat) {
    b = mb >> 8; keyb = mb & 255; Sk = 256; tokb = mb;
    Kd = (u16*)(P.ws + WS_CTXK); Vd = (u16*)(P.ws + WS_VTCTX);
  } else {
    const int r2 = mb - 4096;
    b = r2 / 1280; keyb = r2 % 1280; Sk = 1280; tokb = 4096 + b * 1024 + keyb;
    Kd = (u16*)(P.ws + WS_KMLAT) + (size_t)j * KMLAT_J; Vd = (u16*)(P.ws + WS_VTLATM);
  }
  const float* ssq = (const float*)(P.ws + WS_SSQKV);
  if (!isV) {
#pragma unroll
    for (int mt = 0; mt < 4; ++mt) {
      const int rl = mt * 16 + li;
      float r = 1.f;
      if (fresh) {
        const float4 s4 = *(const float4*)(ssq + (size_t)(tokb + rl) * 4);
        r = rsqrtf((s4.x + s4.y + s4.z + s4.w) * (1.f / 256.f) + EPS);
      }
#pragma unroll
      for (int nt = 0; nt < 4; ++nt) {
        const int dd = wn * 64 + nt * 16 + g * 4;
        st_bf4(Kd + ((size_t)((b * 8 + h) * Sk + keyb + rl)) * 192 + dd, acc[mt][nt] * r);
      }
    }
  } else {
#pragma unroll
    for (int mt = 0; mt < 4; ++mt) {
      const int r0 = mt * 16 + g * 4;
      f32x4 rr = {1.f, 1.f, 1.f, 1.f};
      if (fresh) {
#pragma unroll
        for (int jj = 0; jj < 4; ++jj) {
          const float4 s4 = *(const float4*)(ssq + (size_t)(tokb + r0 + jj) * 4);
          rr[jj] = rsqrtf((s4.x + s4.y + s4.z + s4.w) * (1.f / 256.f) + EPS);
        }
      }
#pragma unroll
      for (int nt = 0; nt < 4; ++nt) {
        const int e = wn * 64 + nt * 16 + li;
        st_bf4(Vd + ((size_t)((b * 8 + h) * 128 + e)) * Sk + keyb + r0, acc[mt][nt] * rr);
      }
    }
  }
}

DEVI void tile_out(const Params& P, int layer, int tile, u16* smem) {
  const int m0 = (tile >> 3) * 128, n0 = (tile & 7) * 128;
  const u16* A = (const u16*)(P.ws + WS_O);
  const u16* B = (const u16*)(P.ws + WS_WOUT) + (size_t)layer * 1024 * 1024;
  f32x4 acc[4][4];
  zero_acc(acc);
  gemm_core<true>(A, 1024, B, 1024, 1024, m0, n0, smem, acc);
  const int lane = tidx() & 63, w = tidx() >> 6, wm = w >> 1, wn = w & 1, g = lane >> 4, li = lane & 15;
  const int mb = m0 + wm * 64, nb = n0 + wn * 64;
  float* T = (float*)(P.ws + WS_T);
#pragma unroll
  for (int mt = 0; mt < 4; ++mt)
#pragma unroll
    for (int nt = 0; nt < 4; ++nt)
      st_f4(T + (size_t)(mb + mt * 16 + li) * 1024 + nb + nt * 16 + g * 4, acc[mt][nt]);
}

template <bool DIFF>
DEVI void attn_item(const Params& P, const u16* __restrict__ Qb, int ldq, int qrow0,
                    const u16* __restrict__ Kb, int ldk, const u16* __restrict__ Vt, int Sk,
                    int h, float lam, float lam_init, const float* gsub, u16* smem) {
  constexpr int KW = DIFF ? 128 : 192;
  constexpr int KLD = KW + 8;
  constexpr int NKK = DIFF ? 2 : 6;
  constexpr int KCH = KW / 8;
  constexpr int NKL = (64 * KCH) / 256;
  constexpr int VLD = 72;
  u16* Ks = smem;
  u16* Vs = smem + 64 * KLD;
  const int tid = tidx(), lane = tid & 63, w = tid >> 6, g = lane >> 4, li = lane & 15;

  bf16x8 qf[2][NKK];
#pragma unroll
  for (int s = 0; s < 2; ++s) {
    const int qrow = DIFF ? (qrow0 + w * 16 + li) : (qrow0 + w * 32 + s * 16 + li);
    const int qcol = DIFF ? (h * 128 + s * 64) : (h * 192);
#pragma unroll
    for (int kk = 0; kk < NKK; ++kk)
      qf[s][kk] = *(const bf16x8*)(Qb + (size_t)qrow * ldq + qcol + kk * 32 + g * 8);
  }
  f32x4 oacc[2][8];
#pragma unroll
  for (int s = 0; s < 2; ++s)
#pragma unroll
    for (int et = 0; et < 8; ++et) oacc[s][et] = (f32x4){0.f, 0.f, 0.f, 0.f};
  float mrow[2] = {-1e30f, -1e30f}, lrow[2] = {0.f, 0.f};

  u32x4 rk[NKL], rv[4];
  auto gload = [&](int key0) {
#pragma unroll
    for (int i = 0; i < NKL; ++i) {
      const int c = tid + 256 * i, r = c / KCH, cc = c % KCH;
      rk[i] = *(const u32x4*)(Kb + (size_t)(key0 + r) * ldk + cc * 8);
    }
#pragma unroll
    for (int i = 0; i < 4; ++i) {
      const int c = tid + 256 * i, r = c >> 3, cc = c & 7;
      rv[i] = *(const u32x4*)(Vt + (size_t)r * Sk + key0 + cc * 8);
    }
  };
  gload(0);
  const int NT = Sk >> 6;
  for (int kt0 = 0; kt0 < NT; ++kt0) {
    __syncthreads();
#pragma unroll
    for (int i = 0; i < NKL; ++i) {
      const int c = tid + 256 * i, r = c / KCH, cc = c % KCH;
      *(u32x4*)(Ks + r * KLD + cc * 8) = rk[i];
    }
#pragma unroll
    for (int i = 0; i < 4; ++i) {
      const int c = tid + 256 * i, r = c >> 3, cc = c & 7;
      *(u32x4*)(Vs + r * VLD + cc * 8) = rv[i];
    }
    __syncthreads();
    if (kt0 + 1 < NT) gload((kt0 + 1) << 6);

    f32x4 st[2][4];
#pragma unroll
    for (int s = 0; s < 2; ++s)
#pragma unroll
      for (int kt = 0; kt < 4; ++kt) st[s][kt] = (f32x4){0.f, 0.f, 0.f, 0.f};
#pragma unroll
    for (int kk = 0; kk < NKK; ++kk) {
#pragma unroll
      for (int kt = 0; kt < 4; ++kt) {
        if (DIFF) {
#pragma unroll
          for (int s = 0; s < 2; ++s) {
            const bf16x8 kf = *(const bf16x8*)(Ks + (kt * 16 + li) * KLD + s * 64 + kk * 32 + g * 8);
            st[s][kt] = mfma16(kf, qf[s][kk], st[s][kt]);
          }
        } else {
          const bf16x8 kf = *(const bf16x8*)(Ks + (kt * 16 + li) * KLD + kk * 32 + g * 8);
#pragma unroll
          for (int s = 0; s < 2; ++s) st[s][kt] = mfma16(kf, qf[s][kk], st[s][kt]);
        }
      }
    }
    bf16x8 pf[2][2];
#pragma unroll
    for (int s = 0; s < 2; ++s) {
      float mx = st[s][0][0];
#pragma unroll
      for (int kt = 0; kt < 4; ++kt)
#pragma unroll
        for (int jj = 0; jj < 4; ++jj) mx = fmaxf(mx, st[s][kt][jj]);
      mx = fmaxf(mx, xshfl(mx, 16));
      mx = fmaxf(mx, xshfl(mx, 32));
      const float mnew = fmaxf(mrow[s], mx);
      const float alpha = exp2f(mrow[s] - mnew);
      mrow[s] = mnew;
      float ps = 0.f;
#pragma unroll
      for (int kt = 0; kt < 4; ++kt)
#pragma unroll
        for (int jj = 0; jj < 4; ++jj) {
          const float p = exp2f(st[s][kt][jj] - mnew);
          st[s][kt][jj] = p;
          ps += p;
        }
      lrow[s] = lrow[s] * alpha + ps;
#pragma unroll
      for (int et = 0; et < 8; ++et) oacc[s][et] *= alpha;
#pragma unroll
      for (int u = 0; u < 2; ++u) {
        union { bf16x8 v; unsigned d[4]; } pu;
        pu.d[0] = pk2(st[s][2 * u][0], st[s][2 * u][1]);
        pu.d[1] = pk2(st[s][2 * u][2], st[s][2 * u][3]);
        pu.d[2] = pk2(st[s][2 * u + 1][0], st[s][2 * u + 1][1]);
        pu.d[3] = pk2(st[s][2 * u + 1][2], st[s][2 * u + 1][3]);
        pf[s][u] = pu.v;
      }
    }
#pragma unroll
    for (int u = 0; u < 2; ++u) {
#pragma unroll
      for (int et = 0; et < 8; ++et) {
        union { bf16x8 v; u32x2 d[2]; } vu;
        vu.d[0] = *(const u32x2*)(Vs + (et * 16 + li) * VLD + (2 * u) * 16 + g * 4);
        vu.d[1] = *(const u32x2*)(Vs + (et * 16 + li) * VLD + (2 * u + 1) * 16 + g * 4);
#pragma unroll
        for (int s = 0; s < 2; ++s) oacc[s][et] = mfma16(vu.v, pf[s][u], oacc[s][et]);
      }
    }
  }
#pragma unroll
  for (int s = 0; s < 2; ++s) {
    lrow[s] += xshfl(lrow[s], 16);
    lrow[s] += xshfl(lrow[s], 32);
  }
  const u16* G = (const u16*)(P.ws + WS_G);
  u16* O = (u16*)(P.ws + WS_O);
  if (DIFF) {
    const float i0 = 1.f / lrow[0], i1 = lam / lrow[1];
    float ss = 0.f;
#pragma unroll
    for (int et = 0; et < 8; ++et) {
      oacc[0][et] = oacc[0][et] * i0 - oacc[1][et] * i1;
#pragma unroll
      for (int jj = 0; jj < 4; ++jj) ss += oacc[0][et][jj] * oacc[0][et][jj];
    }
    ss += xshfl(ss, 16);
    ss += xshfl(ss, 32);
    const float rr = rsqrtf(ss * (1.f / 128.f) + EPS) * (1.f - lam_init);
    const size_t tok = (size_t)(qrow0 + w * 16 + li);
#pragma unroll
    for (int et = 0; et < 8; ++et) {
      const int e = et * 16 + g * 4;
      const float4 gs = *(const float4*)(gsub + e);
      const uint2 gg = *(const uint2*)(G + tok * 1024 + h * 128 + e);
      f32x4 v = oacc[0][et] * rr;
      v[0] *= gs.x * bf2f(gg.x & 0xffffu);
      v[1] *= gs.y * bf2f(gg.x >> 16);
      v[2] *= gs.z * bf2f(gg.y & 0xffffu);
      v[3] *= gs.w * bf2f(gg.y >> 16);
      st_bf4(O + tok * 1024 + h * 128 + e, v);
    }
  } else {
#pragma unroll
    for (int s = 0; s < 2; ++s) {
      const float inv = 1.f / lrow[s];
      const size_t tok = (size_t)(qrow0 + w * 32 + s * 16 + li);
#pragma unroll
      for (int et = 0; et < 8; ++et) {
        const int e = et * 16 + g * 4;
        const uint2 gg = *(const uint2*)(G + tok * 1024 + h * 128 + e);
        f32x4 v = oacc[s][et] * inv;
        v[0] *= bf2f(gg.x & 0xffffu);
        v[1] *= bf2f(gg.x >> 16);
        v[2] *= bf2f(gg.y & 0xffffu);
        v[3] *= bf2f(gg.y >> 16);
        st_bf4(O + tok * 1024 + h * 128 + e, v);
      }
    }
  }
}

DEVI void attn_diff_phase(const Params& P, int j, u16* smem) {
  const float* lamv = (const float*)(P.ws + WS_MISC);
  const float lam = lamv[j * 2], lam_init = lamv[j * 2 + 1];
  const float* gsub = P.in[I_GSUB] + j * 128;
  const u16* Q = (const u16*)(P.ws + WS_Q);
  for (int it = blockIdx.x; it < 1024; it += gridDim.x) {
    if (it < 512) {
      const int bl = it >> 7, h = (it >> 4) & 7, qt = it & 15;
      const u16* Kb = (const u16*)(P.ws + WS_KDLAT) + (size_t)j * KDLAT_J + (size_t)bl * 1280 * 1024 + h * 128;
      const u16* Vt = (const u16*)(P.ws + WS_VTLATD) + (size_t)j * VTLATD_J + (size_t)(bl * 8 + h) * 128 * 1280;
      attn_item<true>(P, Q, 1024, 4096 + bl * 1024 + qt * 64, Kb, 1024, Vt, 1280, h, lam, lam_init, gsub, smem);
    } else {
      const int i2 = it - 512, b = i2 >> 5, h = (i2 >> 2) & 7, qt = i2 & 3;
      const u16* Kb = (const u16*)(P.ws + WS_CTXK) + (size_t)b * 256 * 1024 + h * 128;
      const u16* Vt = (const u16*)(P.ws + WS_VTCTX) + (size_t)(b * 8 + h) * 128 * 256;
      attn_item<true>(P, Q, 1024, b * 256 + qt * 64, Kb, 1024, Vt, 256, h, lam, lam_init, gsub, smem);
    }
  }
}

DEVI void attn_mla_phase(const Params& P, int j, u16* smem) {
  const u16* Q = (const u16*)(P.ws + WS_Q);
  for (int it = blockIdx.x; it < 512; it += gridDim.x) {
    if (it < 256) {
      const int bl = it >> 6, h = (it >> 3) & 7, qt = it & 7;
      const u16* Kb = (const u16*)(P.ws + WS_KMLAT) + (size_t)j * KMLAT_J + (size_t)(bl * 8 + h) * 1280 * 192;
      const u16* Vt = (const u16*)(P.ws + WS_VTLATM) + (size_t)(bl * 8 + h) * 128 * 1280;
      attn_item<false>(P, Q, 1536, 4096 + bl * 1024 + qt * 128, Kb, 192, Vt, 1280, h, 0.f, 0.f, nullptr, smem);
    } else {
      const int i2 = it - 256, b = i2 >> 4, h = (i2 >> 1) & 7, qt = i2 & 1;
      const u16* Kb = (const u16*)(P.ws + WS_CTXK) + (size_t)(b * 8 + h) * 256 * 192;
      const u16* Vt = (const u16*)(P.ws + WS_VTCTX) + (size_t)(b * 8 + h) * 128 * 256;
      attn_item<false>(P, Q, 1536, b * 256 + qt * 128, Kb, 192, Vt, 256, h, 0.f, 0.f, nullptr, smem);
    }
  }
}

DEVI float wave_sum(float v) {
  v += xshfl(v, 1); v += xshfl(v, 2); v += xshfl(v, 4); v += xshfl(v, 8); v += xshfl(v, 16); v += xshfl(v, 32);
  return v;
}

DEVI void ew_phase(const Params& P, int layer) {
  const int lane = tidx() & 63, w = tidx() >> 6;
  const float* ada = (const float*)(P.ws + WS_ADA);
  const float* T = (const float*)(P.ws + WS_T);
  u16* H = (u16*)(P.ws + WS_H);
  for (int row = blockIdx.x * 4 + w; row < 8192; row += gridDim.x * 4) {
    const int cond = row < 4096 ? 0 : 1 + ((row - 4096) >> 10);
    const float* xsrc = (layer <= 0) ? (row < 4096 ? P.in[I_XP] + (size_t)row * 1024 : P.in[I_XS] + (size_t)(row - 4096) * 1024)
                                     : P.out + OUT_Y + (size_t)row * 1024;
    float4 x[4];
#pragma unroll
    for (int i = 0; i < 4; ++i) x[i] = *(const float4*)(xsrc + lane * 4 + i * 256);
    if (layer >= 0) {
      float4 t[4];
      float ss = 0.f;
#pragma unroll
      for (int i = 0; i < 4; ++i) {
        t[i] = *(const float4*)(T + (size_t)row * 1024 + lane * 4 + i * 256);
        ss += t[i].x * t[i].x + t[i].y * t[i].y + t[i].z * t[i].z + t[i].w * t[i].w;
      }
      ss = wave_sum(ss);
      const float rt = rsqrtf(ss * (1.f / 1024.f) + EPS);
      const float* gate = ada + (size_t)(layer * 5 + cond) * 3072 + 2048;
      const float* gp = P.in[I_GPOST] + layer * 1024;
#pragma unroll
      for (int i = 0; i < 4; ++i) {
        const int c = lane * 4 + i * 256;
        const float4 ga = *(const float4*)(gate + c);
        const float4 gq = *(const float4*)(gp + c);
        x[i].x += ga.x * (t[i].x * rt * gq.x);
        x[i].y += ga.y * (t[i].y * rt * gq.y);
        x[i].z += ga.z * (t[i].z * rt * gq.z);
        x[i].w += ga.w * (t[i].w * rt * gq.w);
        *(float4*)(P.out + OUT_Y + (size_t)row * 1024 + c) = x[i];
      }
    }
    const int nl = layer + 1;
    if (nl < 4) {
      float ss = 0.f;
#pragma unroll
      for (int i = 0; i < 4; ++i) ss += x[i].x * x[i].x + x[i].y * x[i].y + x[i].z * x[i].z + x[i].w * x[i].w;
      ss = wave_sum(ss);
      const float rx = rsqrtf(ss * (1.f / 1024.f) + EPS);
      const float* sh = ada + (size_t)(nl * 5 + cond) * 3072;
      const float* sc = sh + 1024;
      const float* gpre = P.in[I_GPRE] + nl * 1024;
#pragma unroll
      for (int i = 0; i < 4; ++i) {
        const int c = lane * 4 + i * 256;
        const float4 s1 = *(const float4*)(sh + c);
        const float4 s2 = *(const float4*)(sc + c);
        const float4 gq = *(const float4*)(gpre + c);
        f32x4 hv;
        hv[0] = x[i].x * rx * gq.x * (1.f + s2.x) + s1.x;
        hv[1] = x[i].y * rx * gq.y * (1.f + s2.y) + s1.y;
        hv[2] = x[i].z * rx * gq.z * (1.f + s2.z) + s1.z;
        hv[3] = x[i].w * rx * gq.w * (1.f + s2.w) + s1.w;
        st_bf4(H + (size_t)row * 1024 + c, hv);
      }
    }
  }
}

DEVI void tr_tile(const float* __restrict__ src, int lds, int k0, int n0, int nvalid, u16* __restrict__ dst, int ldd,
                  const float* kscale, float* tile) {
  const int tid = tidx();
  __syncthreads();
#pragma unroll
  for (int i = 0; i < 16; ++i) {
    const int idx = tid + 256 * i, kk = idx >> 6, nn = idx & 63;
    float v = (n0 + nn < nvalid) ? src[(size_t)(k0 + kk) * lds + n0 + nn] : 0.f;
    if (kscale) v *= kscale[k0 + kk];
    tile[kk * 65 + nn] = v;
  }
  __syncthreads();
#pragma unroll
  for (int i = 0; i < 8; ++i) {
    const int idx = tid + 256 * i, nn = idx >> 5, kp = (idx & 31) * 2;
    *(unsigned*)(dst + (size_t)(n0 + nn) * ldd + k0 + kp) = pk2(tile[kp * 65 + nn], tile[(kp + 1) * 65 + nn]);
  }
}

constexpr int N_ADA = 384;
constexpr int N_TWOUT = 1024, N_TDAIN = 2048, N_TMLAIN = 896, N_TQB = 288, N_TKVB = 256, N_TCV = 512;
constexpr int N_ROPE = 128, N_LAM = 1, N_CDK = 1024, N_CCKV = 256, N_CKPE = 64;
constexpr int P0_ITEMS = N_ADA + N_TWOUT + N_TDAIN + N_TMLAIN + N_TQB + N_TKVB + N_TCV + N_ROPE + N_LAM + N_CDK + N_CCKV + N_CKPE;

DEVI void prep_phase(const Params& P, u16* smem) {
  float* fs = (float*)smem;
  const int tid = tidx();
  for (int item = blockIdx.x; item < P0_ITEMS; item += gridDim.x) {
    int it = item;
    if (it < N_ADA) {
      const int layer = it / 96, cgp = it % 96;
      float* sc = fs;
      float* red = fs + 5120;
      __syncthreads();
      for (int idx = tid; idx < 5120; idx += 256) {
        const int cnd = idx >> 10, k = idx & 1023;
        const float v = cnd == 0 ? P.in[I_CCTX][k] : P.in[I_C][(cnd - 1) * 1024 + k];
        sc[idx] = silu(v);
      }
      __syncthreads();
      const int col = tid & 31, kg = tid >> 5;
      const float* wp = P.in[I_WADA] + (size_t)layer * 1024 * 3072 + cgp * 32 + col;
      float a0 = 0.f, a1 = 0.f, a2 = 0.f, a3 = 0.f, a4 = 0.f;
#pragma unroll 8
      for (int k = kg * 128; k < kg * 128 + 128; ++k) {
        const float wv = wp[(size_t)k * 3072];
        a0 += sc[k] * wv; a1 += sc[1024 + k] * wv; a2 += sc[2048 + k] * wv; a3 += sc[3072 + k] * wv; a4 += sc[4096 + k] * wv;
      }
      red[(kg * 5 + 0) * 32 + col] = a0; red[(kg * 5 + 1) * 32 + col] = a1; red[(kg * 5 + 2) * 32 + col] = a2;
      red[(kg * 5 + 3) * 32 + col] = a3; red[(kg * 5 + 4) * 32 + col] = a4;
      __syncthreads();
      if (tid < 160) {
        const int cnd = tid >> 5, c2 = tid & 31;
        float s = P.in[I_BADA][layer * 3072 + cgp * 32 + c2];
#pragma unroll
        for (int q = 0; q < 8; ++q) s += red[(q * 5 + cnd) * 32 + c2];
        ((float*)(P.ws + WS_ADA))[(size_t)(layer * 5 + cnd) * 3072 + cgp * 32 + c2] = s;
      }
      continue;
    }
    it -= N_ADA;
    if (it < N_TWOUT) {
      const int l = it >> 8, kt = (it >> 4) & 15, nt = it & 15;
      tr_tile(P.in[I_WOUT] + (size_t)l * 1024 * 1024, 1024, kt * 64, nt * 64, 1024,
              (u16*)(P.ws + WS_WOUT) + (size_t)l * 1024 * 1024, 1024, nullptr, fs);
      continue;
    }
    it -= N_TWOUT;
    if (it < N_TDAIN) {
      const int l = it >> 10, kt = (it >> 6) & 15, nt = it & 63;
      tr_tile(P.in[I_DAWIN] + (size_t)l * 1024 * 4096, 4096, kt * 64, nt * 64, 4096,
              (u16*)(P.ws + WS_WDAIN) + (size_t)l * 4096 * 1024, 1024, nullptr, fs);
      continue;
    }
    it -= N_TDAIN;
    if (it < N_TMLAIN) {
      const int l = it / 448, r = it % 448, kt = r / 28, nt = r % 28;
      tr_tile(P.in[I_MWIN] + (size_t)l * 1024 * 1728, 1728, kt * 64, nt * 64, 1728,
              (u16*)(P.ws + WS_WMLAIN) + (size_t)l * 1792 * 1024, 1024, nullptr, fs);
      continue;
    }
    it -= N_TMLAIN;
    if (it < N_TQB) {
      const int l = it / 144, r = it % 144, kt = r / 24, nt = r % 24;
      tr_tile(P.in[I_WQB] + (size_t)l * 384 * 1536, 1536, kt * 64, nt * 64, 1536,
              (u16*)(P.ws + WS_WQB) + (size_t)l * 1536 * 384, 384, P.in[I_GQA] + l * 384, fs);
      continue;
    }
    it -= N_TQB;
    if (it < N_TKVB) {
      const int l = it >> 7, kt = (it >> 5) & 3, nt = it & 31;
      tr_tile(P.in[I_WKVB] + (size_t)l * 256 * 2048, 2048, kt * 64, nt * 64, 2048,
              (u16*)(P.ws + WS_WKVB) + (size_t)l * 2048 * 256, 256, nullptr, fs);
      tr_tile(P.in[I_WKVB] + (size_t)l * 256 * 2048, 2048, kt * 64, nt * 64, 2048,
              (u16*)(P.ws + WS_WKVBG) + (size_t)l * 2048 * 256, 256, P.in[I_GKVA] + l * 256, fs);
      continue;
    }
    it -= N_TKVB;
    if (it < N_TCV) {
      const int grp = it >> 3, sub = it & 7, bl = grp >> 4, jj = (grp >> 3) & 1, h = grp & 7, pt = sub >> 1, et = sub & 1;
      const float* src = P.in[I_CDV] + ((size_t)(bl * 2 + jj) * 256) * 1024 + h * 128;
      u16* dst = (u16*)(P.ws + WS_VTLATD) + (size_t)jj * VTLATD_J + (size_t)(bl * 8 + h) * 128 * 1280 + 1024;
      tr_tile(src, 1024, pt * 64, et * 64, 128, dst, 1280, nullptr, fs);
      continue;
    }
    it -= N_TCV;
    if (it < N_ROPE) {
      const int idx = it * 256 + tid, t = idx >> 5, p = idx & 31, f = p & 15;
      const float inv = exp2f(-(float)f * (13.287712379549449f / 16.f));
      const float pos = (p < 16) ? (float)(t >> 6) : (float)(t & 63);
      float sn, cs;
      sincosf(pos * inv, &sn, &cs);
      float* rc = (float*)(P.ws + WS_ROPE);
      rc[idx] = cs;
      rc[1024 * 32 + idx] = sn;
      continue;
    }
    it -= N_ROPE;
    if (it < N_LAM) {
      if (tid < 2) {
        const int jd = tid;
        float s1 = 0.f, s2 = 0.f;
        for (int d = 0; d < 64; ++d) {
          s1 += P.in[I_LQ1][jd * 64 + d] * P.in[I_LK1][jd * 64 + d];
          s2 += P.in[I_LQ2][jd * 64 + d] * P.in[I_LK2][jd * 64 + d];
        }
        const float li = 0.8f - 0.6f * expf(-0.3f * (float)(2 * jd));
        float* lamv = (float*)(P.ws + WS_MISC);
        lamv[jd * 2] = expf(s1) - expf(s2) + li;
        lamv[jd * 2 + 1] = li;
      }
      continue;
    }
    it -= N_LAM;
    if (it < N_CDK) {
      const size_t e0 = ((size_t)it * 256 + tid) * 8;
      const int col = e0 & 1023, p = (e0 >> 10) & 255, jj = (e0 >> 18) & 1, bl = (int)(e0 >> 19);
      const float4 a = *(const float4*)(P.in[I_CDK] + e0);
      const float4 b = *(const float4*)(P.in[I_CDK] + e0 + 4);
      uint4 u; u.x = pk2(a.x, a.y); u.y = pk2(a.z, a.w); u.z = pk2(b.x, b.y); u.w = pk2(b.z, b.w);
      *(uint4*)((u16*)(P.ws + WS_KDLAT) + (size_t)jj * KDLAT_J + ((size_t)(bl * 1280 + 1024 + p)) * 1024 + col) = u;
      continue;
    }
    it -= N_CDK;
    if (it < N_CCKV) {
      const size_t e0 = ((size_t)it * 256 + tid) * 8;
      const int col = e0 & 255, p = (e0 >> 8) & 255, jj = (e0 >> 16) & 1, bl = (int)(e0 >> 17);
      const float4 a = *(const float4*)(P.in[I_CCKV] + e0);
      const float4 b = *(const float4*)(P.in[I_CCKV] + e0 + 4);
      uint4 u; u.x = pk2(a.x, a.y); u.y = pk2(a.z, a.w); u.z = pk2(b.x, b.y); u.w = pk2(b.z, b.w);
      *(uint4*)((u16*)(P.ws + WS_CKVA) + (size_t)jj * CKVA_J + ((size_t)(4096 + bl * 1280 + 1024 + p)) * 256 + col) = u;
      continue;
    }
    it -= N_CCKV;
    {
      const size_t e0 = ((size_t)it * 256 + tid) * 8;
      const int d = e0 & 63, p = (e0 >> 6) & 255, jj = (e0 >> 14) & 1, bl = (int)(e0 >> 15);
      const float4 a = *(const float4*)(P.in[I_CKPE] + e0);
      const float4 b = *(const float4*)(P.in[I_CKPE] + e0 + 4);
      uint4 u; u.x = pk2(a.x, a.y); u.y = pk2(a.z, a.w); u.z = pk2(b.x, b.y); u.w = pk2(b.z, b.w);
      u16* dst = (u16*)(P.ws + WS_KMLAT) + (size_t)jj * KMLAT_J + ((size_t)(bl * 8) * 1280 + 1024 + p) * 192 + 128 + d;
#pragma unroll
      for (int h = 0; h < 8; ++h) *(uint4*)(dst + (size_t)h * 1280 * 192) = u;
    }
  }
}

DEVI void mla_b_phase(const Params& P, int j, u16* smem) {
  constexpr int NQ = 64 * 12, NKV = 72 * 16, NNORM = 64;
  for (int it = blockIdx.x; it < NKV + NQ + NNORM; it += gridDim.x) {
    if (it < NKV) tile_kvb(P, j, it, smem);
    else if (it < NKV + NQ) tile_qb(P, j, it - NKV, smem);
    else {
      const int lane = tidx() & 63, w = tidx() >> 6;
      const float* ssq = (const float*)(P.ws + WS_SSQKV);
      const float4 gk = *(const float4*)(P.in[I_GKVA] + j * 256 + lane * 4);
      for (int r = w; r < 64; r += 4) {
        const int row = (it - NKV - NQ) * 64 + r;
        const float4 s4 = *(const float4*)(ssq + (size_t)row * 4);
        const float rr = rsqrtf((s4.x + s4.y + s4.z + s4.w) * (1.f / 256.f) + EPS);
        float* p = P.out + OUT_CKV + ((size_t)(((row >> 8) * 2 + j) * 256 + (row & 255))) * 256 + lane * 4;
        float4 v = *(float4*)p;
        v.x *= rr * gk.x; v.y *= rr * gk.y; v.z *= rr * gk.z; v.w *= rr * gk.w;
        *(float4*)p = v;
      }
    }
  }
}

#ifndef EN
#define EN 0xFF
#endif
DEVI void run_phase(const Params& P, int ph, u16* smem) {
  if (ph == 0) { if (EN & 1) prep_phase(P, smem); return; }
  if (ph == 1) { if (EN & 2) ew_phase(P, -1); return; }
  int layer, sub;
  if (ph < 6) { layer = 0; sub = ph - 2; }
  else if (ph < 11) { layer = 1; sub = ph - 6; }
  else if (ph < 15) { layer = 2; sub = ph - 11; }
  else { layer = 3; sub = ph - 15; }
  const int j = layer >> 1;
  if ((layer & 1) == 0) {
    if (sub == 0) { if (EN & 4) for (int t = blockIdx.x; t < 64 * 32; t += gridDim.x) tile_diff_in(P, j, t, smem); }
    else if (sub == 1) { if (EN & 8) attn_diff_phase(P, j, smem); }
    else if (sub == 2) { if (EN & 16) for (int t = blockIdx.x; t < 64 * 8; t += gridDim.x) tile_out(P, layer, t, smem); }
    else { if (EN & 2) ew_phase(P, layer); }
  } else {
    if (sub == 0) { if (EN & 32) for (int t = blockIdx.x; t < 64 * 14; t += gridDim.x) tile_mla_in(P, j, t, smem); }
    else if (sub == 1) { if (EN & 64) mla_b_phase(P, j, smem); }
    else if (sub == 2) { if (EN & 128) attn_mla_phase(P, j, smem); }
    else if (sub == 3) { if (EN & 16) for (int t = blockIdx.x; t < 64 * 8; t += gridDim.x) tile_out(P, layer, t, smem); }
    else { if (EN & 2) ew_phase(P, layer); }
  }
}

constexpr int N_PHASES = 20;

__global__ void __launch_bounds__(256) fwd_megakernel(Params P) {
  __shared__ __attribute__((aligned(16))) u16 smem[SMEM_BYTES / 2];
  for (int ph = P.ph_lo; ph < P.ph_hi; ++ph) {
    Params Pl = P;
    asm volatile("" : "+s"(Pl.ws), "+s"(Pl.out));
    run_phase(Pl, ph, smem);
    if (ph + 1 < P.ph_hi) cg::this_grid().sync();
  }
}

extern "C" void kernel_launch(void* const* d_in, const int* in_sizes, int n_in, void* d_out, int out_size, void* d_ws,
                              size_t ws_size, hipStream_t stream) {
  static int grid_blocks = 0;
  if (!grid_blocks) {
    int dev = 0, cus = 0, per_cu = 0;
    hipGetDevice(&dev);
    hipDeviceGetAttribute(&cus, hipDeviceAttributeMultiprocessorCount, dev);
    hipOccupancyMaxActiveBlocksPerMultiprocessor(&per_cu, fwd_megakernel, 256, 0);
    if (per_cu < 1) per_cu = 1;
    if (per_cu > 2) per_cu = 2;
    grid_blocks = cus * per_cu;
  }
  Params p{};
  for (int i = 0; i < 24; ++i) p.in[i] = (const float*)d_in[i];
  p.out = (float*)d_out;
  p.ws = (unsigned char*)d_ws;
#if MULTI_LAUNCH
  for (int ph = 0; ph < N_PHASES; ++ph) {
    p.ph_lo = ph; p.ph_hi = ph + 1;
    hipLaunchKernelGGL(fwd_megakernel, dim3(grid_blocks), dim3(256), 0, stream, p);
  }
#else
  p.ph_lo = 0; p.ph_hi = N_PHASES;
  void* args[] = {&p};
  hipError_t e = hipLaunchCooperativeKernel((void*)fwd_megakernel, dim3(grid_blocks), dim3(256), args, 0, stream);
  if (e != hipSuccess) fprintf(stderr, "cooperative launch failed: %s (grid %d)\n", hipGetErrorString(e), grid_blocks);
#endif
}
```

```cpp
#include <hip/hip_runtime.h>
#include <hip/hip_cooperative_groups.h>
#include <cstdio>
namespace cg = cooperative_groups;

#ifndef MULTI_LAUNCH
#define MULTI_LAUNCH 0
#endif

typedef unsigned short u16;
typedef __attribute__((ext_vector_type(8))) short bf16x8;
typedef __attribute__((ext_vector_type(4))) float f32x4;
typedef __attribute__((ext_vector_type(4))) unsigned u32x4;
typedef __attribute__((ext_vector_type(2))) unsigned u32x2;

#define DEVI __device__ __forceinline__

struct Params {
  const float* in[24];
  float* out;
  unsigned char* ws;
  int ph_lo, ph_hi;
};

constexpr size_t MBy = 1u << 20;
constexpr size_t WS_WOUT = 0;
constexpr size_t WS_WDAIN = 8 * MBy;
constexpr size_t WS_WMLAIN = 24 * MBy;
constexpr size_t WS_WQB = 31 * MBy;
constexpr size_t WS_WKVB = 34 * MBy;
constexpr size_t WS_WKVBG = 36 * MBy;
constexpr size_t WS_ADA = 38 * MBy;
constexpr size_t WS_ROPE = 39 * MBy;
constexpr size_t WS_MISC = 40 * MBy;
constexpr size_t WS_H = 41 * MBy;
constexpr size_t WS_O = WS_H;
constexpr size_t WS_Q = 57 * MBy;
constexpr size_t WS_T = WS_Q;
constexpr size_t WS_CTXK = 81 * MBy;
constexpr size_t WS_KDLAT = 93 * MBy;
constexpr size_t WS_VTCTX = 113 * MBy;
constexpr size_t WS_VTLATD = 121 * MBy;
constexpr size_t WS_VTLATM = 141 * MBy;
constexpr size_t WS_G = 151 * MBy;
constexpr size_t WS_QA = 167 * MBy;
constexpr size_t WS_CKVA = 173 * MBy;
constexpr size_t WS_SSQQ = 183 * MBy;
constexpr size_t WS_SSQKV = 184 * MBy;
constexpr size_t WS_KMLAT = 185 * MBy;
constexpr size_t WS_KVRAW = 215 * MBy;
constexpr size_t KDLAT_J = (size_t)4 * 1280 * 1024;
constexpr size_t VTLATD_J = (size_t)4 * 8 * 128 * 1280;
constexpr size_t CKVA_J = (size_t)9216 * 256;
constexpr size_t KMLAT_J = (size_t)4 * 8 * 1280 * 192;

constexpr size_t OUT_Y = 0;
constexpr size_t OUT_SK = 8388608;
constexpr size_t OUT_SV = 16777216;
constexpr size_t OUT_CKV = 25165824;
constexpr size_t OUT_KPE = 27262976;

constexpr float EPS = 1e-6f;
constexpr float LOG2E = 1.4426950408889634f;

enum { I_XP = 0, I_XS, I_CDK, I_CDV, I_CCKV, I_CKPE, I_C, I_CCTX, I_WADA, I_BADA, I_GPRE, I_GPOST, I_WOUT,
       I_DAWIN, I_LQ1, I_LK1, I_LQ2, I_LK2, I_GSUB, I_MWIN, I_GQA, I_WQB, I_GKVA, I_WKVB };

DEVI int tidx() { int t = threadIdx.x; asm volatile("" : "+v"(t)); return t; }
DEVI u16 f2bf(float f) {
  unsigned u = __float_as_uint(f);
  u += 0x7fffu + ((u >> 16) & 1u);
  return (u16)(u >> 16);
}
DEVI unsigned pk2(float a, float b) { return (unsigned)f2bf(a) | ((unsigned)f2bf(b) << 16); }
DEVI float bf2f(unsigned v) { return __uint_as_float(v << 16); }
DEVI void st_bf4(u16* p, f32x4 v) {
  uint2 u; u.x = pk2(v[0], v[1]); u.y = pk2(v[2], v[3]);
  *(uint2*)p = u;
}
DEVI void st_f4(float* p, f32x4 v) { *(float4*)p = make_float4(v[0], v[1], v[2], v[3]); }
DEVI f32x4 mfma16(bf16x8 a, bf16x8 b, f32x4 c) { return __builtin_amdgcn_mfma_f32_16x16x32_bf16(a, b, c, 0, 0, 0); }
DEVI float silu(float x) { return x / (1.f + __expf(-x)); }
DEVI float xshfl(float v, int m) { return __shfl_xor(v, m, 64); }

DEVI void rope4(f32x4& x1, f32x4& x2, const float* cs, const float* sn) {
  float4 c = *(const float4*)cs; float4 s = *(const float4*)sn;
  f32x4 a = x1, b = x2;
  x1[0] = a[0] * c.x - b[0] * s.x; x2[0] = a[0] * s.x + b[0] * c.x;
  x1[1] = a[1] * c.y - b[1] * s.y; x2[1] = a[1] * s.y + b[1] * c.y;
  x1[2] = a[2] * c.z - b[2] * s.z; x2[2] = a[2] * s.z + b[2] * c.z;
  x1[3] = a[3] * c.w - b[3] * s.w; x2[3] = a[3] * s.w + b[3] * c.w;
}

constexpr int LDT = 72;
constexpr int TILE_ELEMS = 128 * LDT;
constexpr int SMEM_BYTES = 4 * TILE_ELEMS * 2;

template <bool SWAP>
DEVI void gemm_core(const u16* __restrict__ A, int lda, const u16* __restrict__ B, int ldb, int K,
                    int m0, int n0, u16* smem, f32x4 (&acc)[4][4]) {
  const int tid = tidx(), lane = tid & 63, w = tid >> 6;
  const int wm = w >> 1, wn = w & 1;
  const int g = lane >> 4, li = lane & 15;
  u16* As = smem;
  u16* Bs = smem + 2 * TILE_ELEMS;
  const int lr = tid >> 3, lc = (tid & 7) * 8;
  const u16* ap = A + (size_t)(m0 + lr) * lda + lc;
  const u16* bp = B + (size_t)(n0 + lr) * ldb + lc;
  u32x4 ra[4], rb[4];
#pragma unroll
  for (int i = 0; i < 4; ++i) {
    ra[i] = *(const u32x4*)(ap + (size_t)i * 32 * lda);
    rb[i] = *(const u32x4*)(bp + (size_t)i * 32 * ldb);
  }
  __syncthreads();
#pragma unroll
  for (int i = 0; i < 4; ++i) {
    *(u32x4*)(As + (lr + 32 * i) * LDT + lc) = ra[i];
    *(u32x4*)(Bs + (lr + 32 * i) * LDT + lc) = rb[i];
  }
  __syncthreads();
  const int KT = K >> 6;
  for (int kt = 0; kt < KT; ++kt) {
    const int buf = kt & 1;
    if (kt + 1 < KT) {
      const int k0 = (kt + 1) << 6;
#pragma unroll
      for (int i = 0; i < 4; ++i) {
        ra[i] = *(const u32x4*)(ap + (size_t)i * 32 * lda + k0);
        rb[i] = *(const u32x4*)(bp + (size_t)i * 32 * ldb + k0);
      }
    }
    const u16* Ab = As + buf * TILE_ELEMS + (wm * 64 + li) * LDT + g * 8;
    const u16* Bb = Bs + buf * TILE_ELEMS + (wn * 64 + li) * LDT + g * 8;
#pragma unroll
    for (int ks = 0; ks < 2; ++ks) {
      bf16x8 a[4], b[4];
#pragma unroll
      for (int t = 0; t < 4; ++t) {
        a[t] = *(const bf16x8*)(Ab + t * 16 * LDT + ks * 32);
        b[t] = *(const bf16x8*)(Bb + t * 16 * LDT + ks * 32);
      }
#pragma unroll
      for (int mt = 0; mt < 4; ++mt)
#pragma unroll
        for (int nt = 0; nt < 4; ++nt)
          acc[mt][nt] = SWAP ? mfma16(b[nt], a[mt], acc[mt][nt]) : mfma16(a[mt], b[nt], acc[mt][nt]);
    }
    if (kt + 1 < KT) {
      const int nb = buf ^ 1;
#pragma unroll
      for (int i = 0; i < 4; ++i) {
        *(u32x4*)(As + nb * TILE_ELEMS + (lr + 32 * i) * LDT + lc) = ra[i];
        *(u32x4*)(Bs + nb * TILE_ELEMS + (lr + 32 * i) * LDT + lc) = rb[i];
      }
    }
    __syncthreads();
  }
}

DEVI void zero_acc(f32x4 (&acc)[4][4]) {
#pragma unroll
  for (int i = 0; i < 4; ++i)
#pragma unroll
    for (int k = 0; k < 4; ++k) acc[i][k] = (f32x4){0.f, 0.f, 0.f, 0.f};
}

DEVI void tile_diff_in(const Params& P, int j, int tile, u16* smem) {
  const int m0 = (tile >> 5) * 128, n0 = (tile & 31) * 128;
  const int region = n0 >> 10;
  const u16* A = (const u16*)(P.ws + WS_H);
  const u16* B = (const u16*)(P.ws + WS_WDAIN) + (size_t)j * 4096 * 1024;
  f32x4 acc[4][4];
  zero_acc(acc);
  if (region == 2) gemm_core<false>(A, 1024, B, 1024, 1024, m0, n0, smem, acc);
  else gemm_core<true>(A, 1024, B, 1024, 1024, m0, n0, smem, acc);

  const int lane = tidx() & 63, w = tidx() >> 6, wm = w >> 1, wn = w & 1, g = lane >> 4, li = lane & 15;
  const int mb = m0 + wm * 64, nb = n0 + wn * 64;
  const bool isLat = mb >= 4096;
  const int b = mb >> 8, sb = mb & 255, bl = (mb - 4096) >> 10, tb = (mb - 4096) & 1023;
  const float* ropeC = (const float*)(P.ws + WS_ROPE);
  const float* ropeS = ropeC + 1024 * 32;
  if (region == 2) {
    const int cbase = nb - 2048;
    u16* vtc = (u16*)(P.ws + WS_VTCTX);
    u16* vtl = (u16*)(P.ws + WS_VTLATD) + (size_t)j * VTLATD_J;
#pragma unroll
    for (int mt = 0; mt < 4; ++mt) {
      const int r0 = mt * 16 + g * 4;
#pragma unroll
      for (int nt = 0; nt < 4; ++nt) {
        const int col = cbase + nt * 16 + li, h = col >> 7, e = col & 127;
        if (!isLat) {
          const int s = sb + r0;
          float* sv = P.out + OUT_SV + ((size_t)((b * 2 + j) * 256 + s)) * 1024 + col;
#pragma unroll
          for (int jj = 0; jj < 4; ++jj) sv[(size_t)jj * 1024] = acc[mt][nt][jj];
          st_bf4(vtc + ((size_t)((b * 8 + h) * 128 + e)) * 256 + s, acc[mt][nt]);
        } else {
          const int t = tb + r0;
          st_bf4(vtl + ((size_t)((bl * 8 + h) * 128 + e)) * 1280 + t, acc[mt][nt]);
        }
      }
    }
  } else {
    const float qs = 0.125f * LOG2E;
#pragma unroll
    for (int mt = 0; mt < 4; ++mt) {
      const int rl = mt * 16 + li, row = mb + rl;
      if (region <= 1 && isLat) {
        const int t = tb + rl;
#pragma unroll
        for (int nt = 0; nt < 2; ++nt)
          rope4(acc[mt][nt], acc[mt][nt + 2], ropeC + t * 32 + nt * 16 + g * 4, ropeS + t * 32 + nt * 16 + g * 4);
      }
#pragma unroll
      for (int nt = 0; nt < 4; ++nt) {
        const int col = nb + nt * 16 + g * 4;
        f32x4 v = acc[mt][nt];
        if (region == 0) {
          v *= qs;
          st_bf4((u16*)(P.ws + WS_Q) + (size_t)row * 1024 + col, v);
        } else if (region == 1) {
          const int c2 = col - 1024;
          if (!isLat) {
            st_f4(P.out + OUT_SK + ((size_t)((b * 2 + j) * 256 + sb + rl)) * 1024 + c2, v);
            st_bf4((u16*)(P.ws + WS_CTXK) + (size_t)row * 1024 + c2, v);
          } else {
            st_bf4((u16*)(P.ws + WS_KDLAT) + (size_t)j * KDLAT_J + ((size_t)(bl * 1280 + tb + rl)) * 1024 + c2, v);
          }
        } else {
#pragma unroll
          for (int jj = 0; jj < 4; ++jj) v[jj] = silu(v[jj]);
          st_bf4((u16*)(P.ws + WS_G) + (size_t)row * 1024 + (col - 3072), v);
        }
      }
    }
  }
}

DEVI void tile_mla_in(const Params& P, int j, int tile, u16* smem) {
  const int m0 = (tile / 14) * 128, n0 = (tile % 14) * 128;
  const u16* A = (const u16*)(P.ws + WS_H);
  const u16* B = (const u16*)(P.ws + WS_WMLAIN) + (size_t)j * 1792 * 1024;
  f32x4 acc[4][4];
  zero_acc(acc);
  gemm_core<true>(A, 1024, B, 1024, 1024, m0, n0, smem, acc);

  const int lane = tidx() & 63, w = tidx() >> 6, wm = w >> 1, wn = w & 1, g = lane >> 4, li = lane & 15;
  const int mb = m0 + wm * 64, nb = n0 + wn * 64;
  const bool isLat = mb >= 4096;
  const int b = mb >> 8, sb = mb & 255, bl = (mb - 4096) >> 10, tb = (mb - 4096) & 1023;
  const float* ropeC = (const float*)(P.ws + WS_ROPE);
  const float* ropeS = ropeC + 1024 * 32;
  if (nb >= 1728) return;
#pragma unroll
  for (int mt = 0; mt < 4; ++mt) {
    const int rl = mt * 16 + li, row = mb + rl;
    if (nb < 640) {
      float ss = 0.f;
#pragma unroll
      for (int nt = 0; nt < 4; ++nt)
#pragma unroll
        for (int jj = 0; jj < 4; ++jj) ss += acc[mt][nt][jj] * acc[mt][nt][jj];
      ss += xshfl(ss, 16);
      ss += xshfl(ss, 32);
      if (nb < 384) {
        if (g == 0) ((float*)(P.ws + WS_SSQQ))[row * 8 + (nb >> 6)] = ss;
#pragma unroll
        for (int nt = 0; nt < 4; ++nt)
          st_bf4((u16*)(P.ws + WS_QA) + (size_t)row * 384 + nb + nt * 16 + g * 4, acc[mt][nt]);
      } else {
        if (g == 0) ((float*)(P.ws + WS_SSQKV))[row * 4 + ((nb - 384) >> 6)] = ss;
        const int arow = isLat ? (4096 + bl * 1280 + tb + rl) : row;
#pragma unroll
        for (int nt = 0; nt < 4; ++nt) {
          const int c2 = nb - 384 + nt * 16 + g * 4;
          st_bf4((u16*)(P.ws + WS_CKVA) + (size_t)j * CKVA_J + (size_t)arow * 256 + c2, acc[mt][nt]);
          if (!isLat) st_f4((float*)(P.ws + WS_KVRAW) + (size_t)row * 256 + c2, acc[mt][nt]);
        }
      }
    } else if (nb == 640) {
      if (isLat) {
        const int t = tb + rl;
#pragma unroll
        for (int nt = 0; nt < 2; ++nt)
          rope4(acc[mt][nt], acc[mt][nt + 2], ropeC + t * 32 + nt * 16 + g * 4, ropeS + t * 32 + nt * 16 + g * 4);
      }
#pragma unroll
      for (int nt = 0; nt < 4; ++nt) {
        const int d = nt * 16 + g * 4;
        if (!isLat) {
          st_f4(P.out + OUT_KPE + ((size_t)((b * 2 + j) * 256 + sb + rl)) * 64 + d, acc[mt][nt]);
          u16* kd = (u16*)(P.ws + WS_CTXK) + ((size_t)(b * 8) * 256 + sb + rl) * 192 + 128 + d;
#pragma unroll
          for (int h = 0; h < 8; ++h) st_bf4(kd + (size_t)h * 256 * 192, acc[mt][nt]);
        } else {
          u16* kd = (u16*)(P.ws + WS_KMLAT) + (size_t)j * KMLAT_J + ((size_t)(bl * 8) * 1280 + tb + rl) * 192 + 128 + d;
#pragma unroll
          for (int h = 0; h < 8; ++h) st_bf4(kd + (size_t)h * 1280 * 192, acc[mt][nt]);
        }
      }
    } else {
#pragma unroll
      for (int nt = 0; nt < 4; ++nt) {
        f32x4 v = acc[mt][nt];
#pragma unroll
        for (int jj = 0; jj < 4; ++jj) v[jj] = silu(v[jj]);
        st_bf4((u16*)(P.ws + WS_G) + (size_t)row * 1024 + (nb - 704 + nt * 16 + g * 4), v);
      }
    }
  }
}

DEVI void tile_qb(const Params& P, int j, int tile, u16* smem) {
  const int m0 = (tile / 12) * 128, n0 = (tile % 12) * 128;
  const u16* A = (const u16*)(P.ws + WS_QA);
  const u16* B = (const u16*)(P.ws + WS_WQB) + (size_t)j * 1536 * 384;
  f32x4 acc[4][4];
  zero_acc(acc);
  gemm_core<true>(A, 384, B, 384, 384, m0, n0, smem, acc);
  const int lane = tidx() & 63, w = tidx() >> 6, wm = w >> 1, wn = w & 1, g = lane >> 4, li = lane & 15;
  const int mb = m0 + wm * 64, nb = n0 + wn * 64;
  const bool isLat = mb >= 4096;
  const int tb = (mb - 4096) & 1023;
  const float* ropeC = (const float*)(P.ws + WS_ROPE);
  const float* ropeS = ropeC + 1024 * 32;
  const float* ssq = (const float*)(P.ws + WS_SSQQ);
  const bool isRope = (nb % 192) == 128;
  const float qs = 0.07216878364870322f * LOG2E;
#pragma unroll
  for (int mt = 0; mt < 4; ++mt) {
    const int rl = mt * 16 + li, row = mb + rl;
    float ss = 0.f;
#pragma unroll
    for (int i = 0; i < 6; ++i) ss += ssq[row * 8 + i];
    const float r = rsqrtf(ss * (1.f / 384.f) + EPS) * qs;
    if (isRope && isLat) {
      const int t = tb + rl;
#pragma unroll
      for (int nt = 0; nt < 2; ++nt)
        rope4(acc[mt][nt], acc[mt][nt + 2], ropeC + t * 32 + nt * 16 + g * 4, ropeS + t * 32 + nt * 16 + g * 4);
    }
#pragma unroll
    for (int nt = 0; nt < 4; ++nt) {
      f32x4 v = acc[mt][nt] * r;
      st_bf4((u16*)(P.ws + WS_Q) + (size_t)row * 1536 + nb + nt * 16 + g * 4, v);
    }
  }
}

DEVI void tile_kvb(const Params& P, int j, int tile, u16* smem) {
  const int m0 = (tile >> 4) * 128, n0 = (tile & 15) * 128;
  const bool tileLat = m0 >= 4096;
  const bool fresh = !tileLat || ((m0 - 4096) % 1280) < 1024;
  const u16* A = (const u16*)(P.ws + WS_CKVA) + (size_t)j * CKVA_J;
  const u16* B = (const u16*)(P.ws + (fresh ? WS_WKVBG : WS_WKVB)) + (size_t)j * 2048 * 256;
  const bool isV = (n0 >> 7) & 1;
  const int h = n0 >> 8;
  f32x4 acc[4][4];
  zero_acc(acc);
  if (isV) gemm_core<false>(A, 256, B, 256, 256, m0, n0, smem, acc);
  else gemm_core<true>(A, 256, B, 256, 256, m0, n0, smem, acc);
  const int lane = tidx() & 63, w = tidx() >> 6, wm = w >> 1, wn = w & 1, g = lane >> 4, li = lane & 15;
  const int mb = m0 + wm * 64;
  int b, keyb, Sk, tokb;
  u16 *Kd, *Vd;
  if (!tileLat) {
    b = mb >> 8; keyb = mb & 255; Sk = 256; tokb = mb;
    Kd = (u16*)(P.ws + WS_CTXK); Vd = (u16*)(P.ws + WS_VTCTX);
  } else {
    const int r2 = mb - 4096;
    b = r2 / 1280; keyb = r2 % 1280; Sk = 1280; tokb = 4096 + b * 1024 + keyb;
    Kd = (u16*)(P.ws + WS_KMLAT) + (size_t)j * KMLAT_J; Vd = (u16*)(P.ws + WS_VTLATM);
  }
  const float* ssq = (const float*)(P.ws + WS_SSQKV);
  if (!isV) {
#pragma unroll
    for (int mt = 0; mt < 4; ++mt) {
      const int rl = mt * 16 + li;
      float r = 1.f;
      if (fresh) {
        const float4 s4 = *(const float4*)(ssq + (size_t)(tokb + rl) * 4);
        r = rsqrtf((s4.x + s4.y + s4.z + s4.w) * (1.f / 256.f) + EPS);
      }
#pragma unroll
      for (int nt = 0; nt < 4; ++nt) {
        const int dd = wn * 64 + nt * 16 + g * 4;
        st_bf4(Kd + ((size_t)((b * 8 + h) * Sk + keyb + rl)) * 192 + dd, acc[mt][nt] * r);
      }
    }
  } else {
#pragma unroll
    for (int mt = 0; mt < 4; ++mt) {
      const int r0 = mt * 16 + g * 4;
      f32x4 rr = {1.f, 1.f, 1.f, 1.f};
      if (fresh) {
#pragma unroll
        for (int jj = 0; jj < 4; ++jj) {
          const float4 s4 = *(const float4*)(ssq + (size_t)(tokb + r0 + jj) * 4);
          rr[jj] = rsqrtf((s4.x + s4.y + s4.z + s4.w) * (1.f / 256.f) + EPS);
        }
      }
#pragma unroll
      for (int nt = 0; nt < 4; ++nt) {
        const int e = wn * 64 + nt * 16 + li;
        st_bf4(Vd + ((size_t)((b * 8 + h) * 128 + e)) * Sk + keyb + r0, acc[mt][nt] * rr);
      }
    }
  }
}

DEVI void tile_out(const Params& P, int layer, int tile, u16* smem) {
  const int m0 = (tile >> 3) * 128, n0 = (tile & 7) * 128;
  const u16* A = (const u16*)(P.ws + WS_O);
  const u16* B = (const u16*)(P.ws + WS_WOUT) + (size_t)layer * 1024 * 1024;
  f32x4 acc[4][4];
  zero_acc(acc);
  gemm_core<true>(A, 1024, B, 1024, 1024, m0, n0, smem, acc);
  const int lane = tidx() & 63, w = tidx() >> 6, wm = w >> 1, wn = w & 1, g = lane >> 4, li = lane & 15;
  const int mb = m0 + wm * 64, nb = n0 + wn * 64;
  float* T = (float*)(P.ws + WS_T);
#pragma unroll
  for (int mt = 0; mt < 4; ++mt)
#pragma unroll
    for (int nt = 0; nt < 4; ++nt)
      st_f4(T + (size_t)(mb + mt * 16 + li) * 1024 + nb + nt * 16 + g * 4, acc[mt][nt]);
}

template <bool DIFF>
DEVI void attn_item(const Params& P, const u16* __restrict__ Qb, int ldq, int qrow0,
                    const u16* __restrict__ Kb, int ldk, const u16* __restrict__ Vt, int Sk,
                    int h, float lam, float lam_init, const float* gsub, u16* smem) {
  constexpr int KW = DIFF ? 128 : 192;
  constexpr int KLD = KW + 8;
  constexpr int NKK = DIFF ? 2 : 6;
  constexpr int KCH = KW / 8;
  constexpr int NKL = (64 * KCH) / 256;
  constexpr int VLD = 72;
  u16* Ks = smem;
  u16* Vs = smem + 64 * KLD;
  const int tid = tidx(), lane = tid & 63, w = tid >> 6, g = lane >> 4, li = lane & 15;

  bf16x8 qf[2][NKK];
#pragma unroll
  for (int s = 0; s < 2; ++s) {
    const int qrow = DIFF ? (qrow0 + w * 16 + li) : (qrow0 + w * 32 + s * 16 + li);
    const int qcol = DIFF ? (h * 128 + s * 64) : (h * 192);
#pragma unroll
    for (int kk = 0; kk < NKK; ++kk)
      qf[s][kk] = *(const bf16x8*)(Qb + (size_t)qrow * ldq + qcol + kk * 32 + g * 8);
  }
  f32x4 oacc[2][8];
#pragma unroll
  for (int s = 0; s < 2; ++s)
#pragma unroll
    for (int et = 0; et < 8; ++et) oacc[s][et] = (f32x4){0.f, 0.f, 0.f, 0.f};
  float mrow[2] = {-1e30f, -1e30f}, lrow[2] = {0.f, 0.f};

  u32x4 rk[NKL], rv[4];
  auto gload = [&](int key0) {
#pragma unroll
    for (int i = 0; i < NKL; ++i) {
      const int c = tid + 256 * i, r = c / KCH, cc = c % KCH;
      rk[i] = *(const u32x4*)(Kb + (size_t)(key0 + r) * ldk + cc * 8);
    }
#pragma unroll
    for (int i = 0; i < 4; ++i) {
      const int c = tid + 256 * i, r = c >> 3, cc = c & 7;
      rv[i] = *(const u32x4*)(Vt + (size_t)r * Sk + key0 + cc * 8);
    }
  };
  gload(0);
  const int NT = Sk >> 6;
  for (int kt0 = 0; kt0 < NT; ++kt0) {
    __syncthreads();
#pragma unroll
    for (int i = 0; i < NKL; ++i) {
      const int c = tid + 256 * i, r = c / KCH, cc = c % KCH;
      *(u32x4*)(Ks + r * KLD + cc * 8) = rk[i];
    }
#pragma unroll
    for (int i = 0; i < 4; ++i) {
      const int c = tid + 256 * i, r = c >> 3, cc = c & 7;
      *(u32x4*)(Vs + r * VLD + cc * 8) = rv[i];
    }
    __syncthreads();
    if (kt0 + 1 < NT) gload((kt0 + 1) << 6);

    f32x4 st[2][4];
#pragma unroll
    for (int s = 0; s < 2; ++s)
#pragma unroll
      for (int kt = 0; kt < 4; ++kt) st[s][kt] = (f32x4){0.f, 0.f, 0.f, 0.f};
#pragma unroll
    for (int kk = 0; kk < NKK; ++kk) {
#pragma unroll
      for (int kt = 0; kt < 4; ++kt) {
        if (DIFF) {
#pragma unroll
          for (int s = 0; s < 2; ++s) {
            const bf16x8 kf = *(const bf16x8*)(Ks + (kt * 16 + li) * KLD + s * 64 + kk * 32 + g * 8);
            st[s][kt] = mfma16(kf, qf[s][kk], st[s][kt]);
          }
        } else {
          const bf16x8 kf = *(const bf16x8*)(Ks + (kt * 16 + li) * KLD + kk * 32 + g * 8);
#pragma unroll
          for (int s = 0; s < 2; ++s) st[s][kt] = mfma16(kf, qf[s][kk], st[s][kt]);
        }
      }
    }
    bf16x8 pf[2][2];
#pragma unroll
    for (int s = 0; s < 2; ++s) {
      float mx = st[s][0][0];
#pragma unroll
      for (int kt = 0; kt < 4; ++kt)
#pragma unroll
        for (int jj = 0; jj < 4; ++jj) mx = fmaxf(mx, st[s][kt][jj]);
      mx = fmaxf(mx, xshfl(mx, 16));
      mx = fmaxf(mx, xshfl(mx, 32));
      const float mnew = fmaxf(mrow[s], mx);
      const float alpha = exp2f(mrow[s] - mnew);
      mrow[s] = mnew;
      float ps = 0.f;
#pragma unroll
      for (int kt = 0; kt < 4; ++kt)
#pragma unroll
        for (int jj = 0; jj < 4; ++jj) {
          const float p = exp2f(st[s][kt][jj] - mnew);
          st[s][kt][jj] = p;
          ps += p;
        }
      lrow[s] = lrow[s] * alpha + ps;
#pragma unroll
      for (int et = 0; et < 8; ++et) oacc[s][et] *= alpha;
#pragma unroll
      for (int u = 0; u < 2; ++u) {
        union { bf16x8 v; unsigned d[4]; } pu;
        pu.d[0] = pk2(st[s][2 * u][0], st[s][2 * u][1]);
        pu.d[1] = pk2(st[s][2 * u][2], st[s][2 * u][3]);
        pu.d[2] = pk2(st[s][2 * u + 1][0], st[s][2 * u + 1][1]);
        pu.d[3] = pk2(st[s][2 * u + 1][2], st[s][2 * u + 1][3]);
        pf[s][u] = pu.v;
      }
    }
#pragma unroll
    for (int u = 0; u < 2; ++u) {
#pragma unroll
      for (int et = 0; et < 8; ++et) {
        union { bf16x8 v; u32x2 d[2]; } vu;
        vu.d[0] = *(const u32x2*)(Vs + (et * 16 + li) * VLD + (2 * u) * 16 + g * 4);
        vu.d[1] = *(const u32x2*)(Vs + (et * 16 + li) * VLD + (2 * u + 1) * 16 + g * 4);
#pragma unroll
        for (int s = 0; s < 2; ++s) oacc[s][et] = mfma16(vu.v, pf[s][u], oacc[s][et]);
      }
    }
  }
#pragma unroll
  for (int s = 0; s < 2; ++s) {
    lrow[s] += xshfl(lrow[s], 16);
    lrow[s] += xshfl(lrow[s], 32);
  }
  const u16* G = (const u16*)(P.ws + WS_G);
  u16* O = (u16*)(P.ws + WS_O);
  if (DIFF) {
    const float i0 = 1.f / lrow[0], i1 = lam / lrow[1];
    float ss = 0.f;
#pragma unroll
    for (int et = 0; et < 8; ++et) {
      oacc[0][et] = oacc[0][et] * i0 - oacc[1][et] * i1;
#pragma unroll
      for (int jj = 0; jj < 4; ++jj) ss += oacc[0][et][jj] * oacc[0][et][jj];
    }
    ss += xshfl(ss, 16);
    ss += xshfl(ss, 32);
    const float rr = rsqrtf(ss * (1.f / 128.f) + EPS) * (1.f - lam_init);
    const size_t tok = (size_t)(qrow0 + w * 16 + li);
#pragma unroll
    for (int et = 0; et < 8; ++et) {
      const int e = et * 16 + g * 4;
      const float4 gs = *(const float4*)(gsub + e);
      const uint2 gg = *(const uint2*)(G + tok * 1024 + h * 128 + e);
      f32x4 v = oacc[0][et] * rr;
      v[0] *= gs.x * bf2f(gg.x & 0xffffu);
      v[1] *= gs.y * bf2f(gg.x >> 16);
      v[2] *= gs.z * bf2f(gg.y & 0xffffu);
      v[3] *= gs.w * bf2f(gg.y >> 16);
      st_bf4(O + tok * 1024 + h * 128 + e, v);
    }
  } else {
#pragma unroll
    for (int s = 0; s < 2; ++s) {
      const float inv = 1.f / lrow[s];
      const size_t tok = (size_t)(qrow0 + w * 32 + s * 16 + li);
#pragma unroll
      for (int et = 0; et < 8; ++et) {
        const int e = et * 16 + g * 4;
        const uint2 gg = *(const uint2*)(G + tok * 1024 + h * 128 + e);
        f32x4 v = oacc[s][et] * inv;
        v[0] *= bf2f(gg.x & 0xffffu);
        v[1] *= bf2f(gg.x >> 16);
        v[2] *= bf2f(gg.y & 0xffffu);
        v[3] *= bf2f(gg.y >> 16);
        st_bf4(O + tok * 1024 + h * 128 + e, v);
      }
    }
  }
}

DEVI void attn_diff_phase(const Params& P, int j, u16* smem) {
  const float* lamv = (const float*)(P.ws + WS_MISC);
  const float lam = lamv[j * 2], lam_init = lamv[j * 2 + 1];
  const float* gsub = P.in[I_GSUB] + j * 128;
  const u16* Q = (const u16*)(P.ws + WS_Q);
  for (int it = blockIdx.x; it < 1024; it += gridDim.x) {
    if (it < 512) {
      const int bl = it >> 7, h = (it >> 4) & 7, qt = it & 15;
      const u16* Kb = (const u16*)(P.ws + WS_KDLAT) + (size_t)j * KDLAT_J + (size_t)bl * 1280 * 1024 + h * 128;
      const u16* Vt = (const u16*)(P.ws + WS_VTLATD) + (size_t)j * VTLATD_J + (size_t)(bl * 8 + h) * 128 * 1280;
      attn_item<true>(P, Q, 1024, 4096 + bl * 1024 + qt * 64, Kb, 1024, Vt, 1280, h, lam, lam_init, gsub, smem);
    } else {
      const int i2 = it - 512, b = i2 >> 5, h = (i2 >> 2) & 7, qt = i2 & 3;
      const u16* Kb = (const u16*)(P.ws + WS_CTXK) + (size_t)b * 256 * 1024 + h * 128;
      const u16* Vt = (const u16*)(P.ws + WS_VTCTX) + (size_t)(b * 8 + h) * 128 * 256;
      attn_item<true>(P, Q, 1024, b * 256 + qt * 64, Kb, 1024, Vt, 256, h, lam, lam_init, gsub, smem);
    }
  }
}

DEVI void attn_mla_phase(const Params& P, int j, u16* smem) {
  const u16* Q = (const u16*)(P.ws + WS_Q);
  for (int it = blockIdx.x; it < 512; it += gridDim.x) {
    if (it < 256) {
      const int bl = it >> 6, h = (it >> 3) & 7, qt = it & 7;
      const u16* Kb = (const u16*)(P.ws + WS_KMLAT) + (size_t)j * KMLAT_J + (size_t)(bl * 8 + h) * 1280 * 192;
      const u16* Vt = (const u16*)(P.ws + WS_VTLATM) + (size_t)(bl * 8 + h) * 128 * 1280;
      attn_item<false>(P, Q, 1536, 4096 + bl * 1024 + qt * 128, Kb, 192, Vt, 1280, h, 0.f, 0.f, nullptr, smem);
    } else {
      const int i2 = it - 256, b = i2 >> 4, h = (i2 >> 1) & 7, qt = i2 & 1;
      const u16* Kb = (const u16*)(P.ws + WS_CTXK) + (size_t)(b * 8 + h) * 256 * 192;
      const u16* Vt = (const u16*)(P.ws + WS_VTCTX) + (size_t)(b * 8 + h) * 128 * 256;
      attn_item<false>(P, Q, 1536, b * 256 + qt * 128, Kb, 192, Vt, 256, h, 0.f, 0.f, nullptr, smem);
    }
  }
}

DEVI float wave_sum(float v) {
  v += xshfl(v, 1); v += xshfl(v, 2); v += xshfl(v, 4); v += xshfl(v, 8); v += xshfl(v, 16); v += xshfl(v, 32);
  return v;
}

DEVI void ew_phase(const Params& P, int layer) {
  const int lane = tidx() & 63, w = tidx() >> 6;
  const float* ada = (const float*)(P.ws + WS_ADA);
  const float* T = (const float*)(P.ws + WS_T);
  u16* H = (u16*)(P.ws + WS_H);
  for (int row = blockIdx.x * 4 + w; row < 8192; row += gridDim.x * 4) {
    const int cond = row < 4096 ? 0 : 1 + ((row - 4096) >> 10);
    const float* xsrc = (layer <= 0) ? (row < 4096 ? P.in[I_XP] + (size_t)row * 1024 : P.in[I_XS] + (size_t)(row - 4096) * 1024)
                                     : P.out + OUT_Y + (size_t)row * 1024;
    float4 x[4];
#pragma unroll
    for (int i = 0; i < 4; ++i) x[i] = *(const float4*)(xsrc + lane * 4 + i * 256);
    if (layer >= 0) {
      float4 t[4];
      float ss = 0.f;
#pragma unroll
      for (int i = 0; i < 4; ++i) {
        t[i] = *(const float4*)(T + (size_t)row * 1024 + lane * 4 + i * 256);
        ss += t[i].x * t[i].x + t[i].y * t[i].y + t[i].z * t[i].z + t[i].w * t[i].w;
      }
      ss = wave_sum(ss);
      const float rt = rsqrtf(ss * (1.f / 1024.f) + EPS);
      const float* gate = ada + (size_t)(layer * 5 + cond) * 3072 + 2048;
      const float* gp = P.in[I_GPOST] + layer * 1024;
#pragma unroll
      for (int i = 0; i < 4; ++i) {
        const int c = lane * 4 + i * 256;
        const float4 ga = *(const float4*)(gate + c);
        const float4 gq = *(const float4*)(gp + c);
        x[i].x += ga.x * (t[i].x * rt * gq.x);
        x[i].y += ga.y * (t[i].y * rt * gq.y);
        x[i].z += ga.z * (t[i].z * rt * gq.z);
        x[i].w += ga.w * (t[i].w * rt * gq.w);
        *(float4*)(P.out + OUT_Y + (size_t)row * 1024 + c) = x[i];
      }
    }
    const int nl = layer + 1;
    if (nl < 4) {
      float ss = 0.f;
#pragma unroll
      for (int i = 0; i < 4; ++i) ss += x[i].x * x[i].x + x[i].y * x[i].y + x[i].z * x[i].z + x[i].w * x[i].w;
      ss = wave_sum(ss);
      const float rx = rsqrtf(ss * (1.f / 1024.f) + EPS);
      const float* sh = ada + (size_t)(nl * 5 + cond) * 3072;
      const float* sc = sh + 1024;
      const float* gpre = P.in[I_GPRE] + nl * 1024;
#pragma unroll
      for (int i = 0; i < 4; ++i) {
        const int c = lane * 4 + i * 256;
        const float4 s1 = *(const float4*)(sh + c);
        const float4 s2 = *(const float4*)(sc + c);
        const float4 gq = *(const float4*)(gpre + c);
        f32x4 hv;
        hv[0] = x[i].x * rx * gq.x * (1.f + s2.x) + s1.x;
        hv[1] = x[i].y * rx * gq.y * (1.f + s2.y) + s1.y;
        hv[2] = x[i].z * rx * gq.z * (1.f + s2.z) + s1.z;
        hv[3] = x[i].w * rx * gq.w * (1.f + s2.w) + s1.w;
        st_bf4(H + (size_t)row * 1024 + c, hv);
      }
    }
  }
}

DEVI void tr_tile(const float* __restrict__ src, int lds, int k0, int n0, int nvalid, u16* __restrict__ dst, int ldd,
                  const float* kscale, float* tile) {
  const int tid = tidx();
  __syncthreads();
#pragma unroll
  for (int i = 0; i < 16; ++i) {
    const int idx = tid + 256 * i, kk = idx >> 6, nn = idx & 63;
    float v = (n0 + nn < nvalid) ? src[(size_t)(k0 + kk) * lds + n0 + nn] : 0.f;
    if (kscale) v *= kscale[k0 + kk];
    tile[kk * 65 + nn] = v;
  }
  __syncthreads();
#pragma unroll
  for (int i = 0; i < 8; ++i) {
    const int idx = tid + 256 * i, nn = idx >> 5, kp = (idx & 31) * 2;
    *(unsigned*)(dst + (size_t)(n0 + nn) * ldd + k0 + kp) = pk2(tile[kp * 65 + nn], tile[(kp + 1) * 65 + nn]);
  }
}

constexpr int N_ADA = 384;
constexpr int N_TWOUT = 1024, N_TDAIN = 2048, N_TMLAIN = 896, N_TQB = 288, N_TKVB = 256, N_TCV = 512;
constexpr int N_ROPE = 128, N_LAM = 1, N_CDK = 1024, N_CCKV = 256, N_CKPE = 64;
constexpr int P0_ITEMS = N_ADA + N_TWOUT + N_TDAIN + N_TMLAIN + N_TQB + N_TKVB + N_TCV + N_ROPE + N_LAM + N_CDK + N_CCKV + N_CKPE;

DEVI void prep_phase(const Params& P, u16* smem) {
  float* fs = (float*)smem;
  const int tid = tidx();
  for (int item = blockIdx.x; item < P0_ITEMS; item += gridDim.x) {
    int it = item;
    if (it < N_ADA) {
      const int layer = it / 96, cgp = it % 96;
      float* sc = fs;
      float* red = fs + 5120;
      __syncthreads();
      for (int idx = tid; idx < 5120; idx += 256) {
        const int cnd = idx >> 10, k = idx & 1023;
        const float v = cnd == 0 ? P.in[I_CCTX][k] : P.in[I_C][(cnd - 1) * 1024 + k];
        sc[idx] = silu(v);
      }
      __syncthreads();
      const int col = tid & 31, kg = tid >> 5;
      const float* wp = P.in[I_WADA] + (size_t)layer * 1024 * 3072 + cgp * 32 + col;
      float a0 = 0.f, a1 = 0.f, a2 = 0.f, a3 = 0.f, a4 = 0.f;
#pragma unroll 8
      for (int k = kg * 128; k < kg * 128 + 128; ++k) {
        const float wv = wp[(size_t)k * 3072];
        a0 += sc[k] * wv; a1 += sc[1024 + k] * wv; a2 += sc[2048 + k] * wv; a3 += sc[3072 + k] * wv; a4 += sc[4096 + k] * wv;
      }
      red[(kg * 5 + 0) * 32 + col] = a0; red[(kg * 5 + 1) * 32 + col] = a1; red[(kg * 5 + 2) * 32 + col] = a2;
      red[(kg * 5 + 3) * 32 + col] = a3; red[(kg * 5 + 4) * 32 + col] = a4;
      __syncthreads();
      if (tid < 160) {
        const int cnd = tid >> 5, c2 = tid & 31;
        float s = P.in[I_BADA][layer * 3072 + cgp * 32 + c2];
#pragma unroll
        for (int q = 0; q < 8; ++q) s += red[(q * 5 + cnd) * 32 + c2];
        ((float*)(P.ws + WS_ADA))[(size_t)(layer * 5 + cnd) * 3072 + cgp * 32 + c2] = s;
      }
      continue;
    }
    it -= N_ADA;
    if (it < N_TWOUT) {
      const int l = it >> 8, kt = (it >> 4) & 15, nt = it & 15;
      tr_tile(P.in[I_WOUT] + (size_t)l * 1024 * 1024, 1024, kt * 64, nt * 64, 1024,
              (u16*)(P.ws + WS_WOUT) + (size_t)l * 1024 * 1024, 1024, nullptr, fs);
      continue;
    }
    it -= N_TWOUT;
    if (it < N_TDAIN) {
      const int l = it >> 10, kt = (it >> 6) & 15, nt = it & 63;
      tr_tile(P.in[I_DAWIN] + (size_t)l * 1024 * 4096, 4096, kt * 64, nt * 64, 4096,
              (u16*)(P.ws + WS_WDAIN) + (size_t)l * 4096 * 1024, 1024, nullptr, fs);
      continue;
    }
    it -= N_TDAIN;
    if (it < N_TMLAIN) {
      const int l = it / 448, r = it % 448, kt = r / 28, nt = r % 28;
      tr_tile(P.in[I_MWIN] + (size_t)l * 1024 * 1728, 1728, kt * 64, nt * 64, 1728,
              (u16*)(P.ws + WS_WMLAIN) + (size_t)l * 1792 * 1024, 1024, nullptr, fs);
      continue;
    }
    it -= N_TMLAIN;
    if (it < N_TQB) {
      const int l = it / 144, r = it % 144, kt = r / 24, nt = r % 24;
      tr_tile(P.in[I_WQB] + (size_t)l * 384 * 1536, 1536, kt * 64, nt * 64, 1536,
              (u16*)(P.ws + WS_WQB) + (size_t)l * 1536 * 384, 384, P.in[I_GQA] + l * 384, fs);
      continue;
    }
    it -= N_TQB;
    if (it < N_TKVB) {
      const int l = it >> 7, kt = (it >> 5) & 3, nt = it & 31;
      tr_tile(P.in[I_WKVB] + (size_t)l * 256 * 2048, 2048, kt * 64, nt * 64, 2048,
              (u16*)(P.ws + WS_WKVB) + (size_t)l * 2048 * 256, 256, nullptr, fs);
      tr_tile(P.in[I_WKVB] + (size_t)l * 256 * 2048, 2048, kt * 64, nt * 64, 2048,
              (u16*)(P.ws + WS_WKVBG) + (size_t)l * 2048 * 256, 256, P.in[I_GKVA] + l * 256, fs);
      continue;
    }
    it -= N_TKVB;
    if (it < N_TCV) {
      const int grp = it >> 3, sub = it & 7, bl = grp >> 4, jj = (grp >> 3) & 1, h = grp & 7, pt = sub >> 1, et = sub & 1;
      const float* src = P.in[I_CDV] + ((size_t)(bl * 2 + jj) * 256) * 1024 + h * 128;
      u16* dst = (u16*)(P.ws + WS_VTLATD) + (size_t)jj * VTLATD_J + (size_t)(bl * 8 + h) * 128 * 1280 + 1024;
      tr_tile(src, 1024, pt * 64, et * 64, 128, dst, 1280, nullptr, fs);
      continue;
    }
    it -= N_TCV;
    if (it < N_ROPE) {
      const int idx = it * 256 + tid, t = idx >> 5, p = idx & 31, f = p & 15;
      const float inv = exp2f(-(float)f * (13.287712379549449f / 16.f));
      const float pos = (p < 16) ? (float)(t >> 6) : (float)(t & 63);
      float sn, cs;
      sincosf(pos * inv, &sn, &cs);
      float* rc = (float*)(P.ws + WS_ROPE);
      rc[idx] = cs;
      rc[1024 * 32 + idx] = sn;
      continue;
    }
    it -= N_ROPE;
    if (it < N_LAM) {
      if (tid < 2) {
        const int jd = tid;
        float s1 = 0.f, s2 = 0.f;
        for (int d = 0; d < 64; ++d) {
          s1 += P.in[I_LQ1][jd * 64 + d] * P.in[I_LK1][jd * 64 + d];
          s2 += P.in[I_LQ2][jd * 64 + d] * P.in[I_LK2][jd * 64 + d];
        }
        const float li = 0.8f - 0.6f * expf(-0.3f * (float)(2 * jd));
        float* lamv = (float*)(P.ws + WS_MISC);
        lamv[jd * 2] = expf(s1) - expf(s2) + li;
        lamv[jd * 2 + 1] = li;
      }
      continue;
    }
    it -= N_LAM;
    if (it < N_CDK) {
      const size_t e0 = ((size_t)it * 256 + tid) * 8;
      const int col = e0 & 1023, p = (e0 >> 10) & 255, jj = (e0 >> 18) & 1, bl = (int)(e0 >> 19);
      const float4 a = *(const float4*)(P.in[I_CDK] + e0);
      const float4 b = *(const float4*)(P.in[I_CDK] + e0 + 4);
      uint4 u; u.x = pk2(a.x, a.y); u.y = pk2(a.z, a.w); u.z = pk2(b.x, b.y); u.w = pk2(b.z, b.w);
      *(uint4*)((u16*)(P.ws + WS_KDLAT) + (size_t)jj * KDLAT_J + ((size_t)(bl * 1280 + 1024 + p)) * 1024 + col) = u;
      continue;
    }
    it -= N_CDK;
    if (it < N_CCKV) {
      const size_t e0 = ((size_t)it * 256 + tid) * 8;
      const int col = e0 & 255, p = (e0 >> 8) & 255, jj = (e0 >> 16) & 1, bl = (int)(e0 >> 17);
      const float4 a = *(const float4*)(P.in[I_CCKV] + e0);
      const float4 b = *(const float4*)(P.in[I_CCKV] + e0 + 4);
      uint4 u; u.x = pk2(a.x, a.y); u.y = pk2(a.z, a.w); u.z = pk2(b.x, b.y); u.w = pk2(b.z, b.w);
      *(uint4*)((u16*)(P.ws + WS_CKVA) + (size_t)jj * CKVA_J + ((size_t)(4096 + bl * 1280 + 1024 + p)) * 256 + col) = u;
      continue;
    }
    it -= N_CCKV;
    {
      const size_t e0 = ((size_t)it * 256 + tid) * 8;
      const int d = e0 & 63, p = (e0 >> 6) & 255, jj = (e0 >> 14) & 1, bl = (int)(e0 >> 15);
      const float4 a = *(const float4*)(P.in[I_CKPE] + e0);
      const float4 b = *(const float4*)(P.in[I_CKPE] + e0 + 4);
      uint4 u; u.x = pk2(a.x, a.y); u.y = pk2(a.z, a.w); u.z = pk2(b.x, b.y); u.w = pk2(b.z, b.w);
      u16* dst = (u16*)(P.ws + WS_KMLAT) + (size_t)jj * KMLAT_J + ((size_t)(bl * 8) * 1280 + 1024 + p) * 192 + 128 + d;
#pragma unroll
      for (int h = 0; h < 8; ++h) *(uint4*)(dst + (size_t)h * 1280 * 192) = u;
    }
  }
}

DEVI void mla_b_phase(const Params& P, int j, u16* smem) {
  constexpr int NQ = 64 * 12, NKV = 72 * 16, NNORM = 64;
  for (int it = blockIdx.x; it < NKV + NQ + NNORM; it += gridDim.x) {
    if (it < NKV) tile_kvb(P, j, it, smem);
    else if (it < NKV + NQ) tile_qb(P, j, it - NKV, smem);
    else {
      const int lane = tidx() & 63, w = tidx() >> 6;
      const float* ssq = (const float*)(P.ws + WS_SSQKV);
      const float4 gk = *(const float4*)(P.in[I_GKVA] + j * 256 + lane * 4);
      for (int r = w; r < 64; r += 4) {
        const int row = (it - NKV - NQ) * 64 + r;
        const float4 s4 = *(const float4*)(ssq + (size_t)row * 4);
        const float rr = rsqrtf((s4.x + s4.y + s4.z + s4.w) * (1.f / 256.f) + EPS);
        float* p = P.out + OUT_CKV + ((size_t)(((row >> 8) * 2 + j) * 256 + (row & 255))) * 256 + lane * 4;
        float4 v = *(const float4*)((const float*)(P.ws + WS_KVRAW) + (size_t)row * 256 + lane * 4);
        v.x *= rr * gk.x; v.y *= rr * gk.y; v.z *= rr * gk.z; v.w *= rr * gk.w;
        *(float4*)p = v;
      }
    }
  }
}


#define XB_TMO      128
#define XB_XCNT(j)  (256  + 64 * (j))
#define XB_XSUB(j)  (1280 + 64 * (j))
#define XB_XGEN(j)  (2304 + 64 * (j))
#define XB_TOP      3328
#define XB_TOPGEN   3392
#define XCD_BAR_WORDS 3456
#define XB_SPIN_CAP (1u << 22)
#define LAS __attribute__((address_space(3)))
DEVI unsigned xb_ld(unsigned* p) { return __hip_atomic_load(p, __ATOMIC_RELAXED, __HIP_MEMORY_SCOPE_AGENT); }
DEVI unsigned xb_add(unsigned* p, unsigned v) { return __hip_atomic_fetch_add(p, v, __ATOMIC_RELAXED, __HIP_MEMORY_SCOPE_AGENT); }
DEVI unsigned xb_xcc_id() { return (unsigned)__builtin_amdgcn_s_getreg((3 << 11) | 20) & 0xFu; }
#define XB_SPIN(cond, bar) do { unsigned _sp = 0; while (cond) { __builtin_amdgcn_s_sleep(1); \
    if ((++_sp & 255u) == 0u) { if (xb_ld(&(bar)[XB_TMO])) break; if (_sp > XB_SPIN_CAP) { atomicAdd(&(bar)[XB_TMO], 1u); break; } } } } while (0)
struct XcdBarrier { unsigned* bar; unsigned x; volatile LAS unsigned* st; };
DEVI XcdBarrier xcd_barrier_post(unsigned* bar, volatile LAS unsigned* st) {
  XcdBarrier b; b.bar = bar; b.x = xb_xcc_id(); b.st = st;
  if (threadIdx.x == 0) (void)xb_add(&bar[XB_XCNT(b.x)], 1u);
  return b;
}
DEVI void xcd_barrier_complete(unsigned* bar, unsigned x, unsigned& nloc, unsigned& nx) {
  const unsigned G = gridDim.x * gridDim.y * gridDim.z;
  unsigned sum, cnt, mine, sp = 0u;
  for (;;) {
    sum = 0u; cnt = 0u; mine = 0u;
#pragma unroll
    for (unsigned j = 0; j < 16; ++j) { const unsigned c = xb_ld(&bar[XB_XCNT(j)]); sum += c; cnt += (c > 0u) ? 1u : 0u; mine = (j == x) ? c : mine; }
    if (sum == G) break;
    __builtin_amdgcn_s_sleep(1);
    if ((++sp & 255u) == 0u) { if (xb_ld(&bar[XB_TMO])) break; if (sp > XB_SPIN_CAP) { atomicAdd(&bar[XB_TMO], 1u); break; } }
  }
  nloc = mine > 0u ? mine : 1u; nx = cnt > 0u ? cnt : 1u;
}
DEVI void xcd_barrier(const XcdBarrier& b) {
  asm volatile("s_waitcnt vmcnt(0)" ::: "memory");
  __syncthreads();
  if (threadIdx.x == 0) {
    unsigned* bar = b.bar;
    __builtin_amdgcn_s_waitcnt(0);
    unsigned nloc = b.st[0], nx = b.st[1];
    if (nloc == 0u) { xcd_barrier_complete(bar, b.x, nloc, nx); b.st[0] = nloc; b.st[1] = nx; }
    const unsigned old = xb_add(&bar[XB_XSUB(b.x)], 1u);
    const unsigned gen = old / nloc;
    if (old + 1u == (gen + 1u) * nloc) {
      __builtin_amdgcn_fence(__ATOMIC_RELEASE, "agent");
      asm volatile("s_waitcnt vmcnt(0)" ::: "memory");
      const unsigned og = xb_add(&bar[XB_TOP], 1u);
      const unsigned tg = og / nx;
      if (og + 1u == (tg + 1u) * nx) xb_add(&bar[XB_TOPGEN], 1u);
      else XB_SPIN(xb_ld(&bar[XB_TOPGEN]) == tg, bar);
      __builtin_amdgcn_fence(__ATOMIC_ACQUIRE, "agent");
      xb_add(&bar[XB_XGEN(b.x)], 1u);
      asm volatile("s_waitcnt vmcnt(0)" ::: "memory");
    } else {
      XB_SPIN(xb_ld(&bar[XB_XGEN(b.x)]) == gen, bar);
      __builtin_amdgcn_fence(__ATOMIC_ACQUIRE, "agent");
      asm volatile("s_waitcnt vmcnt(0)" ::: "memory");
    }
  }
  __syncthreads();
}
constexpr size_t WS_BAR = WS_MISC + 65536;

#ifndef EN
#define EN 0xFF
#endif
DEVI void run_phase(const Params& P, int ph, u16* smem) {
  if (ph == 0) { if (EN & 1) prep_phase(P, smem); return; }
  if (ph == 1) { if (EN & 2) ew_phase(P, -1); return; }
  int layer, sub;
  if (ph < 6) { layer = 0; sub = ph - 2; }
  else if (ph < 11) { layer = 1; sub = ph - 6; }
  else if (ph < 15) { layer = 2; sub = ph - 11; }
  else { layer = 3; sub = ph - 15; }
  const int j = layer >> 1;
  if ((layer & 1) == 0) {
    if (sub == 0) { if (EN & 4) for (int t = blockIdx.x; t < 64 * 32; t += gridDim.x) tile_diff_in(P, j, t, smem); }
    else if (sub == 1) { if (EN & 8) attn_diff_phase(P, j, smem); }
    else if (sub == 2) { if (EN & 16) for (int t = blockIdx.x; t < 64 * 8; t += gridDim.x) tile_out(P, layer, t, smem); }
    else { if (EN & 2) ew_phase(P, layer); }
  } else {
    if (sub == 0) { if (EN & 32) for (int t = blockIdx.x; t < 64 * 14; t += gridDim.x) tile_mla_in(P, j, t, smem); }
    else if (sub == 1) { if (EN & 64) mla_b_phase(P, j, smem); }
    else if (sub == 2) { if (EN & 128) attn_mla_phase(P, j, smem); }
    else if (sub == 3) { if (EN & 16) for (int t = blockIdx.x; t < 64 * 8; t += gridDim.x) tile_out(P, layer, t, smem); }
    else { if (EN & 2) ew_phase(P, layer); }
  }
}

constexpr int N_PHASES = 20;

__global__ void __launch_bounds__(256) fwd_megakernel(Params P) {
  __shared__ __attribute__((aligned(16))) u16 smem[SMEM_BYTES / 2];
  __shared__ uint4 xb_words;
  if (threadIdx.x == 0) xb_words = make_uint4(0u, 0u, 0u, 0u);
  __syncthreads();
  XcdBarrier xb = xcd_barrier_post((unsigned*)(P.ws + WS_BAR), (volatile LAS unsigned*)&xb_words);
  for (int ph = P.ph_lo; ph < P.ph_hi; ++ph) {
    Params Pl = P;
    asm volatile("" : "+s"(Pl.ws), "+s"(Pl.out));
    run_phase(Pl, ph, smem);
    if (ph + 1 < P.ph_hi) {
      if (ph == 0) cg::this_grid().sync();
      else xcd_barrier(xb);
    }
#ifdef EXTRA_SYNCS
    for (int q = 0; q < EXTRA_SYNCS; ++q) xcd_barrier(xb);
#endif
  }
}

extern "C" void kernel_launch(void* const* d_in, const int* in_sizes, int n_in, void* d_out, int out_size, void* d_ws,
                              size_t ws_size, hipStream_t stream) {
  static int grid_blocks = 0;
  if (!grid_blocks) {
    int dev = 0, cus = 0, per_cu = 0;
    (void)hipGetDevice(&dev);
    (void)hipDeviceGetAttribute(&cus, hipDeviceAttributeMultiprocessorCount, dev);
    (void)hipOccupancyMaxActiveBlocksPerMultiprocessor(&per_cu, fwd_megakernel, 256, 0);
    if (per_cu < 1) per_cu = 1;
    if (per_cu > 2) per_cu = 2;
    grid_blocks = cus * per_cu;
  }
  if (hipMemsetAsync((unsigned char*)d_ws + WS_BAR, 0, 16384, stream) != hipSuccess) { fprintf(stderr, "memset failed\n"); return; }
  Params p{};
  for (int i = 0; i < 24; ++i) p.in[i] = (const float*)d_in[i];
  p.out = (float*)d_out;
  p.ws = (unsigned char*)d_ws;
#if MULTI_LAUNCH
  for (int ph = 0; ph < N_PHASES; ++ph) {
    p.ph_lo = ph; p.ph_hi = ph + 1;
    hipLaunchKernelGGL(fwd_megakernel, dim3(grid_blocks), dim3(256), 0, stream, p);
  }
#else
  p.ph_lo = 0; p.ph_hi = N_PHASES;
  void* args[] = {&p};
  hipError_t e = hipLaunchCooperativeKernel((void*)fwd_megakernel, dim3(grid_blocks), dim3(256), args, 0, stream);
  if (e != hipSuccess) fprintf(stderr, "cooperative launch failed: %s (grid %d)\n", hipGetErrorString(e), grid_blocks);
#endif
}
```

```cpp
#include <hip/hip_runtime.h>
#include <hip/hip_cooperative_groups.h>
#include <cstdio>
namespace cg = cooperative_groups;

#ifndef MULTI_LAUNCH
#define MULTI_LAUNCH 0
#endif

typedef unsigned short u16;
typedef __attribute__((ext_vector_type(8))) short bf16x8;
typedef __attribute__((ext_vector_type(4))) float f32x4;
typedef __attribute__((ext_vector_type(4))) unsigned u32x4;
typedef __attribute__((ext_vector_type(2))) unsigned u32x2;

#define DEVI __device__ __forceinline__

struct Params {
  const float* in[24];
  float* out;
  unsigned char* ws;
  int ph_lo, ph_hi;
};

constexpr size_t MBy = 1u << 20;
constexpr size_t WS_WOUT = 0;
constexpr size_t WS_WDAIN = 8 * MBy;
constexpr size_t WS_WMLAIN = 24 * MBy;
constexpr size_t WS_WQB = 31 * MBy;
constexpr size_t WS_WKVB = 34 * MBy;
constexpr size_t WS_WKVBG = 36 * MBy;
constexpr size_t WS_ADA = 38 * MBy;
constexpr size_t WS_ROPE = 39 * MBy;
constexpr size_t WS_MISC = 40 * MBy;
constexpr size_t WS_H = 41 * MBy;
constexpr size_t WS_O = WS_H;
constexpr size_t WS_Q = 57 * MBy;
constexpr size_t WS_T = WS_Q;
constexpr size_t WS_CTXK = 81 * MBy;
constexpr size_t WS_KDLAT = 93 * MBy;
constexpr size_t WS_VTCTX = 113 * MBy;
constexpr size_t WS_VTLATD = 121 * MBy;
constexpr size_t WS_VTLATM = 141 * MBy;
constexpr size_t WS_G = 151 * MBy;
constexpr size_t WS_QA = 167 * MBy;
constexpr size_t WS_CKVA = 173 * MBy;
constexpr size_t WS_SSQQ = 183 * MBy;
constexpr size_t WS_SSQKV = 184 * MBy;
constexpr size_t WS_KMLAT = 185 * MBy;
constexpr size_t WS_KVRAW = 215 * MBy;
constexpr size_t KDLAT_J = (size_t)4 * 1280 * 1024;
constexpr size_t VTLATD_J = (size_t)4 * 8 * 128 * 1280;
constexpr size_t CKVA_J = (size_t)9216 * 256;
constexpr size_t KMLAT_J = (size_t)4 * 8 * 1280 * 192;

constexpr size_t OUT_Y = 0;
constexpr size_t OUT_SK = 8388608;
constexpr size_t OUT_SV = 16777216;
constexpr size_t OUT_CKV = 25165824;
constexpr size_t OUT_KPE = 27262976;

constexpr float EPS = 1e-6f;
constexpr float LOG2E = 1.4426950408889634f;

enum { I_XP = 0, I_XS, I_CDK, I_CDV, I_CCKV, I_CKPE, I_C, I_CCTX, I_WADA, I_BADA, I_GPRE, I_GPOST, I_WOUT,
       I_DAWIN, I_LQ1, I_LK1, I_LQ2, I_LK2, I_GSUB, I_MWIN, I_GQA, I_WQB, I_GKVA, I_WKVB };

DEVI int tidx() { int t = threadIdx.x; asm volatile("" : "+v"(t)); return t; }
DEVI u16 f2bf(float f) {
  unsigned u = __float_as_uint(f);
  u += 0x7fffu + ((u >> 16) & 1u);
  return (u16)(u >> 16);
}
DEVI unsigned pk2(float a, float b) { return (unsigned)f2bf(a) | ((unsigned)f2bf(b) << 16); }
DEVI float bf2f(unsigned v) { return __uint_as_float(v << 16); }
DEVI void st_bf4(u16* p, f32x4 v) {
  uint2 u; u.x = pk2(v[0], v[1]); u.y = pk2(v[2], v[3]);
  *(uint2*)p = u;
}
DEVI void st_f4(float* p, f32x4 v) { *(float4*)p = make_float4(v[0], v[1], v[2], v[3]); }
DEVI f32x4 mfma16(bf16x8 a, bf16x8 b, f32x4 c) { return __builtin_amdgcn_mfma_f32_16x16x32_bf16(a, b, c, 0, 0, 0); }
DEVI float silu(float x) { return x / (1.f + __expf(-x)); }
DEVI float xshfl(float v, int m) { return __shfl_xor(v, m, 64); }

DEVI void rope4(f32x4& x1, f32x4& x2, const float* cs, const float* sn) {
  float4 c = *(const float4*)cs; float4 s = *(const float4*)sn;
  f32x4 a = x1, b = x2;
  x1[0] = a[0] * c.x - b[0] * s.x; x2[0] = a[0] * s.x + b[0] * c.x;
  x1[1] = a[1] * c.y - b[1] * s.y; x2[1] = a[1] * s.y + b[1] * c.y;
  x1[2] = a[2] * c.z - b[2] * s.z; x2[2] = a[2] * s.z + b[2] * c.z;
  x1[3] = a[3] * c.w - b[3] * s.w; x2[3] = a[3] * s.w + b[3] * c.w;
}

constexpr int LDT = 72;
constexpr int TILE_ELEMS = 128 * LDT;
constexpr int SMEM_BYTES = 4 * TILE_ELEMS * 2;

template <bool SWAP>
DEVI void gemm_core(const u16* __restrict__ A, int lda, const u16* __restrict__ B, int ldb, int K,
                    int m0, int n0, u16* smem, f32x4 (&acc)[4][4]) {
  const int tid = tidx(), lane = tid & 63, w = tid >> 6;
  const int wm = w >> 1, wn = w & 1;
  const int g = lane >> 4, li = lane & 15;
  u16* As = smem;
  u16* Bs = smem + 2 * TILE_ELEMS;
  const int lr = tid >> 3, lc = (tid & 7) * 8;
  const u16* ap = A + (size_t)(m0 + lr) * lda + lc;
  const u16* bp = B + (size_t)(n0 + lr) * ldb + lc;
  u32x4 ra[4], rb[4];
#pragma unroll
  for (int i = 0; i < 4; ++i) {
    ra[i] = *(const u32x4*)(ap + (size_t)i * 32 * lda);
    rb[i] = *(const u32x4*)(bp + (size_t)i * 32 * ldb);
  }
  __syncthreads();
#pragma unroll
  for (int i = 0; i < 4; ++i) {
    *(u32x4*)(As + (lr + 32 * i) * LDT + lc) = ra[i];
    *(u32x4*)(Bs + (lr + 32 * i) * LDT + lc) = rb[i];
  }
  __syncthreads();
  const int KT = K >> 6;
  for (int kt = 0; kt < KT; ++kt) {
    const int buf = kt & 1;
    if (kt + 1 < KT) {
      const int k0 = (kt + 1) << 6;
#pragma unroll
      for (int i = 0; i < 4; ++i) {
        ra[i] = *(const u32x4*)(ap + (size_t)i * 32 * lda + k0);
        rb[i] = *(const u32x4*)(bp + (size_t)i * 32 * ldb + k0);
      }
    }
    const u16* Ab = As + buf * TILE_ELEMS + (wm * 64 + li) * LDT + g * 8;
    const u16* Bb = Bs + buf * TILE_ELEMS + (wn * 64 + li) * LDT + g * 8;
#pragma unroll
    for (int ks = 0; ks < 2; ++ks) {
      bf16x8 a[4], b[4];
#pragma unroll
      for (int t = 0; t < 4; ++t) {
        a[t] = *(const bf16x8*)(Ab + t * 16 * LDT + ks * 32);
        b[t] = *(const bf16x8*)(Bb + t * 16 * LDT + ks * 32);
      }
#pragma unroll
      for (int mt = 0; mt < 4; ++mt)
#pragma unroll
        for (int nt = 0; nt < 4; ++nt)
          acc[mt][nt] = SWAP ? mfma16(b[nt], a[mt], acc[mt][nt]) : mfma16(a[mt], b[nt], acc[mt][nt]);
    }
    if (kt + 1 < KT) {
      const int nb = buf ^ 1;
#pragma unroll
      for (int i = 0; i < 4; ++i) {
        *(u32x4*)(As + nb * TILE_ELEMS + (lr + 32 * i) * LDT + lc) = ra[i];
        *(u32x4*)(Bs + nb * TILE_ELEMS + (lr + 32 * i) * LDT + lc) = rb[i];
      }
    }
    __syncthreads();
  }
}

DEVI void zero_acc(f32x4 (&acc)[4][4]) {
#pragma unroll
  for (int i = 0; i < 4; ++i)
#pragma unroll
    for (int k = 0; k < 4; ++k) acc[i][k] = (f32x4){0.f, 0.f, 0.f, 0.f};
}

DEVI void tile_diff_in(const Params& P, int j, int tile, u16* smem) {
  const int m0 = (tile >> 5) * 128, n0 = (tile & 31) * 128;
  const int region = n0 >> 10;
  const u16* A = (const u16*)(P.ws + WS_H);
  const u16* B = (const u16*)(P.ws + WS_WDAIN) + (size_t)j * 4096 * 1024;
  f32x4 acc[4][4];
  zero_acc(acc);
  if (region == 2) gemm_core<false>(A, 1024, B, 1024, 1024, m0, n0, smem, acc);
  else gemm_core<true>(A, 1024, B, 1024, 1024, m0, n0, smem, acc);

  const int lane = tidx() & 63, w = tidx() >> 6, wm = w >> 1, wn = w & 1, g = lane >> 4, li = lane & 15;
  const int mb = m0 + wm * 64, nb = n0 + wn * 64;
  const bool isLat = mb >= 4096;
  const int b = mb >> 8, sb = mb & 255, bl = (mb - 4096) >> 10, tb = (mb - 4096) & 1023;
  const float* ropeC = (const float*)(P.ws + WS_ROPE);
  const float* ropeS = ropeC + 1024 * 32;
  if (region == 2) {
    const int cbase = nb - 2048;
    u16* vtc = (u16*)(P.ws + WS_VTCTX);
    u16* vtl = (u16*)(P.ws + WS_VTLATD) + (size_t)j * VTLATD_J;
#pragma unroll
    for (int mt = 0; mt < 4; ++mt) {
      const int r0 = mt * 16 + g * 4;
#pragma unroll
      for (int nt = 0; nt < 4; ++nt) {
        const int col = cbase + nt * 16 + li, h = col >> 7, e = col & 127;
        if (!isLat) {
          const int s = sb + r0;
          float* sv = P.out + OUT_SV + ((size_t)((b * 2 + j) * 256 + s)) * 1024 + col;
#pragma unroll
          for (int jj = 0; jj < 4; ++jj) sv[(size_t)jj * 1024] = acc[mt][nt][jj];
          st_bf4(vtc + ((size_t)((b * 8 + h) * 128 + e)) * 256 + s, acc[mt][nt]);
        } else {
          const int t = tb + r0;
          st_bf4(vtl + ((size_t)((bl * 8 + h) * 128 + e)) * 1280 + t, acc[mt][nt]);
        }
      }
    }
  } else {
    const float qs = 0.125f * LOG2E;
#pragma unroll
    for (int mt = 0; mt < 4; ++mt) {
      const int rl = mt * 16 + li, row = mb + rl;
      if (region <= 1 && isLat) {
        const int t = tb + rl;
#pragma unroll
        for (int nt = 0; nt < 2; ++nt)
          rope4(acc[mt][nt], acc[mt][nt + 2], ropeC + t * 32 + nt * 16 + g * 4, ropeS + t * 32 + nt * 16 + g * 4);
      }
#pragma unroll
      for (int nt = 0; nt < 4; ++nt) {
        const int col = nb + nt * 16 + g * 4;
        f32x4 v = acc[mt][nt];
        if (region == 0) {
          v *= qs;
          st_bf4((u16*)(P.ws + WS_Q) + (size_t)row * 1024 + col, v);
        } else if (region == 1) {
          const int c2 = col - 1024;
          if (!isLat) {
            st_f4(P.out + OUT_SK + ((size_t)((b * 2 + j) * 256 + sb + rl)) * 1024 + c2, v);
            st_bf4((u16*)(P.ws + WS_CTXK) + (size_t)row * 1024 + c2, v);
          } else {
            st_bf4((u16*)(P.ws + WS_KDLAT) + (size_t)j * KDLAT_J + ((size_t)(bl * 1280 + tb + rl)) * 1024 + c2, v);
          }
        } else {
#pragma unroll
          for (int jj = 0; jj < 4; ++jj) v[jj] = silu(v[jj]);
          st_bf4((u16*)(P.ws + WS_G) + (size_t)row * 1024 + (col - 3072), v);
        }
      }
    }
  }
}

DEVI void tile_mla_in(const Params& P, int j, int tile, u16* smem) {
  const int m0 = (tile / 14) * 128, n0 = (tile % 14) * 128;
  const u16* A = (const u16*)(P.ws + WS_H);
  const u16* B = (const u16*)(P.ws + WS_WMLAIN) + (size_t)j * 1792 * 1024;
  f32x4 acc[4][4];
  zero_acc(acc);
  gemm_core<true>(A, 1024, B, 1024, 1024, m0, n0, smem, acc);

  const int lane = tidx() & 63, w = tidx() >> 6, wm = w >> 1, wn = w & 1, g = lane >> 4, li = lane & 15;
  const int mb = m0 + wm * 64, nb = n0 + wn * 64;
  const bool isLat = mb >= 4096;
  const int b = mb >> 8, sb = mb & 255, bl = (mb - 4096) >> 10, tb = (mb - 4096) & 1023;
  const float* ropeC = (const float*)(P.ws + WS_ROPE);
  const float* ropeS = ropeC + 1024 * 32;
  if (nb >= 1728) return;
#pragma unroll
  for (int mt = 0; mt < 4; ++mt) {
    const int rl = mt * 16 + li, row = mb + rl;
    if (nb < 640) {
      float ss = 0.f;
#pragma unroll
      for (int nt = 0; nt < 4; ++nt)
#pragma unroll
        for (int jj = 0; jj < 4; ++jj) ss += acc[mt][nt][jj] * acc[mt][nt][jj];
      ss += xshfl(ss, 16);
      ss += xshfl(ss, 32);
      if (nb < 384) {
        if (g == 0) ((float*)(P.ws + WS_SSQQ))[row * 8 + (nb >> 6)] = ss;
#pragma unroll
        for (int nt = 0; nt < 4; ++nt)
          st_bf4((u16*)(P.ws + WS_QA) + (size_t)row * 384 + nb + nt * 16 + g * 4, acc[mt][nt]);
      } else {
        if (g == 0) ((float*)(P.ws + WS_SSQKV))[row * 4 + ((nb - 384) >> 6)] = ss;
        const int arow = isLat ? (4096 + bl * 1280 + tb + rl) : row;
#pragma unroll
        for (int nt = 0; nt < 4; ++nt) {
          const int c2 = nb - 384 + nt * 16 + g * 4;
          st_bf4((u16*)(P.ws + WS_CKVA) + (size_t)j * CKVA_J + (size_t)arow * 256 + c2, acc[mt][nt]);
          if (!isLat) st_f4((float*)(P.ws + WS_KVRAW) + (size_t)row * 256 + c2, acc[mt][nt]);
        }
      }
    } else if (nb == 640) {
      if (isLat) {
        const int t = tb + rl;
#pragma unroll
        for (int nt = 0; nt < 2; ++nt)
          rope4(acc[mt][nt], acc[mt][nt + 2], ropeC + t * 32 + nt * 16 + g * 4, ropeS + t * 32 + nt * 16 + g * 4);
      }
#pragma unroll
      for (int nt = 0; nt < 4; ++nt) {
        const int d = nt * 16 + g * 4;
        if (!isLat) {
          st_f4(P.out + OUT_KPE + ((size_t)((b * 2 + j) * 256 + sb + rl)) * 64 + d, acc[mt][nt]);
          u16* kd = (u16*)(P.ws + WS_CTXK) + ((size_t)(b * 8) * 256 + sb + rl) * 192 + 128 + d;
#pragma unroll
          for (int h = 0; h < 8; ++h) st_bf4(kd + (size_t)h * 256 * 192, acc[mt][nt]);
        } else {
          u16* kd = (u16*)(P.ws + WS_KMLAT) + (size_t)j * KMLAT_J + ((size_t)(bl * 8) * 1280 + tb + rl) * 192 + 128 + d;
#pragma unroll
          for (int h = 0; h < 8; ++h) st_bf4(kd + (size_t)h * 1280 * 192, acc[mt][nt]);
        }
      }
    } else {
#pragma unroll
      for (int nt = 0; nt < 4; ++nt) {
        f32x4 v = acc[mt][nt];
#pragma unroll
        for (int jj = 0; jj < 4; ++jj) v[jj] = silu(v[jj]);
        st_bf4((u16*)(P.ws + WS_G) + (size_t)row * 1024 + (nb - 704 + nt * 16 + g * 4), v);
      }
    }
  }
}

DEVI void tile_qb(const Params& P, int j, int tile, u16* smem) {
  const int m0 = (tile / 12) * 128, n0 = (tile % 12) * 128;
  const u16* A = (const u16*)(P.ws + WS_QA);
  const u16* B = (const u16*)(P.ws + WS_WQB) + (size_t)j * 1536 * 384;
  f32x4 acc[4][4];
  zero_acc(acc);
  gemm_core<true>(A, 384, B, 384, 384, m0, n0, smem, acc);
  const int lane = tidx() & 63, w = tidx() >> 6, wm = w >> 1, wn = w & 1, g = lane >> 4, li = lane & 15;
  const int mb = m0 + wm * 64, nb = n0 + wn * 64;
  const bool isLat = mb >= 4096;
  const int tb = (mb - 4096) & 1023;
  const float* ropeC = (const float*)(P.ws + WS_ROPE);
  const float* ropeS = ropeC + 1024 * 32;
  const float* ssq = (const float*)(P.ws + WS_SSQQ);
  const bool isRope = (nb % 192) == 128;
  const float qs = 0.07216878364870322f * LOG2E;
#pragma unroll
  for (int mt = 0; mt < 4; ++mt) {
    const int rl = mt * 16 + li, row = mb + rl;
    float ss = 0.f;
#pragma unroll
    for (int i = 0; i < 6; ++i) ss += ssq[row * 8 + i];
    const float r = rsqrtf(ss * (1.f / 384.f) + EPS) * qs;
    if (isRope && isLat) {
      const int t = tb + rl;
#pragma unroll
      for (int nt = 0; nt < 2; ++nt)
        rope4(acc[mt][nt], acc[mt][nt + 2], ropeC + t * 32 + nt * 16 + g * 4, ropeS + t * 32 + nt * 16 + g * 4);
    }
#pragma unroll
    for (int nt = 0; nt < 4; ++nt) {
      f32x4 v = acc[mt][nt] * r;
      st_bf4((u16*)(P.ws + WS_Q) + (size_t)row * 1536 + nb + nt * 16 + g * 4, v);
    }
  }
}

DEVI void tile_kvb(const Params& P, int j, int tile, u16* smem) {
  const int m0 = (tile >> 4) * 128, n0 = (tile & 15) * 128;
  const bool tileLat = m0 >= 4096;
  const bool fresh = !tileLat || ((m0 - 4096) % 1280) < 1024;
  const u16* A = (const u16*)(P.ws + WS_CKVA) + (size_t)j * CKVA_J;
  const u16* B = (const u16*)(P.ws + (fresh ? WS_WKVBG : WS_WKVB)) + (size_t)j * 2048 * 256;
  const bool isV = (n0 >> 7) & 1;
  const int h = n0 >> 8;
  f32x4 acc[4][4];
  zero_acc(acc);
  if (isV) gemm_core<false>(A, 256, B, 256, 256, m0, n0, smem, acc);
  else gemm_core<true>(A, 256, B, 256, 256, m0, n0, smem, acc);
  const int lane = tidx() & 63, w = tidx() >> 6, wm = w >> 1, wn = w & 1, g = lane >> 4, li = lane & 15;
  const int mb = m0 + wm * 64;
  int b, keyb, Sk, tokb;
  u16 *Kd, *Vd;
  if (!tileLat) {
    b = mb >> 8; keyb = mb & 255; Sk = 256; tokb = mb;
    Kd = (u16*)(P.ws + WS_CTXK); Vd = (u16*)(P.ws + WS_VTCTX);
  } else {
    const int r2 = mb - 4096;
    b = r2 / 1280; keyb = r2 % 1280; Sk = 1280; tokb = 4096 + b * 1024 + keyb;
    Kd = (u16*)(P.ws + WS_KMLAT) + (size_t)j * KMLAT_J; Vd = (u16*)(P.ws + WS_VTLATM);
  }
  const float* ssq = (const float*)(P.ws + WS_SSQKV);
  if (!isV) {
#pragma unroll
    for (int mt = 0; mt < 4; ++mt) {
      const int rl = mt * 16 + li;
      float r = 1.f;
      if (fresh) {
        const float4 s4 = *(const float4*)(ssq + (size_t)(tokb + rl) * 4);
        r = rsqrtf((s4.x + s4.y + s4.z + s4.w) * (1.f / 256.f) + EPS);
      }
#pragma unroll
      for (int nt = 0; nt < 4; ++nt) {
        const int dd = wn * 64 + nt * 16 + g * 4;
        st_bf4(Kd + ((size_t)((b * 8 + h) * Sk + keyb + rl)) * 192 + dd, acc[mt][nt] * r);
      }
    }
  } else {
#pragma unroll
    for (int mt = 0; mt < 4; ++mt) {
      const int r0 = mt * 16 + g * 4;
      f32x4 rr = {1.f, 1.f, 1.f, 1.f};
      if (fresh) {
#pragma unroll
        for (int jj = 0; jj < 4; ++jj) {
          const float4 s4 = *(const float4*)(ssq + (size_t)(tokb + r0 + jj) * 4);
          rr[jj] = rsqrtf((s4.x + s4.y + s4.z + s4.w) * (1.f / 256.f) + EPS);
        }
      }
#pragma unroll
      for (int nt = 0; nt < 4; ++nt) {
        const int e = wn * 64 + nt * 16 + li;
        st_bf4(Vd + ((size_t)((b * 8 + h) * 128 + e)) * Sk + keyb + r0, acc[mt][nt] * rr);
      }
    }
  }
}

DEVI void tile_out(const Params& P, int layer, int tile, u16* smem) {
  const int m0 = (tile >> 3) * 128, n0 = (tile & 7) * 128;
  const u16* A = (const u16*)(P.ws + WS_O);
  const u16* B = (const u16*)(P.ws + WS_WOUT) + (size_t)layer * 1024 * 1024;
  f32x4 acc[4][4];
  zero_acc(acc);
  gemm_core<true>(A, 1024, B, 1024, 1024, m0, n0, smem, acc);
  const int lane = tidx() & 63, w = tidx() >> 6, wm = w >> 1, wn = w & 1, g = lane >> 4, li = lane & 15;
  const int mb = m0 + wm * 64, nb = n0 + wn * 64;
  float* T = (float*)(P.ws + WS_T);
#pragma unroll
  for (int mt = 0; mt < 4; ++mt)
#pragma unroll
    for (int nt = 0; nt < 4; ++nt)
      st_f4(T + (size_t)(mb + mt * 16 + li) * 1024 + nb + nt * 16 + g * 4, acc[mt][nt]);
}

template <bool DIFF>
DEVI void attn_item(const Params& P, const u16* __restrict__ Qb, int ldq, int qrow0,
                    const u16* __restrict__ Kb, int ldk, const u16* __restrict__ Vt, int Sk,
                    int h, float lam, float lam_init, const float* gsub, u16* smem) {
  constexpr int KW = DIFF ? 128 : 192;
  constexpr int KLD = KW + 8;
  constexpr int NKK = DIFF ? 2 : 6;
  constexpr int KT = DIFF ? 64 : 32;
  constexpr int NS = KT / 16;
  constexpr int NU = KT / 32;
  constexpr int KCH = KW / 8;
  constexpr int NKL = (KT * KCH) / 256;
  constexpr int VCH = KT / 8;
  constexpr int NVL = (128 * VCH) / 256;
  constexpr int VLD = KT + 8;
  u16* Ks = smem;
  u16* Vs = smem + KT * KLD;
  const int tid = tidx(), lane = tid & 63, w = tid >> 6, g = lane >> 4, li = lane & 15;

  bf16x8 qf[2][NKK];
#pragma unroll
  for (int s = 0; s < 2; ++s) {
    const int qrow = DIFF ? (qrow0 + w * 16 + li) : (qrow0 + w * 32 + s * 16 + li);
    const int qcol = DIFF ? (h * 128 + s * 64) : (h * 192);
#pragma unroll
    for (int kk = 0; kk < NKK; ++kk)
      qf[s][kk] = *(const bf16x8*)(Qb + (size_t)qrow * ldq + qcol + kk * 32 + g * 8);
  }
  f32x4 oacc[2][8];
#pragma unroll
  for (int s = 0; s < 2; ++s)
#pragma unroll
    for (int et = 0; et < 8; ++et) oacc[s][et] = (f32x4){0.f, 0.f, 0.f, 0.f};
  float mrow[2] = {-1e30f, -1e30f}, lrow[2] = {0.f, 0.f};

  u32x4 rk[NKL], rv[NVL];
  auto gload = [&](int key0) {
#pragma unroll
    for (int i = 0; i < NKL; ++i) {
      const int c = tid + 256 * i, r = c / KCH, cc = c % KCH;
      rk[i] = *(const u32x4*)(Kb + (size_t)(key0 + r) * ldk + cc * 8);
    }
#pragma unroll
    for (int i = 0; i < NVL; ++i) {
      const int c = tid + 256 * i, r = c / VCH, cc = c % VCH;
      rv[i] = *(const u32x4*)(Vt + (size_t)r * Sk + key0 + cc * 8);
    }
  };
  gload(0);
  const int NT = Sk / KT;
  for (int kt0 = 0; kt0 < NT; ++kt0) {
    __syncthreads();
#pragma unroll
    for (int i = 0; i < NKL; ++i) {
      const int c = tid + 256 * i, r = c / KCH, cc = c % KCH;
      *(u32x4*)(Ks + r * KLD + cc * 8) = rk[i];
    }
#pragma unroll
    for (int i = 0; i < NVL; ++i) {
      const int c = tid + 256 * i, r = c / VCH, cc = c % VCH;
      *(u32x4*)(Vs + r * VLD + cc * 8) = rv[i];
    }
    __syncthreads();
    if (kt0 + 1 < NT) gload((kt0 + 1) * KT);

    f32x4 st[2][NS];
#pragma unroll
    for (int s = 0; s < 2; ++s)
#pragma unroll
      for (int kt = 0; kt < NS; ++kt) st[s][kt] = (f32x4){0.f, 0.f, 0.f, 0.f};
#pragma unroll
    for (int kk = 0; kk < NKK; ++kk) {
#pragma unroll
      for (int kt = 0; kt < NS; ++kt) {
        if (DIFF) {
#pragma unroll
          for (int s = 0; s < 2; ++s) {
            const bf16x8 kf = *(const bf16x8*)(Ks + (kt * 16 + li) * KLD + s * 64 + kk * 32 + g * 8);
            st[s][kt] = mfma16(kf, qf[s][kk], st[s][kt]);
          }
        } else {
          const bf16x8 kf = *(const bf16x8*)(Ks + (kt * 16 + li) * KLD + kk * 32 + g * 8);
#pragma unroll
          for (int s = 0; s < 2; ++s) st[s][kt] = mfma16(kf, qf[s][kk], st[s][kt]);
        }
      }
    }
    bf16x8 pf[2][NU];
#pragma unroll
    for (int s = 0; s < 2; ++s) {
      float mx = st[s][0][0];
#pragma unroll
      for (int kt = 0; kt < NS; ++kt)
#pragma unroll
        for (int jj = 0; jj < 4; ++jj) mx = fmaxf(mx, st[s][kt][jj]);
      mx = fmaxf(mx, xshfl(mx, 16));
      mx = fmaxf(mx, xshfl(mx, 32));
      const float mnew = fmaxf(mrow[s], mx);
      const float alpha = exp2f(mrow[s] - mnew);
      mrow[s] = mnew;
      float ps = 0.f;
#pragma unroll
      for (int kt = 0; kt < NS; ++kt)
#pragma unroll
        for (int jj = 0; jj < 4; ++jj) {
          const float p = exp2f(st[s][kt][jj] - mnew);
          st[s][kt][jj] = p;
          ps += p;
        }
      lrow[s] = lrow[s] * alpha + ps;
#pragma unroll
      for (int et = 0; et < 8; ++et) oacc[s][et] *= alpha;
#pragma unroll
      for (int u = 0; u < NU; ++u) {
        union { bf16x8 v; unsigned d[4]; } pu;
        pu.d[0] = pk2(st[s][2 * u][0], st[s][2 * u][1]);
        pu.d[1] = pk2(st[s][2 * u][2], st[s][2 * u][3]);
        pu.d[2] = pk2(st[s][2 * u + 1][0], st[s][2 * u + 1][1]);
        pu.d[3] = pk2(st[s][2 * u + 1][2], st[s][2 * u + 1][3]);
        pf[s][u] = pu.v;
      }
    }
#pragma unroll
    for (int u = 0; u < NU; ++u) {
#pragma unroll
      for (int et = 0; et < 8; ++et) {
        union { bf16x8 v; u32x2 d[2]; } vu;
        vu.d[0] = *(const u32x2*)(Vs + (et * 16 + li) * VLD + (2 * u) * 16 + g * 4);
        vu.d[1] = *(const u32x2*)(Vs + (et * 16 + li) * VLD + (2 * u + 1) * 16 + g * 4);
#pragma unroll
        for (int s = 0; s < 2; ++s) oacc[s][et] = mfma16(vu.v, pf[s][u], oacc[s][et]);
      }
    }
  }
#pragma unroll
  for (int s = 0; s < 2; ++s) {
    lrow[s] += xshfl(lrow[s], 16);
    lrow[s] += xshfl(lrow[s], 32);
  }
  const u16* G = (const u16*)(P.ws + WS_G);
  u16* O = (u16*)(P.ws + WS_O);
  if (DIFF) {
    const float i0 = 1.f / lrow[0], i1 = lam / lrow[1];
    float ss = 0.f;
#pragma unroll
    for (int et = 0; et < 8; ++et) {
      oacc[0][et] = oacc[0][et] * i0 - oacc[1][et] * i1;
#pragma unroll
      for (int jj = 0; jj < 4; ++jj) ss += oacc[0][et][jj] * oacc[0][et][jj];
    }
    ss += xshfl(ss, 16);
    ss += xshfl(ss, 32);
    const float rr = rsqrtf(ss * (1.f / 128.f) + EPS) * (1.f - lam_init);
    const size_t tok = (size_t)(qrow0 + w * 16 + li);
#pragma unroll
    for (int et = 0; et < 8; ++et) {
      const int e = et * 16 + g * 4;
      const float4 gs = *(const float4*)(gsub + e);
      const uint2 gg = *(const uint2*)(G + tok * 1024 + h * 128 + e);
      f32x4 v = oacc[0][et] * rr;
      v[0] *= gs.x * bf2f(gg.x & 0xffffu);
      v[1] *= gs.y * bf2f(gg.x >> 16);
      v[2] *= gs.z * bf2f(gg.y & 0xffffu);
      v[3] *= gs.w * bf2f(gg.y >> 16);
      st_bf4(O + tok * 1024 + h * 128 + e, v);
    }
  } else {
#pragma unroll
    for (int s = 0; s < 2; ++s) {
      const float inv = 1.f / lrow[s];
      const size_t tok = (size_t)(qrow0 + w * 32 + s * 16 + li);
#pragma unroll
      for (int et = 0; et < 8; ++et) {
        const int e = et * 16 + g * 4;
        const uint2 gg = *(const uint2*)(G + tok * 1024 + h * 128 + e);
        f32x4 v = oacc[s][et] * inv;
        v[0] *= bf2f(gg.x & 0xffffu);
        v[1] *= bf2f(gg.x >> 16);
        v[2] *= bf2f(gg.y & 0xffffu);
        v[3] *= bf2f(gg.y >> 16);
        st_bf4(O + tok * 1024 + h * 128 + e, v);
      }
    }
  }
}

DEVI void attn_diff_phase(const Params& P, int j, u16* smem) {
  const float* lamv = (const float*)(P.ws + WS_MISC);
  const float lam = lamv[j * 2], lam_init = lamv[j * 2 + 1];
  const float* gsub = P.in[I_GSUB] + j * 128;
  const u16* Q = (const u16*)(P.ws + WS_Q);
  for (int it = blockIdx.x; it < 1024; it += gridDim.x) {
    if (it < 512) {
      const int bl = it >> 7, h = (it >> 4) & 7, qt = it & 15;
      const u16* Kb = (const u16*)(P.ws + WS_KDLAT) + (size_t)j * KDLAT_J + (size_t)bl * 1280 * 1024 + h * 128;
      const u16* Vt = (const u16*)(P.ws + WS_VTLATD) + (size_t)j * VTLATD_J + (size_t)(bl * 8 + h) * 128 * 1280;
      attn_item<true>(P, Q, 1024, 4096 + bl * 1024 + qt * 64, Kb, 1024, Vt, 1280, h, lam, lam_init, gsub, smem);
    } else {
      const int i2 = it - 512, b = i2 >> 5, h = (i2 >> 2) & 7, qt = i2 & 3;
      const u16* Kb = (const u16*)(P.ws + WS_CTXK) + (size_t)b * 256 * 1024 + h * 128;
      const u16* Vt = (const u16*)(P.ws + WS_VTCTX) + (size_t)(b * 8 + h) * 128 * 256;
      attn_item<true>(P, Q, 1024, b * 256 + qt * 64, Kb, 1024, Vt, 256, h, lam, lam_init, gsub, smem);
    }
  }
}

DEVI void attn_mla_phase(const Params& P, int j, u16* smem) {
  const u16* Q = (const u16*)(P.ws + WS_Q);
  for (int it = blockIdx.x; it < 512; it += gridDim.x) {
    if (it < 256) {
      const int bl = it >> 6, h = (it >> 3) & 7, qt = it & 7;
      const u16* Kb = (const u16*)(P.ws + WS_KMLAT) + (size_t)j * KMLAT_J + (size_t)(bl * 8 + h) * 1280 * 192;
      const u16* Vt = (const u16*)(P.ws + WS_VTLATM) + (size_t)(bl * 8 + h) * 128 * 1280;
      attn_item<false>(P, Q, 1536, 4096 + bl * 1024 + qt * 128, Kb, 192, Vt, 1280, h, 0.f, 0.f, nullptr, smem);
    } else {
      const int i2 = it - 256, b = i2 >> 4, h = (i2 >> 1) & 7, qt = i2 & 1;
      const u16* Kb = (const u16*)(P.ws + WS_CTXK) + (size_t)(b * 8 + h) * 256 * 192;
      const u16* Vt = (const u16*)(P.ws + WS_VTCTX) + (size_t)(b * 8 + h) * 128 * 256;
      attn_item<false>(P, Q, 1536, b * 256 + qt * 128, Kb, 192, Vt, 256, h, 0.f, 0.f, nullptr, smem);
    }
  }
}

DEVI float wave_sum(float v) {
  v += xshfl(v, 1); v += xshfl(v, 2); v += xshfl(v, 4); v += xshfl(v, 8); v += xshfl(v, 16); v += xshfl(v, 32);
  return v;
}

DEVI void ew_phase(const Params& P, int layer) {
  const int lane = tidx() & 63, w = tidx() >> 6;
  const float* ada = (const float*)(P.ws + WS_ADA);
  const float* T = (const float*)(P.ws + WS_T);
  u16* H = (u16*)(P.ws + WS_H);
  for (int row = blockIdx.x * 4 + w; row < 8192; row += gridDim.x * 4) {
    const int cond = row < 4096 ? 0 : 1 + ((row - 4096) >> 10);
    const float* xsrc = (layer <= 0) ? (row < 4096 ? P.in[I_XP] + (size_t)row * 1024 : P.in[I_XS] + (size_t)(row - 4096) * 1024)
                                     : P.out + OUT_Y + (size_t)row * 1024;
    float4 x[4];
#pragma unroll
    for (int i = 0; i < 4; ++i) x[i] = *(const float4*)(xsrc + lane * 4 + i * 256);
    if (layer >= 0) {
      float4 t[4];
      float ss = 0.f;
#pragma unroll
      for (int i = 0; i < 4; ++i) {
        t[i] = *(const float4*)(T + (size_t)row * 1024 + lane * 4 + i * 256);
        ss += t[i].x * t[i].x + t[i].y * t[i].y + t[i].z * t[i].z + t[i].w * t[i].w;
      }
      ss = wave_sum(ss);
      const float rt = rsqrtf(ss * (1.f / 1024.f) + EPS);
      const float* gate = ada + (size_t)(layer * 5 + cond) * 3072 + 2048;
      const float* gp = P.in[I_GPOST] + layer * 1024;
#pragma unroll
      for (int i = 0; i < 4; ++i) {
        const int c = lane * 4 + i * 256;
        const float4 ga = *(const float4*)(gate + c);
        const float4 gq = *(const float4*)(gp + c);
        x[i].x += ga.x * (t[i].x * rt * gq.x);
        x[i].y += ga.y * (t[i].y * rt * gq.y);
        x[i].z += ga.z * (t[i].z * rt * gq.z);
        x[i].w += ga.w * (t[i].w * rt * gq.w);
        *(float4*)(P.out + OUT_Y + (size_t)row * 1024 + c) = x[i];
      }
    }
    const int nl = layer + 1;
    if (nl < 4) {
      float ss = 0.f;
#pragma unroll
      for (int i = 0; i < 4; ++i) ss += x[i].x * x[i].x + x[i].y * x[i].y + x[i].z * x[i].z + x[i].w * x[i].w;
      ss = wave_sum(ss);
      const float rx = rsqrtf(ss * (1.f / 1024.f) + EPS);
      const float* sh = ada + (size_t)(nl * 5 + cond) * 3072;
      const float* sc = sh + 1024;
      const float* gpre = P.in[I_GPRE] + nl * 1024;
#pragma unroll
      for (int i = 0; i < 4; ++i) {
        const int c = lane * 4 + i * 256;
        const float4 s1 = *(const float4*)(sh + c);
        const float4 s2 = *(const float4*)(sc + c);
        const float4 gq = *(const float4*)(gpre + c);
        f32x4 hv;
        hv[0] = x[i].x * rx * gq.x * (1.f + s2.x) + s1.x;
        hv[1] = x[i].y * rx * gq.y * (1.f + s2.y) + s1.y;
        hv[2] = x[i].z * rx * gq.z * (1.f + s2.z) + s1.z;
        hv[3] = x[i].w * rx * gq.w * (1.f + s2.w) + s1.w;
        st_bf4(H + (size_t)row * 1024 + c, hv);
      }
    }
  }
}

DEVI void tr_tile(const float* __restrict__ src, int lds, int k0, int n0, int nvalid, u16* __restrict__ dst, int ldd,
                  const float* kscale, float* tile) {
  const int tid = tidx();
  __syncthreads();
#pragma unroll
  for (int i = 0; i < 16; ++i) {
    const int idx = tid + 256 * i, kk = idx >> 6, nn = idx & 63;
    float v = (n0 + nn < nvalid) ? src[(size_t)(k0 + kk) * lds + n0 + nn] : 0.f;
    if (kscale) v *= kscale[k0 + kk];
    tile[kk * 65 + nn] = v;
  }
  __syncthreads();
#pragma unroll
  for (int i = 0; i < 8; ++i) {
    const int idx = tid + 256 * i, nn = idx >> 5, kp = (idx & 31) * 2;
    *(unsigned*)(dst + (size_t)(n0 + nn) * ldd + k0 + kp) = pk2(tile[kp * 65 + nn], tile[(kp + 1) * 65 + nn]);
  }
}

constexpr int N_ADA = 384;
constexpr int N_TWOUT = 1024, N_TDAIN = 2048, N_TMLAIN = 896, N_TQB = 288, N_TKVB = 256, N_TCV = 512;
constexpr int N_ROPE = 128, N_LAM = 1, N_CDK = 1024, N_CCKV = 256, N_CKPE = 64;
constexpr int P0_ITEMS = N_ADA + N_TWOUT + N_TDAIN + N_TMLAIN + N_TQB + N_TKVB + N_TCV + N_ROPE + N_LAM + N_CDK + N_CCKV + N_CKPE;

DEVI void prep_phase(const Params& P, u16* smem) {
  float* fs = (float*)smem;
  const int tid = tidx();
  for (int item = blockIdx.x; item < P0_ITEMS; item += gridDim.x) {
    int it = item;
    if (it < N_ADA) {
      const int layer = it / 96, cgp = it % 96;
      float* sc = fs;
      float* red = fs + 5120;
      __syncthreads();
      for (int idx = tid; idx < 5120; idx += 256) {
        const int cnd = idx >> 10, k = idx & 1023;
        const float v = cnd == 0 ? P.in[I_CCTX][k] : P.in[I_C][(cnd - 1) * 1024 + k];
        sc[idx] = silu(v);
      }
      __syncthreads();
      const int col = tid & 31, kg = tid >> 5;
      const float* wp = P.in[I_WADA] + (size_t)layer * 1024 * 3072 + cgp * 32 + col;
      float a0 = 0.f, a1 = 0.f, a2 = 0.f, a3 = 0.f, a4 = 0.f;
#pragma unroll 8
      for (int k = kg * 128; k < kg * 128 + 128; ++k) {
        const float wv = wp[(size_t)k * 3072];
        a0 += sc[k] * wv; a1 += sc[1024 + k] * wv; a2 += sc[2048 + k] * wv; a3 += sc[3072 + k] * wv; a4 += sc[4096 + k] * wv;
      }
      red[(kg * 5 + 0) * 32 + col] = a0; red[(kg * 5 + 1) * 32 + col] = a1; red[(kg * 5 + 2) * 32 + col] = a2;
      red[(kg * 5 + 3) * 32 + col] = a3; red[(kg * 5 + 4) * 32 + col] = a4;
      __syncthreads();
      if (tid < 160) {
        const int cnd = tid >> 5, c2 = tid & 31;
        float s = P.in[I_BADA][layer * 3072 + cgp * 32 + c2];
#pragma unroll
        for (int q = 0; q < 8; ++q) s += red[(q * 5 + cnd) * 32 + c2];
        ((float*)(P.ws + WS_ADA))[(size_t)(layer * 5 + cnd) * 3072 + cgp * 32 + c2] = s;
      }
      continue;
    }
    it -= N_ADA;
    if (it < N_TWOUT) {
      const int l = it >> 8, kt = (it >> 4) & 15, nt = it & 15;
      tr_tile(P.in[I_WOUT] + (size_t)l * 1024 * 1024, 1024, kt * 64, nt * 64, 1024,
              (u16*)(P.ws + WS_WOUT) + (size_t)l * 1024 * 1024, 1024, nullptr, fs);
      continue;
    }
    it -= N_TWOUT;
    if (it < N_TDAIN) {
      const int l = it >> 10, kt = (it >> 6) & 15, nt = it & 63;
      tr_tile(P.in[I_DAWIN] + (size_t)l * 1024 * 4096, 4096, kt * 64, nt * 64, 4096,
              (u16*)(P.ws + WS_WDAIN) + (size_t)l * 4096 * 1024, 1024, nullptr, fs);
      continue;
    }
    it -= N_TDAIN;
    if (it < N_TMLAIN) {
      const int l = it / 448, r = it % 448, kt = r / 28, nt = r % 28;
      tr_tile(P.in[I_MWIN] + (size_t)l * 1024 * 1728, 1728, kt * 64, nt * 64, 1728,
              (u16*)(P.ws + WS_WMLAIN) + (size_t)l * 1792 * 1024, 1024, nullptr, fs);
      continue;
    }
    it -= N_TMLAIN;
    if (it < N_TQB) {
      const int l = it / 144, r = it % 144, kt = r / 24, nt = r % 24;
      tr_tile(P.in[I_WQB] + (size_t)l * 384 * 1536, 1536, kt * 64, nt * 64, 1536,
              (u16*)(P.ws + WS_WQB) + (size_t)l * 1536 * 384, 384, P.in[I_GQA] + l * 384, fs);
      continue;
    }
    it -= N_TQB;
    if (it < N_TKVB) {
      const int l = it >> 7, kt = (it >> 5) & 3, nt = it & 31;
      tr_tile(P.in[I_WKVB] + (size_t)l * 256 * 2048, 2048, kt * 64, nt * 64, 2048,
              (u16*)(P.ws + WS_WKVB) + (size_t)l * 2048 * 256, 256, nullptr, fs);
      tr_tile(P.in[I_WKVB] + (size_t)l * 256 * 2048, 2048, kt * 64, nt * 64, 2048,
              (u16*)(P.ws + WS_WKVBG) + (size_t)l * 2048 * 256, 256, P.in[I_GKVA] + l * 256, fs);
      continue;
    }
    it -= N_TKVB;
    if (it < N_TCV) {
      const int grp = it >> 3, sub = it & 7, bl = grp >> 4, jj = (grp >> 3) & 1, h = grp & 7, pt = sub >> 1, et = sub & 1;
      const float* src = P.in[I_CDV] + ((size_t)(bl * 2 + jj) * 256) * 1024 + h * 128;
      u16* dst = (u16*)(P.ws + WS_VTLATD) + (size_t)jj * VTLATD_J + (size_t)(bl * 8 + h) * 128 * 1280 + 1024;
      tr_tile(src, 1024, pt * 64, et * 64, 128, dst, 1280, nullptr, fs);
      continue;
    }
    it -= N_TCV;
    if (it < N_ROPE) {
      const int idx = it * 256 + tid, t = idx >> 5, p = idx & 31, f = p & 15;
      const float inv = exp2f(-(float)f * (13.287712379549449f / 16.f));
      const float pos = (p < 16) ? (float)(t >> 6) : (float)(t & 63);
      float sn, cs;
      sincosf(pos * inv, &sn, &cs);
      float* rc = (float*)(P.ws + WS_ROPE);
      rc[idx] = cs;
      rc[1024 * 32 + idx] = sn;
      continue;
    }
    it -= N_ROPE;
    if (it < N_LAM) {
      if (tid < 2) {
        const int jd = tid;
        float s1 = 0.f, s2 = 0.f;
        for (int d = 0; d < 64; ++d) {
          s1 += P.in[I_LQ1][jd * 64 + d] * P.in[I_LK1][jd * 64 + d];
          s2 += P.in[I_LQ2][jd * 64 + d] * P.in[I_LK2][jd * 64 + d];
        }
        const float li = 0.8f - 0.6f * expf(-0.3f * (float)(2 * jd));
        float* lamv = (float*)(P.ws + WS_MISC);
        lamv[jd * 2] = expf(s1) - expf(s2) + li;
        lamv[jd * 2 + 1] = li;
      }
      continue;
    }
    it -= N_LAM;
    if (it < N_CDK) {
      const size_t e0 = ((size_t)it * 256 + tid) * 8;
      const int col = e0 & 1023, p = (e0 >> 10) & 255, jj = (e0 >> 18) & 1, bl = (int)(e0 >> 19);
      const float4 a = *(const float4*)(P.in[I_CDK] + e0);
      const float4 b = *(const float4*)(P.in[I_CDK] + e0 + 4);
      uint4 u; u.x = pk2(a.x, a.y); u.y = pk2(a.z, a.w); u.z = pk2(b.x, b.y); u.w = pk2(b.z, b.w);
      *(uint4*)((u16*)(P.ws + WS_KDLAT) + (size_t)jj * KDLAT_J + ((size_t)(bl * 1280 + 1024 + p)) * 1024 + col) = u;
      continue;
    }
    it -= N_CDK;
    if (it < N_CCKV) {
      const size_t e0 = ((size_t)it * 256 + tid) * 8;
      const int col = e0 & 255, p = (e0 >> 8) & 255, jj = (e0 >> 16) & 1, bl = (int)(e0 >> 17);
      const float4 a = *(const float4*)(P.in[I_CCKV] + e0);
      const float4 b = *(const float4*)(P.in[I_CCKV] + e0 + 4);
      uint4 u; u.x = pk2(a.x, a.y); u.y = pk2(a.z, a.w); u.z = pk2(b.x, b.y); u.w = pk2(b.z, b.w);
      *(uint4*)((u16*)(P.ws + WS_CKVA) + (size_t)jj * CKVA_J + ((size_t)(4096 + bl * 1280 + 1024 + p)) * 256 + col) = u;
      continue;
    }
    it -= N_CCKV;
    {
      const size_t e0 = ((size_t)it * 256 + tid) * 8;
      const int d = e0 & 63, p = (e0 >> 6) & 255, jj = (e0 >> 14) & 1, bl = (int)(e0 >> 15);
      const float4 a = *(const float4*)(P.in[I_CKPE] + e0);
      const float4 b = *(const float4*)(P.in[I_CKPE] + e0 + 4);
      uint4 u; u.x = pk2(a.x, a.y); u.y = pk2(a.z, a.w); u.z = pk2(b.x, b.y); u.w = pk2(b.z, b.w);
      u16* dst = (u16*)(P.ws + WS_KMLAT) + (size_t)jj * KMLAT_J + ((size_t)(bl * 8) * 1280 + 1024 + p) * 192 + 128 + d;
#pragma unroll
      for (int h = 0; h < 8; ++h) *(uint4*)(dst + (size_t)h * 1280 * 192) = u;
    }
  }
}

DEVI void mla_b_phase(const Params& P, int j, u16* smem) {
  constexpr int NQ = 64 * 12, NKV = 72 * 16, NNORM = 64;
  for (int it = blockIdx.x; it < NKV + NQ + NNORM; it += gridDim.x) {
    if (it < NKV) tile_kvb(P, j, it, smem);
    else if (it < NKV + NQ) tile_qb(P, j, it - NKV, smem);
    else {
      const int lane = tidx() & 63, w = tidx() >> 6;
      const float* ssq = (const float*)(P.ws + WS_SSQKV);
      const float4 gk = *(const float4*)(P.in[I_GKVA] + j * 256 + lane * 4);
      for (int r = w; r < 64; r += 4) {
        const int row = (it - NKV - NQ) * 64 + r;
        const float4 s4 = *(const float4*)(ssq + (size_t)row * 4);
        const float rr = rsqrtf((s4.x + s4.y + s4.z + s4.w) * (1.f / 256.f) + EPS);
        float* p = P.out + OUT_CKV + ((size_t)(((row >> 8) * 2 + j) * 256 + (row & 255))) * 256 + lane * 4;
        float4 v = *(const float4*)((const float*)(P.ws + WS_KVRAW) + (size_t)row * 256 + lane * 4);
        v.x *= rr * gk.x; v.y *= rr * gk.y; v.z *= rr * gk.z; v.w *= rr * gk.w;
        *(float4*)p = v;
      }
    }
  }
}


#define XB_TMO      128
#define XB_XCNT(j)  (256  + 64 * (j))
#define XB_XSUB(j)  (1280 + 64 * (j))
#define XB_XGEN(j)  (2304 + 64 * (j))
#define XB_TOP      3328
#define XB_TOPGEN   3392
#define XCD_BAR_WORDS 3456
#define XB_SPIN_CAP (1u << 22)
#define LAS __attribute__((address_space(3)))
DEVI unsigned xb_ld(unsigned* p) { return __hip_atomic_load(p, __ATOMIC_RELAXED, __HIP_MEMORY_SCOPE_AGENT); }
DEVI unsigned xb_add(unsigned* p, unsigned v) { return __hip_atomic_fetch_add(p, v, __ATOMIC_RELAXED, __HIP_MEMORY_SCOPE_AGENT); }
DEVI unsigned xb_xcc_id() { return (unsigned)__builtin_amdgcn_s_getreg((3 << 11) | 20) & 0xFu; }
#define XB_SPIN(cond, bar) do { unsigned _sp = 0; while (cond) { __builtin_amdgcn_s_sleep(1); \
    if ((++_sp & 255u) == 0u) { if (xb_ld(&(bar)[XB_TMO])) break; if (_sp > XB_SPIN_CAP) { atomicAdd(&(bar)[XB_TMO], 1u); break; } } } } while (0)
struct XcdBarrier { unsigned* bar; unsigned x; volatile LAS unsigned* st; };
DEVI XcdBarrier xcd_barrier_post(unsigned* bar, volatile LAS unsigned* st) {
  XcdBarrier b; b.bar = bar; b.x = xb_xcc_id(); b.st = st;
  if (threadIdx.x == 0) (void)xb_add(&bar[XB_XCNT(b.x)], 1u);
  return b;
}
DEVI void xcd_barrier_complete(unsigned* bar, unsigned x, unsigned& nloc, unsigned& nx) {
  const unsigned G = gridDim.x * gridDim.y * gridDim.z;
  unsigned sum, cnt, mine, sp = 0u;
  for (;;) {
    sum = 0u; cnt = 0u; mine = 0u;
#pragma unroll
    for (unsigned j = 0; j < 16; ++j) { const unsigned c = xb_ld(&bar[XB_XCNT(j)]); sum += c; cnt += (c > 0u) ? 1u : 0u; mine = (j == x) ? c : mine; }
    if (sum == G) break;
    __builtin_amdgcn_s_sleep(1);
    if ((++sp & 255u) == 0u) { if (xb_ld(&bar[XB_TMO])) break; if (sp > XB_SPIN_CAP) { atomicAdd(&bar[XB_TMO], 1u); break; } }
  }
  nloc = mine > 0u ? mine : 1u; nx = cnt > 0u ? cnt : 1u;
}
DEVI void xcd_barrier(const XcdBarrier& b) {
  asm volatile("s_waitcnt vmcnt(0)" ::: "memory");
  __syncthreads();
  if (threadIdx.x == 0) {
    unsigned* bar = b.bar;
    __builtin_amdgcn_s_waitcnt(0);
    unsigned nloc = b.st[0], nx = b.st[1];
    if (nloc == 0u) { xcd_barrier_complete(bar, b.x, nloc, nx); b.st[0] = nloc; b.st[1] = nx; }
    const unsigned old = xb_add(&bar[XB_XSUB(b.x)], 1u);
    const unsigned gen = old / nloc;
    if (old + 1u == (gen + 1u) * nloc) {
      __builtin_amdgcn_fence(__ATOMIC_RELEASE, "agent");
      asm volatile("s_waitcnt vmcnt(0)" ::: "memory");
      const unsigned og = xb_add(&bar[XB_TOP], 1u);
      const unsigned tg = og / nx;
      if (og + 1u == (tg + 1u) * nx) xb_add(&bar[XB_TOPGEN], 1u);
      else XB_SPIN(xb_ld(&bar[XB_TOPGEN]) == tg, bar);
      __builtin_amdgcn_fence(__ATOMIC_ACQUIRE, "agent");
      xb_add(&bar[XB_XGEN(b.x)], 1u);
      asm volatile("s_waitcnt vmcnt(0)" ::: "memory");
    } else {
      XB_SPIN(xb_ld(&bar[XB_XGEN(b.x)]) == gen, bar);
      __builtin_amdgcn_fence(__ATOMIC_ACQUIRE, "agent");
      asm volatile("s_waitcnt vmcnt(0)" ::: "memory");
    }
  }
  __syncthreads();
}
constexpr size_t WS_BAR = WS_MISC + 65536;

#ifndef EN
#define EN 0xFF
#endif
DEVI void run_phase(const Params& P, int ph, u16* smem) {
  if (ph == 0) { if (EN & 1) prep_phase(P, smem); return; }
  if (ph == 1) { if (EN & 2) ew_phase(P, -1); return; }
  int layer, sub;
  if (ph < 6) { layer = 0; sub = ph - 2; }
  else if (ph < 11) { layer = 1; sub = ph - 6; }
  else if (ph < 15) { layer = 2; sub = ph - 11; }
  else { layer = 3; sub = ph - 15; }
  const int j = layer >> 1;
  if ((layer & 1) == 0) {
    if (sub == 0) { if (EN & 4) for (int t = blockIdx.x; t < 64 * 32; t += gridDim.x) tile_diff_in(P, j, t, smem); }
    else if (sub == 1) { if (EN & 8) attn_diff_phase(P, j, smem); }
    else if (sub == 2) { if (EN & 16) for (int t = blockIdx.x; t < 64 * 8; t += gridDim.x) tile_out(P, layer, t, smem); }
    else { if (EN & 2) ew_phase(P, layer); }
  } else {
    if (sub == 0) { if (EN & 32) for (int t = blockIdx.x; t < 64 * 14; t += gridDim.x) tile_mla_in(P, j, t, smem); }
    else if (sub == 1) { if (EN & 64) mla_b_phase(P, j, smem); }
    else if (sub == 2) { if (EN & 128) attn_mla_phase(P, j, smem); }
    else if (sub == 3) { if (EN & 16) for (int t = blockIdx.x; t < 64 * 8; t += gridDim.x) tile_out(P, layer, t, smem); }
    else { if (EN & 2) ew_phase(P, layer); }
  }
}

constexpr int N_PHASES = 20;

__global__ void __launch_bounds__(256, 2) fwd_megakernel(Params P) {
  __shared__ __attribute__((aligned(16))) u16 smem[SMEM_BYTES / 2];
  __shared__ uint4 xb_words;
  if (threadIdx.x == 0) xb_words = make_uint4(0u, 0u, 0u, 0u);
  __syncthreads();
  XcdBarrier xb = xcd_barrier_post((unsigned*)(P.ws + WS_BAR), (volatile LAS unsigned*)&xb_words);
  for (int ph = P.ph_lo; ph < P.ph_hi; ++ph) {
    Params Pl = P;
    asm volatile("" : "+s"(Pl.ws), "+s"(Pl.out));
    run_phase(Pl, ph, smem);
    if (ph + 1 < P.ph_hi) {
      if (ph == 0) cg::this_grid().sync();
      else xcd_barrier(xb);
    }
#ifdef EXTRA_SYNCS
    for (int q = 0; q < EXTRA_SYNCS; ++q) xcd_barrier(xb);
#endif
  }
}

extern "C" void kernel_launch(void* const* d_in, const int* in_sizes, int n_in, void* d_out, int out_size, void* d_ws,
                              size_t ws_size, hipStream_t stream) {
  static int grid_blocks = 0;
  if (!grid_blocks) {
    int dev = 0, cus = 0, per_cu = 0;
    (void)hipGetDevice(&dev);
    (void)hipDeviceGetAttribute(&cus, hipDeviceAttributeMultiprocessorCount, dev);
    (void)hipOccupancyMaxActiveBlocksPerMultiprocessor(&per_cu, fwd_megakernel, 256, 0);
    if (per_cu < 1) per_cu = 1;
    if (per_cu > 2) per_cu = 2;
    grid_blocks = cus * per_cu;
  }
  if (hipMemsetAsync((unsigned char*)d_ws + WS_BAR, 0, 16384, stream) != hipSuccess) { fprintf(stderr, "memset failed\n"); return; }
  Params p{};
  for (int i = 0; i < 24; ++i) p.in[i] = (const float*)d_in[i];
  p.out = (float*)d_out;
  p.ws = (unsigned char*)d_ws;
#if MULTI_LAUNCH
  for (int ph = 0; ph < N_PHASES; ++ph) {
    p.ph_lo = ph; p.ph_hi = ph + 1;
    hipLaunchKernelGGL(fwd_megakernel, dim3(grid_blocks), dim3(256), 0, stream, p);
  }
#else
  p.ph_lo = 0; p.ph_hi = N_PHASES;
  void* args[] = {&p};
  hipError_t e = hipLaunchCooperativeKernel((void*)fwd_megakernel, dim3(grid_blocks), dim3(256), args, 0, stream);
  if (e != hipSuccess) fprintf(stderr, "cooperative launch failed: %s (grid %d)\n", hipGetErrorString(e), grid_blocks);
#endif
}
```

```cpp
#include <hip/hip_runtime.h>
#include <hip/hip_cooperative_groups.h>
#include <cstdio>
namespace cg = cooperative_groups;

#ifndef MULTI_LAUNCH
#define MULTI_LAUNCH 0
#endif

typedef unsigned short u16;
typedef __attribute__((ext_vector_type(8))) short bf16x8;
typedef __attribute__((ext_vector_type(4))) float f32x4;
typedef __attribute__((ext_vector_type(4))) unsigned u32x4;
typedef __attribute__((ext_vector_type(2))) unsigned u32x2;

#define DEVI __device__ __forceinline__

struct Params {
  const float* in[24];
  float* out;
  unsigned char* ws;
  int ph_lo, ph_hi;
};

constexpr size_t MBy = 1u << 20;
constexpr size_t WS_WOUT = 0;
constexpr size_t WS_WDAIN = 8 * MBy;
constexpr size_t WS_WMLAIN = 24 * MBy;
constexpr size_t WS_WQB = 31 * MBy;
constexpr size_t WS_WKVB = 34 * MBy;
constexpr size_t WS_WKVBG = 36 * MBy;
constexpr size_t WS_ADA = 38 * MBy;
constexpr size_t WS_ROPE = 39 * MBy;
constexpr size_t WS_MISC = 40 * MBy;
constexpr size_t WS_H = 41 * MBy;
constexpr size_t WS_O = WS_H;
constexpr size_t WS_Q = 57 * MBy;
constexpr size_t WS_T = WS_Q;
constexpr size_t WS_CTXK = 81 * MBy;
constexpr size_t WS_KDLAT = 93 * MBy;
constexpr size_t WS_VTCTX = 113 * MBy;
constexpr size_t WS_VTLATD = 121 * MBy;
constexpr size_t WS_VTLATM = 141 * MBy;
constexpr size_t WS_G = 151 * MBy;
constexpr size_t WS_QA = 167 * MBy;
constexpr size_t WS_CKVA = 173 * MBy;
constexpr size_t WS_SSQQ = 183 * MBy;
constexpr size_t WS_SSQKV = 184 * MBy;
constexpr size_t WS_KMLAT = 185 * MBy;
constexpr size_t WS_KVRAW = 215 * MBy;
constexpr size_t KDLAT_J = (size_t)4 * 1280 * 1024;
constexpr size_t VTLATD_J = (size_t)4 * 8 * 128 * 1280;
constexpr size_t CKVA_J = (size_t)9216 * 256;
constexpr size_t KMLAT_J = (size_t)4 * 8 * 1280 * 192;

constexpr size_t OUT_Y = 0;
constexpr size_t OUT_SK = 8388608;
constexpr size_t OUT_SV = 16777216;
constexpr size_t OUT_CKV = 25165824;
constexpr size_t OUT_KPE = 27262976;

constexpr float EPS = 1e-6f;
constexpr float LOG2E = 1.4426950408889634f;

enum { I_XP = 0, I_XS, I_CDK, I_CDV, I_CCKV, I_CKPE, I_C, I_CCTX, I_WADA, I_BADA, I_GPRE, I_GPOST, I_WOUT,
       I_DAWIN, I_LQ1, I_LK1, I_LQ2, I_LK2, I_GSUB, I_MWIN, I_GQA, I_WQB, I_GKVA, I_WKVB };

DEVI int tidx() { int t = threadIdx.x; asm volatile("" : "+v"(t)); return t; }
DEVI u16 f2bf(float f) {
  unsigned u = __float_as_uint(f);
  u += 0x7fffu + ((u >> 16) & 1u);
  return (u16)(u >> 16);
}
DEVI unsigned pk2(float a, float b) { return (unsigned)f2bf(a) | ((unsigned)f2bf(b) << 16); }
DEVI float bf2f(unsigned v) { return __uint_as_float(v << 16); }
DEVI void st_bf4(u16* p, f32x4 v) {
  uint2 u; u.x = pk2(v[0], v[1]); u.y = pk2(v[2], v[3]);
  *(uint2*)p = u;
}
DEVI void st_f4(float* p, f32x4 v) { *(float4*)p = make_float4(v[0], v[1], v[2], v[3]); }
DEVI f32x4 mfma16(bf16x8 a, bf16x8 b, f32x4 c) { return __builtin_amdgcn_mfma_f32_16x16x32_bf16(a, b, c, 0, 0, 0); }
DEVI float silu(float x) { return x / (1.f + __expf(-x)); }
DEVI float xshfl(float v, int m) { return __shfl_xor(v, m, 64); }

DEVI void rope4(f32x4& x1, f32x4& x2, const float* cs, const float* sn) {
  float4 c = *(const float4*)cs; float4 s = *(const float4*)sn;
  f32x4 a = x1, b = x2;
  x1[0] = a[0] * c.x - b[0] * s.x; x2[0] = a[0] * s.x + b[0] * c.x;
  x1[1] = a[1] * c.y - b[1] * s.y; x2[1] = a[1] * s.y + b[1] * c.y;
  x1[2] = a[2] * c.z - b[2] * s.z; x2[2] = a[2] * s.z + b[2] * c.z;
  x1[3] = a[3] * c.w - b[3] * s.w; x2[3] = a[3] * s.w + b[3] * c.w;
}

constexpr int LDT = 64;
constexpr int TILE_ELEMS = 128 * LDT;
constexpr int SMEM_BYTES = 4 * TILE_ELEMS * 2;

template <bool SWAP>
DEVI void gemm_core(const u16* __restrict__ A, int lda, const u16* __restrict__ B, int ldb, int K,
                    int m0, int n0, u16* smem, f32x4 (&acc)[4][4]) {
  const int tid = tidx(), lane = tid & 63, w = tid >> 6;
  const int wm = w >> 1, wn = w & 1;
  const int g = lane >> 4, li = lane & 15;
  u16* As = smem;
  u16* Bs = smem + 2 * TILE_ELEMS;
  const int lr = tid >> 3, lc = (tid & 7) * 8;
  const u16* ap = A + (size_t)(m0 + lr) * lda + lc;
  const u16* bp = B + (size_t)(n0 + lr) * ldb + lc;
  const int wsw = (((tid & 7) ^ (lr & 7)) * 8);
  u16* sa = As + lr * LDT + wsw;
  u16* sb = Bs + lr * LDT + wsw;
  const int rs0 = ((g ^ (li & 7)) * 8), rs1 = (((4 + g) ^ (li & 7)) * 8);
  const u16* Ard = As + (wm * 64 + li) * LDT;
  const u16* Brd = Bs + (wn * 64 + li) * LDT;
  u32x4 ra0[4], rb0[4], ra1[4], rb1[4];
#define GLOAD(RA, RB, KT_) { const int k0_ = (KT_) << 6; _Pragma("unroll") for (int i = 0; i < 4; ++i) { \
    RA[i] = *(const u32x4*)(ap + (size_t)i * 32 * lda + k0_); RB[i] = *(const u32x4*)(bp + (size_t)i * 32 * ldb + k0_); } }
#define SSTORE(RA, RB, BUF) { _Pragma("unroll") for (int i = 0; i < 4; ++i) { \
    *(u32x4*)(sa + (BUF) * TILE_ELEMS + 32 * i * LDT) = RA[i]; *(u32x4*)(sb + (BUF) * TILE_ELEMS + 32 * i * LDT) = RB[i]; } }
#define FRAGS(BUF) _Pragma("unroll") for (int t = 0; t < 4; ++t) { \
      fa0[t] = *(const bf16x8*)(Ard + (BUF) * TILE_ELEMS + t * 16 * LDT + rs0); fb0[t] = *(const bf16x8*)(Brd + (BUF) * TILE_ELEMS + t * 16 * LDT + rs0); } \
    _Pragma("unroll") for (int t = 0; t < 4; ++t) { \
      fa1[t] = *(const bf16x8*)(Ard + (BUF) * TILE_ELEMS + t * 16 * LDT + rs1); fb1[t] = *(const bf16x8*)(Brd + (BUF) * TILE_ELEMS + t * 16 * LDT + rs1); }
#define MMA(FA, FB) _Pragma("unroll") for (int mt = 0; mt < 4; ++mt) _Pragma("unroll") for (int nt = 0; nt < 4; ++nt) \
      acc[mt][nt] = SWAP ? mfma16(FB[nt], FA[mt], acc[mt][nt]) : mfma16(FA[mt], FB[nt], acc[mt][nt]);
  const int KT = K >> 6;
  bf16x8 fa0[4], fb0[4], fa1[4], fb1[4];
  GLOAD(ra0, rb0, 0);
  GLOAD(ra1, rb1, 1);
  __syncthreads();
  SSTORE(ra0, rb0, 0);
  GLOAD(ra0, rb0, (2 < KT ? 2 : KT - 1));
  __syncthreads();
  for (int kt = 0; kt < KT; kt += 2) {
    FRAGS(0);
    __builtin_amdgcn_sched_barrier(0);
    MMA(fa0, fb0);
    __builtin_amdgcn_sched_barrier(0);
    SSTORE(ra1, rb1, 1);
    GLOAD(ra1, rb1, (kt + 3 < KT ? kt + 3 : KT - 1));
    __builtin_amdgcn_sched_barrier(0);
    MMA(fa1, fb1);
    __syncthreads();
    FRAGS(1);
    __builtin_amdgcn_sched_barrier(0);
    MMA(fa0, fb0);
    __builtin_amdgcn_sched_barrier(0);
    SSTORE(ra0, rb0, 0);
    GLOAD(ra0, rb0, (kt + 4 < KT ? kt + 4 : KT - 1));
    __builtin_amdgcn_sched_barrier(0);
    MMA(fa1, fb1);
    __syncthreads();
  }
#undef GLOAD
#undef SSTORE
#undef FRAGS
#undef MMA
}

DEVI void zero_acc(f32x4 (&acc)[4][4]) {
#pragma unroll
  for (int i = 0; i < 4; ++i)
#pragma unroll
    for (int k = 0; k < 4; ++k) acc[i][k] = (f32x4){0.f, 0.f, 0.f, 0.f};
}


DEVI int xcd_remap(int l, int total) { return (l & 7) * (total >> 3) + (l >> 3); }
DEVI void patch_tile(int v, int NT, int PN, int& mt, int& nt) {
  const int psz = 8 * PN, p = v / psz, i = v - p * psz, npn = NT / PN;
  const int pm = p / npn, pn = p - pm * npn;
  const int im = i / PN, in = i - im * PN;
  mt = pm * 8 + im;
  nt = pn * PN + in;
}

DEVI void tile_diff_in(const Params& P, int j, int tile, u16* smem) {
  int tm_, tn_; patch_tile(xcd_remap(tile, 2048), 32, 8, tm_, tn_);
  const int m0 = tm_ * 128, n0 = tn_ * 128;
  const int region = n0 >> 10;
  const u16* A = (const u16*)(P.ws + WS_H);
  const u16* B = (const u16*)(P.ws + WS_WDAIN) + (size_t)j * 4096 * 1024;
  f32x4 acc[4][4];
  zero_acc(acc);
  if (region == 2) gemm_core<false>(A, 1024, B, 1024, 1024, m0, n0, smem, acc);
  else gemm_core<true>(A, 1024, B, 1024, 1024, m0, n0, smem, acc);

  const int lane = tidx() & 63, w = tidx() >> 6, wm = w >> 1, wn = w & 1, g = lane >> 4, li = lane & 15;
  const int mb = m0 + wm * 64, nb = n0 + wn * 64;
  const bool isLat = mb >= 4096;
  const int b = mb >> 8, sb = mb & 255, bl = (mb - 4096) >> 10, tb = (mb - 4096) & 1023;
  const float* ropeC = (const float*)(P.ws + WS_ROPE);
  const float* ropeS = ropeC + 1024 * 32;
  if (region == 2) {
    const int cbase = nb - 2048;
    u16* vtc = (u16*)(P.ws + WS_VTCTX);
    u16* vtl = (u16*)(P.ws + WS_VTLATD) + (size_t)j * VTLATD_J;
#pragma unroll
    for (int mt = 0; mt < 4; ++mt) {
      const int r0 = mt * 16 + g * 4;
#pragma unroll
      for (int nt = 0; nt < 4; ++nt) {
        const int col = cbase + nt * 16 + li, h = col >> 7, e = col & 127;
        if (!isLat) {
          const int s = sb + r0;
          float* sv = P.out + OUT_SV + ((size_t)((b * 2 + j) * 256 + s)) * 1024 + col;
#pragma unroll
          for (int jj = 0; jj < 4; ++jj) sv[(size_t)jj * 1024] = acc[mt][nt][jj];
          st_bf4(vtc + ((size_t)((b * 8 + h) * 128 + e)) * 256 + s, acc[mt][nt]);
        } else {
          const int t = tb + r0;
          st_bf4(vtl + ((size_t)((bl * 8 + h) * 128 + e)) * 1280 + t, acc[mt][nt]);
        }
      }
    }
  } else {
    const float qs = 0.125f * LOG2E;
#pragma unroll
    for (int mt = 0; mt < 4; ++mt) {
      const int rl = mt * 16 + li, row = mb + rl;
      if (region <= 1 && isLat) {
        const int t = tb + rl;
#pragma unroll
        for (int nt = 0; nt < 2; ++nt)
          rope4(acc[mt][nt], acc[mt][nt + 2], ropeC + t * 32 + nt * 16 + g * 4, ropeS + t * 32 + nt * 16 + g * 4);
      }
#pragma unroll
      for (int nt = 0; nt < 4; ++nt) {
        const int col = nb + nt * 16 + g * 4;
        f32x4 v = acc[mt][nt];
        if (region == 0) {
          v *= qs;
          st_bf4((u16*)(P.ws + WS_Q) + (size_t)row * 1024 + col, v);
        } else if (region == 1) {
          const int c2 = col - 1024;
          if (!isLat) {
            st_f4(P.out + OUT_SK + ((size_t)((b * 2 + j) * 256 + sb + rl)) * 1024 + c2, v);
            st_bf4((u16*)(P.ws + WS_CTXK) + (size_t)row * 1024 + c2, v);
          } else {
            st_bf4((u16*)(P.ws + WS_KDLAT) + (size_t)j * KDLAT_J + ((size_t)(bl * 1280 + tb + rl)) * 1024 + c2, v);
          }
        } else {
#pragma unroll
          for (int jj = 0; jj < 4; ++jj) v[jj] = silu(v[jj]);
          st_bf4((u16*)(P.ws + WS_G) + (size_t)row * 1024 + (col - 3072), v);
        }
      }
    }
  }
}

DEVI void tile_mla_in(const Params& P, int j, int tile, u16* smem) {
  int tm_, tn_; patch_tile(xcd_remap(tile, 896), 14, 7, tm_, tn_);
  const int m0 = tm_ * 128, n0 = tn_ * 128;
  const u16* A = (const u16*)(P.ws + WS_H);
  const u16* B = (const u16*)(P.ws + WS_WMLAIN) + (size_t)j * 1792 * 1024;
  f32x4 acc[4][4];
  zero_acc(acc);
  gemm_core<true>(A, 1024, B, 1024, 1024, m0, n0, smem, acc);

  const int lane = tidx() & 63, w = tidx() >> 6, wm = w >> 1, wn = w & 1, g = lane >> 4, li = lane & 15;
  const int mb = m0 + wm * 64, nb = n0 + wn * 64;
  const bool isLat = mb >= 4096;
  const int b = mb >> 8, sb = mb & 255, bl = (mb - 4096) >> 10, tb = (mb - 4096) & 1023;
  const float* ropeC = (const float*)(P.ws + WS_ROPE);
  const float* ropeS = ropeC + 1024 * 32;
  if (nb >= 1728) return;
#pragma unroll
  for (int mt = 0; mt < 4; ++mt) {
    const int rl = mt * 16 + li, row = mb + rl;
    if (nb < 640) {
      float ss = 0.f;
#pragma unroll
      for (int nt = 0; nt < 4; ++nt)
#pragma unroll
        for (int jj = 0; jj < 4; ++jj) ss += acc[mt][nt][jj] * acc[mt][nt][jj];
      ss += xshfl(ss, 16);
      ss += xshfl(ss, 32);
      if (nb < 384) {
        if (g == 0) ((float*)(P.ws + WS_SSQQ))[row * 8 + (nb >> 6)] = ss;
#pragma unroll
        for (int nt = 0; nt < 4; ++nt)
          st_bf4((u16*)(P.ws + WS_QA) + (size_t)row * 384 + nb + nt * 16 + g * 4, acc[mt][nt]);
      } else {
        if (g == 0) ((float*)(P.ws + WS_SSQKV))[row * 4 + ((nb - 384) >> 6)] = ss;
        const int arow = isLat ? (4096 + bl * 1280 + tb + rl) : row;
#pragma unroll
        for (int nt = 0; nt < 4; ++nt) {
          const int c2 = nb - 384 + nt * 16 + g * 4;
          st_bf4((u16*)(P.ws + WS_CKVA) + (size_t)j * CKVA_J + (size_t)arow * 256 + c2, acc[mt][nt]);
          if (!isLat) st_f4((float*)(P.ws + WS_KVRAW) + (size_t)row * 256 + c2, acc[mt][nt]);
        }
      }
    } else if (nb == 640) {
      if (isLat) {
        const int t = tb + rl;
#pragma unroll
        for (int nt = 0; nt < 2; ++nt)
          rope4(acc[mt][nt], acc[mt][nt + 2], ropeC + t * 32 + nt * 16 + g * 4, ropeS + t * 32 + nt * 16 + g * 4);
      }
#pragma unroll
      for (int nt = 0; nt < 4; ++nt) {
        const int d = nt * 16 + g * 4;
        if (!isLat) {
          st_f4(P.out + OUT_KPE + ((size_t)((b * 2 + j) * 256 + sb + rl)) * 64 + d, acc[mt][nt]);
          u16* kd = (u16*)(P.ws + WS_CTXK) + ((size_t)(b * 8) * 256 + sb + rl) * 192 + 128 + d;
#pragma unroll
          for (int h = 0; h < 8; ++h) st_bf4(kd + (size_t)h * 256 * 192, acc[mt][nt]);
        } else {
          u16* kd = (u16*)(P.ws + WS_KMLAT) + (size_t)j * KMLAT_J + ((size_t)(bl * 8) * 1280 + tb + rl) * 192 + 128 + d;
#pragma unroll
          for (int h = 0; h < 8; ++h) st_bf4(kd + (size_t)h * 1280 * 192, acc[mt][nt]);
        }
      }
    } else {
#pragma unroll
      for (int nt = 0; nt < 4; ++nt) {
        f32x4 v = acc[mt][nt];
#pragma unroll
        for (int jj = 0; jj < 4; ++jj) v[jj] = silu(v[jj]);
        st_bf4((u16*)(P.ws + WS_G) + (size_t)row * 1024 + (nb - 704 + nt * 16 + g * 4), v);
      }
    }
  }
}

DEVI void tile_qb(const Params& P, int j, int tile, u16* smem) {
  int tm_, tn_; patch_tile(xcd_remap(tile, 768), 12, 6, tm_, tn_);
  const int m0 = tm_ * 128, n0 = tn_ * 128;
  const u16* A = (const u16*)(P.ws + WS_QA);
  const u16* B = (const u16*)(P.ws + WS_WQB) + (size_t)j * 1536 * 384;
  f32x4 acc[4][4];
  zero_acc(acc);
  gemm_core<true>(A, 384, B, 384, 384, m0, n0, smem, acc);
  const int lane = tidx() & 63, w = tidx() >> 6, wm = w >> 1, wn = w & 1, g = lane >> 4, li = lane & 15;
  const int mb = m0 + wm * 64, nb = n0 + wn * 64;
  const bool isLat = mb >= 4096;
  const int tb = (mb - 4096) & 1023;
  const float* ropeC = (const float*)(P.ws + WS_ROPE);
  const float* ropeS = ropeC + 1024 * 32;
  const float* ssq = (const float*)(P.ws + WS_SSQQ);
  const bool isRope = (nb % 192) == 128;
  const float qs = 0.07216878364870322f * LOG2E;
#pragma unroll
  for (int mt = 0; mt < 4; ++mt) {
    const int rl = mt * 16 + li, row = mb + rl;
    float ss = 0.f;
#pragma unroll
    for (int i = 0; i < 6; ++i) ss += ssq[row * 8 + i];
    const float r = rsqrtf(ss * (1.f / 384.f) + EPS) * qs;
    if (isRope && isLat) {
      const int t = tb + rl;
#pragma unroll
      for (int nt = 0; nt < 2; ++nt)
        rope4(acc[mt][nt], acc[mt][nt + 2], ropeC + t * 32 + nt * 16 + g * 4, ropeS + t * 32 + nt * 16 + g * 4);
    }
#pragma unroll
    for (int nt = 0; nt < 4; ++nt) {
      f32x4 v = acc[mt][nt] * r;
      st_bf4((u16*)(P.ws + WS_Q) + (size_t)row * 1536 + nb + nt * 16 + g * 4, v);
    }
  }
}

DEVI void tile_kvb(const Params& P, int j, int tile, u16* smem) {
  int tm_, tn_; patch_tile(xcd_remap(tile, 1152), 16, 8, tm_, tn_);
  const int m0 = tm_ * 128, n0 = tn_ * 128;
  const bool tileLat = m0 >= 4096;
  const bool fresh = !tileLat || ((m0 - 4096) % 1280) < 1024;
  const u16* A = (const u16*)(P.ws + WS_CKVA) + (size_t)j * CKVA_J;
  const u16* B = (const u16*)(P.ws + (fresh ? WS_WKVBG : WS_WKVB)) + (size_t)j * 2048 * 256;
  const bool isV = (n0 >> 7) & 1;
  const int h = n0 >> 8;
  f32x4 acc[4][4];
  zero_acc(acc);
  if (isV) gemm_core<false>(A, 256, B, 256, 256, m0, n0, smem, acc);
  else gemm_core<true>(A, 256, B, 256, 256, m0, n0, smem, acc);
  const int lane = tidx() & 63, w = tidx() >> 6, wm = w >> 1, wn = w & 1, g = lane >> 4, li = lane & 15;
  const int mb = m0 + wm * 64;
  int b, keyb, Sk, tokb;
  u16 *Kd, *Vd;
  if (!tileLat) {
    b = mb >> 8; keyb = mb & 255; Sk = 256; tokb = mb;
    Kd = (u16*)(P.ws + WS_CTXK); Vd = (u16*)(P.ws + WS_VTCTX);
  } else {
    const int r2 = mb - 4096;
    b = r2 / 1280; keyb = r2 % 1280; Sk = 1280; tokb = 4096 + b * 1024 + keyb;
    Kd = (u16*)(P.ws + WS_KMLAT) + (size_t)j * KMLAT_J; Vd = (u16*)(P.ws + WS_VTLATM);
  }
  const float* ssq = (const float*)(P.ws + WS_SSQKV);
  if (!isV) {
#pragma unroll
    for (int mt = 0; mt < 4; ++mt) {
      const int rl = mt * 16 + li;
      float r = 1.f;
      if (fresh) {
        const float4 s4 = *(const float4*)(ssq + (size_t)(tokb + rl) * 4);
        r = rsqrtf((s4.x + s4.y + s4.z + s4.w) * (1.f / 256.f) + EPS);
      }
#pragma unroll
      for (int nt = 0; nt < 4; ++nt) {
        const int dd = wn * 64 + nt * 16 + g * 4;
        st_bf4(Kd + ((size_t)((b * 8 + h) * Sk + keyb + rl)) * 192 + dd, acc[mt][nt] * r);
      }
    }
  } else {
#pragma unroll
    for (int mt = 0; mt < 4; ++mt) {
      const int r0 = mt * 16 + g * 4;
      f32x4 rr = {1.f, 1.f, 1.f, 1.f};
      if (fresh) {
#pragma unroll
        for (int jj = 0; jj < 4; ++jj) {
          const float4 s4 = *(const float4*)(ssq + (size_t)(tokb + r0 + jj) * 4);
          rr[jj] = rsqrtf((s4.x + s4.y + s4.z + s4.w) * (1.f / 256.f) + EPS);
        }
      }
#pragma unroll
      for (int nt = 0; nt < 4; ++nt) {
        const int e = wn * 64 + nt * 16 + li;
        st_bf4(Vd + ((size_t)((b * 8 + h) * 128 + e)) * Sk + keyb + r0, acc[mt][nt] * rr);
      }
    }
  }
}

DEVI void tile_out(const Params& P, int layer, int tile, u16* smem) {
  int tm_, tn_; patch_tile(xcd_remap(tile, 512), 8, 8, tm_, tn_);
  const int m0 = tm_ * 128, n0 = tn_ * 128;
  const u16* A = (const u16*)(P.ws + WS_O);
  const u16* B = (const u16*)(P.ws + WS_WOUT) + (size_t)layer * 1024 * 1024;
  f32x4 acc[4][4];
  zero_acc(acc);
  gemm_core<true>(A, 1024, B, 1024, 1024, m0, n0, smem, acc);
  const int lane = tidx() & 63, w = tidx() >> 6, wm = w >> 1, wn = w & 1, g = lane >> 4, li = lane & 15;
  const int mb = m0 + wm * 64, nb = n0 + wn * 64;
  float* T = (float*)(P.ws + WS_T);
#pragma unroll
  for (int mt = 0; mt < 4; ++mt)
#pragma unroll
    for (int nt = 0; nt < 4; ++nt)
      st_f4(T + (size_t)(mb + mt * 16 + li) * 1024 + nb + nt * 16 + g * 4, acc[mt][nt]);
}

template <bool DIFF>
DEVI void attn_item(const Params& P, const u16* __restrict__ Qb, int ldq, int qrow0,
                    const u16* __restrict__ Kb, int ldk, const u16* __restrict__ Vt, int Sk,
                    int h, float lam, float lam_init, const float* gsub, u16* smem) {
  constexpr int KW = DIFF ? 128 : 192;
  constexpr int KLD = KW + 16;
  constexpr int NKK = DIFF ? 2 : 6;
  constexpr int KT = DIFF ? 64 : 32;
  constexpr int NS = KT / 16;
  constexpr int NU = KT / 32;
  constexpr int KCH = KW / 8;
  constexpr int NKL = (KT * KCH) / 256;
  constexpr int VCH = KT / 8;
  constexpr int NVL = (128 * VCH) / 256;
  constexpr int VLD = KT + 8;
  u16* Ks = smem;
  u16* Vs = smem + KT * KLD;
  const int tid = tidx(), lane = tid & 63, w = tid >> 6, g = lane >> 4, li = lane & 15;

  bf16x8 qf[2][NKK];
#pragma unroll
  for (int s = 0; s < 2; ++s) {
    const int qrow = DIFF ? (qrow0 + w * 16 + li) : (qrow0 + w * 32 + s * 16 + li);
    const int qcol = DIFF ? (h * 128 + s * 64) : (h * 192);
#pragma unroll
    for (int kk = 0; kk < NKK; ++kk)
      qf[s][kk] = *(const bf16x8*)(Qb + (size_t)qrow * ldq + qcol + kk * 32 + g * 8);
  }
  f32x4 oacc[2][8];
#pragma unroll
  for (int s = 0; s < 2; ++s)
#pragma unroll
    for (int et = 0; et < 8; ++et) oacc[s][et] = (f32x4){0.f, 0.f, 0.f, 0.f};
  float mrow[2] = {-1e30f, -1e30f}, lrow[2] = {0.f, 0.f};

  u32x4 rk[NKL], rv[NVL];
  auto gload = [&](int key0) {
#pragma unroll
    for (int i = 0; i < NKL; ++i) {
      const int c = tid + 256 * i, r = c / KCH, cc = c % KCH;
      rk[i] = *(const u32x4*)(Kb + (size_t)(key0 + r) * ldk + cc * 8);
    }
#pragma unroll
    for (int i = 0; i < NVL; ++i) {
      const int c = tid + 256 * i, r = c / VCH, cc = c % VCH;
      rv[i] = *(const u32x4*)(Vt + (size_t)r * Sk + key0 + cc * 8);
    }
  };
  gload(0);
  const int NT = Sk / KT;
  for (int kt0 = 0; kt0 < NT; ++kt0) {
    __syncthreads();
#pragma unroll
    for (int i = 0; i < NKL; ++i) {
      const int c = tid + 256 * i, r = c / KCH, cc = c % KCH;
      *(u32x4*)(Ks + r * KLD + cc * 8) = rk[i];
    }
#pragma unroll
    for (int i = 0; i < NVL; ++i) {
      const int c = tid + 256 * i, r = c / VCH, cc = c % VCH;
      *(u32x4*)(Vs + r * VLD + cc * 8) = rv[i];
    }
    __syncthreads();
    if (kt0 + 1 < NT) gload((kt0 + 1) * KT);

    f32x4 st[2][NS];
#pragma unroll
    for (int s = 0; s < 2; ++s)
#pragma unroll
      for (int kt = 0; kt < NS; ++kt) st[s][kt] = (f32x4){0.f, 0.f, 0.f, 0.f};
#pragma unroll
    for (int kk = 0; kk < NKK; ++kk) {
#pragma unroll
      for (int kt = 0; kt < NS; ++kt) {
        if (DIFF) {
#pragma unroll
          for (int s = 0; s < 2; ++s) {
            const bf16x8 kf = *(const bf16x8*)(Ks + (kt * 16 + li) * KLD + s * 64 + kk * 32 + g * 8);
            st[s][kt] = mfma16(kf, qf[s][kk], st[s][kt]);
          }
        } else {
          const bf16x8 kf = *(const bf16x8*)(Ks + (kt * 16 + li) * KLD + kk * 32 + g * 8);
#pragma unroll
          for (int s = 0; s < 2; ++s) st[s][kt] = mfma16(kf, qf[s][kk], st[s][kt]);
        }
      }
    }
    bf16x8 pf[2][NU];
#pragma unroll
    for (int s = 0; s < 2; ++s) {
      float mx = st[s][0][0];
#pragma unroll
      for (int kt = 0; kt < NS; ++kt)
#pragma unroll
        for (int jj = 0; jj < 4; ++jj) mx = fmaxf(mx, st[s][kt][jj]);
      mx = fmaxf(mx, xshfl(mx, 16));
      mx = fmaxf(mx, xshfl(mx, 32));
      const float mnew = fmaxf(mrow[s], mx);
      const float alpha = exp2f(mrow[s] - mnew);
      mrow[s] = mnew;
      float ps = 0.f;
#pragma unroll
      for (int kt = 0; kt < NS; ++kt)
#pragma unroll
        for (int jj = 0; jj < 4; ++jj) {
          const float p = exp2f(st[s][kt][jj] - mnew);
          st[s][kt][jj] = p;
          ps += p;
        }
      lrow[s] = lrow[s] * alpha + ps;
#pragma unroll
      for (int et = 0; et < 8; ++et) oacc[s][et] *= alpha;
#pragma unroll
      for (int u = 0; u < NU; ++u) {
        union { bf16x8 v; unsigned d[4]; } pu;
        pu.d[0] = pk2(st[s][2 * u][0], st[s][2 * u][1]);
        pu.d[1] = pk2(st[s][2 * u][2], st[s][2 * u][3]);
        pu.d[2] = pk2(st[s][2 * u + 1][0], st[s][2 * u + 1][1]);
        pu.d[3] = pk2(st[s][2 * u + 1][2], st[s][2 * u + 1][3]);
        pf[s][u] = pu.v;
      }
    }
#pragma unroll
    for (int u = 0; u < NU; ++u) {
#pragma unroll
      for (int et = 0; et < 8; ++et) {
        union { bf16x8 v; u32x2 d[2]; } vu;
        vu.d[0] = *(const u32x2*)(Vs + (et * 16 + li) * VLD + (2 * u) * 16 + g * 4);
        vu.d[1] = *(const u32x2*)(Vs + (et * 16 + li) * VLD + (2 * u + 1) * 16 + g * 4);
#pragma unroll
        for (int s = 0; s < 2; ++s) oacc[s][et] = mfma16(vu.v, pf[s][u], oacc[s][et]);
      }
    }
  }
#pragma unroll
  for (int s = 0; s < 2; ++s) {
    lrow[s] += xshfl(lrow[s], 16);
    lrow[s] += xshfl(lrow[s], 32);
  }
  const u16* G = (const u16*)(P.ws + WS_G);
  u16* O = (u16*)(P.ws + WS_O);
  if (DIFF) {
    const float i0 = 1.f / lrow[0], i1 = lam / lrow[1];
    float ss = 0.f;
#pragma unroll
    for (int et = 0; et < 8; ++et) {
      oacc[0][et] = oacc[0][et] * i0 - oacc[1][et] * i1;
#pragma unroll
      for (int jj = 0; jj < 4; ++jj) ss += oacc[0][et][jj] * oacc[0][et][jj];
    }
    ss += xshfl(ss, 16);
    ss += xshfl(ss, 32);
    const float rr = rsqrtf(ss * (1.f / 128.f) + EPS) * (1.f - lam_init);
    const size_t tok = (size_t)(qrow0 + w * 16 + li);
#pragma unroll
    for (int et = 0; et < 8; ++et) {
      const int e = et * 16 + g * 4;
      const float4 gs = *(const float4*)(gsub + e);
      const uint2 gg = *(const uint2*)(G + tok * 1024 + h * 128 + e);
      f32x4 v = oacc[0][et] * rr;
      v[0] *= gs.x * bf2f(gg.x & 0xffffu);
      v[1] *= gs.y * bf2f(gg.x >> 16);
      v[2] *= gs.z * bf2f(gg.y & 0xffffu);
      v[3] *= gs.w * bf2f(gg.y >> 16);
      st_bf4(O + tok * 1024 + h * 128 + e, v);
    }
  } else {
#pragma unroll
    for (int s = 0; s < 2; ++s) {
      const float inv = 1.f / lrow[s];
      const size_t tok = (size_t)(qrow0 + w * 32 + s * 16 + li);
#pragma unroll
      for (int et = 0; et < 8; ++et) {
        const int e = et * 16 + g * 4;
        const uint2 gg = *(const uint2*)(G + tok * 1024 + h * 128 + e);
        f32x4 v = oacc[s][et] * inv;
        v[0] *= bf2f(gg.x & 0xffffu);
        v[1] *= bf2f(gg.x >> 16);
        v[2] *= bf2f(gg.y & 0xffffu);
        v[3] *= bf2f(gg.y >> 16);
        st_bf4(O + tok * 1024 + h * 128 + e, v);
      }
    }
  }
}

DEVI void attn_diff_phase(const Params& P, int j, u16* smem) {
  const float* lamv = (const float*)(P.ws + WS_MISC);
  const float lam = lamv[j * 2], lam_init = lamv[j * 2 + 1];
  const float* gsub = P.in[I_GSUB] + j * 128;
  const u16* Q = (const u16*)(P.ws + WS_Q);
  for (int it = blockIdx.x; it < 1024; it += gridDim.x) {
    if (it < 512) {
      const int iv = xcd_remap(it, 512);
      const int bl = iv >> 7, h = (iv >> 4) & 7, qt = iv & 15;
      const u16* Kb = (const u16*)(P.ws + WS_KDLAT) + (size_t)j * KDLAT_J + (size_t)bl * 1280 * 1024 + h * 128;
      const u16* Vt = (const u16*)(P.ws + WS_VTLATD) + (size_t)j * VTLATD_J + (size_t)(bl * 8 + h) * 128 * 1280;
      attn_item<true>(P, Q, 1024, 4096 + bl * 1024 + qt * 64, Kb, 1024, Vt, 1280, h, lam, lam_init, gsub, smem);
    } else {
      const int i2 = xcd_remap(it - 512, 512), b = i2 >> 5, h = (i2 >> 2) & 7, qt = i2 & 3;
      const u16* Kb = (const u16*)(P.ws + WS_CTXK) + (size_t)b * 256 * 1024 + h * 128;
      const u16* Vt = (const u16*)(P.ws + WS_VTCTX) + (size_t)(b * 8 + h) * 128 * 256;
      attn_item<true>(P, Q, 1024, b * 256 + qt * 64, Kb, 1024, Vt, 256, h, lam, lam_init, gsub, smem);
    }
  }
}

DEVI void attn_mla_phase(const Params& P, int j, u16* smem) {
  const u16* Q = (const u16*)(P.ws + WS_Q);
  for (int it = blockIdx.x; it < 512; it += gridDim.x) {
    if (it < 256) {
      const int iv = xcd_remap(it, 256);
      const int bl = iv >> 6, h = (iv >> 3) & 7, qt = iv & 7;
      const u16* Kb = (const u16*)(P.ws + WS_KMLAT) + (size_t)j * KMLAT_J + (size_t)(bl * 8 + h) * 1280 * 192;
      const u16* Vt = (const u16*)(P.ws + WS_VTLATM) + (size_t)(bl * 8 + h) * 128 * 1280;
      attn_item<false>(P, Q, 1536, 4096 + bl * 1024 + qt * 128, Kb, 192, Vt, 1280, h, 0.f, 0.f, nullptr, smem);
    } else {
      const int i2 = xcd_remap(it - 256, 256), b = i2 >> 4, h = (i2 >> 1) & 7, qt = i2 & 1;
      const u16* Kb = (const u16*)(P.ws + WS_CTXK) + (size_t)(b * 8 + h) * 256 * 192;
      const u16* Vt = (const u16*)(P.ws + WS_VTCTX) + (size_t)(b * 8 + h) * 128 * 256;
      attn_item<false>(P, Q, 1536, b * 256 + qt * 128, Kb, 192, Vt, 256, h, 0.f, 0.f, nullptr, smem);
    }
  }
}

DEVI float wave_sum(float v) {
  v += xshfl(v, 1); v += xshfl(v, 2); v += xshfl(v, 4); v += xshfl(v, 8); v += xshfl(v, 16); v += xshfl(v, 32);
  return v;
}

DEVI void ew_phase(const Params& P, int layer) {
  const int lane = tidx() & 63, w = tidx() >> 6;
  const float* ada = (const float*)(P.ws + WS_ADA);
  const float* T = (const float*)(P.ws + WS_T);
  u16* H = (u16*)(P.ws + WS_H);
  for (int row = blockIdx.x * 4 + w; row < 8192; row += gridDim.x * 4) {
    const int cond = row < 4096 ? 0 : 1 + ((row - 4096) >> 10);
    const float* xsrc = (layer <= 0) ? (row < 4096 ? P.in[I_XP] + (size_t)row * 1024 : P.in[I_XS] + (size_t)(row - 4096) * 1024)
                                     : P.out + OUT_Y + (size_t)row * 1024;
    float4 x[4];
#pragma unroll
    for (int i = 0; i < 4; ++i) x[i] = *(const float4*)(xsrc + lane * 4 + i * 256);
    if (layer >= 0) {
      float4 t[4];
      float ss = 0.f;
#pragma unroll
      for (int i = 0; i < 4; ++i) {
        t[i] = *(const float4*)(T + (size_t)row * 1024 + lane * 4 + i * 256);
        ss += t[i].x * t[i].x + t[i].y * t[i].y + t[i].z * t[i].z + t[i].w * t[i].w;
      }
      ss = wave_sum(ss);
      const float rt = rsqrtf(ss * (1.f / 1024.f) + EPS);
      const float* gate = ada + (size_t)(layer * 5 + cond) * 3072 + 2048;
      const float* gp = P.in[I_GPOST] + layer * 1024;
#pragma unroll
      for (int i = 0; i < 4; ++i) {
        const int c = lane * 4 + i * 256;
        const float4 ga = *(const float4*)(gate + c);
        const float4 gq = *(const float4*)(gp + c);
        x[i].x += ga.x * (t[i].x * rt * gq.x);
        x[i].y += ga.y * (t[i].y * rt * gq.y);
        x[i].z += ga.z * (t[i].z * rt * gq.z);
        x[i].w += ga.w * (t[i].w * rt * gq.w);
        *(float4*)(P.out + OUT_Y + (size_t)row * 1024 + c) = x[i];
      }
    }
    const int nl = layer + 1;
    if (nl < 4) {
      float ss = 0.f;
#pragma unroll
      for (int i = 0; i < 4; ++i) ss += x[i].x * x[i].x + x[i].y * x[i].y + x[i].z * x[i].z + x[i].w * x[i].w;
      ss = wave_sum(ss);
      const float rx = rsqrtf(ss * (1.f / 1024.f) + EPS);
      const float* sh = ada + (size_t)(nl * 5 + cond) * 3072;
      const float* sc = sh + 1024;
      const float* gpre = P.in[I_GPRE] + nl * 1024;
#pragma unroll
      for (int i = 0; i < 4; ++i) {
        const int c = lane * 4 + i * 256;
        const float4 s1 = *(const float4*)(sh + c);
        const float4 s2 = *(const float4*)(sc + c);
        const float4 gq = *(const float4*)(gpre + c);
        f32x4 hv;
        hv[0] = x[i].x * rx * gq.x * (1.f + s2.x) + s1.x;
        hv[1] = x[i].y * rx * gq.y * (1.f + s2.y) + s1.y;
        hv[2] = x[i].z * rx * gq.z * (1.f + s2.z) + s1.z;
        hv[3] = x[i].w * rx * gq.w * (1.f + s2.w) + s1.w;
        st_bf4(H + (size_t)row * 1024 + c, hv);
      }
    }
  }
}

DEVI void tr_tile(const float* __restrict__ src, int lds, int k0, int n0, int nvalid, u16* __restrict__ dst, int ldd,
                  const float* kscale, float* tile) {
  const int tid = tidx();
  __syncthreads();
#pragma unroll
  for (int i = 0; i < 16; ++i) {
    const int idx = tid + 256 * i, kk = idx >> 6, nn = idx & 63;
    float v = (n0 + nn < nvalid) ? src[(size_t)(k0 + kk) * lds + n0 + nn] : 0.f;
    if (kscale) v *= kscale[k0 + kk];
    tile[kk * 65 + nn] = v;
  }
  __syncthreads();
#pragma unroll
  for (int i = 0; i < 8; ++i) {
    const int idx = tid + 256 * i, nn = idx >> 5, kp = (idx & 31) * 2;
    *(unsigned*)(dst + (size_t)(n0 + nn) * ldd + k0 + kp) = pk2(tile[kp * 65 + nn], tile[(kp + 1) * 65 + nn]);
  }
}

constexpr int N_ADA = 384;
constexpr int N_TWOUT = 1024, N_TDAIN = 2048, N_TMLAIN = 896, N_TQB = 288, N_TKVB = 256, N_TCV = 512;
constexpr int N_ROPE = 128, N_LAM = 1, N_CDK = 1024, N_CCKV = 256, N_CKPE = 64;
constexpr int P0_ITEMS = N_ADA + N_TWOUT + N_TDAIN + N_TMLAIN + N_TQB + N_TKVB + N_TCV + N_ROPE + N_LAM + N_CDK + N_CCKV + N_CKPE;

DEVI void prep_phase(const Params& P, u16* smem) {
  float* fs = (float*)smem;
  const int tid = tidx();
  for (int item = blockIdx.x; item < P0_ITEMS; item += gridDim.x) {
    int it = item;
    if (it < N_ADA) {
      const int layer = it / 96, cgp = it % 96;
      float* sc = fs;
      float* red = fs + 5120;
      __syncthreads();
      for (int idx = tid; idx < 5120; idx += 256) {
        const int cnd = idx >> 10, k = idx & 1023;
        const float v = cnd == 0 ? P.in[I_CCTX][k] : P.in[I_C][(cnd - 1) * 1024 + k];
        sc[idx] = silu(v);
      }
      __syncthreads();
      const int col = tid & 31, kg = tid >> 5;
      const float* wp = P.in[I_WADA] + (size_t)layer * 1024 * 3072 + cgp * 32 + col;
      float a0 = 0.f, a1 = 0.f, a2 = 0.f, a3 = 0.f, a4 = 0.f;
#pragma unroll 8
      for (int k = kg * 128; k < kg * 128 + 128; ++k) {
        const float wv = wp[(size_t)k * 3072];
        a0 += sc[k] * wv; a1 += sc[1024 + k] * wv; a2 += sc[2048 + k] * wv; a3 += sc[3072 + k] * wv; a4 += sc[4096 + k] * wv;
      }
      red[(kg * 5 + 0) * 32 + col] = a0; red[(kg * 5 + 1) * 32 + col] = a1; red[(kg * 5 + 2) * 32 + col] = a2;
      red[(kg * 5 + 3) * 32 + col] = a3; red[(kg * 5 + 4) * 32 + col] = a4;
      __syncthreads();
      if (tid < 160) {
        const int cnd = tid >> 5, c2 = tid & 31;
        float s = P.in[I_BADA][layer * 3072 + cgp * 32 + c2];
#pragma unroll
        for (int q = 0; q < 8; ++q) s += red[(q * 5 + cnd) * 32 + c2];
        ((float*)(P.ws + WS_ADA))[(size_t)(layer * 5 + cnd) * 3072 + cgp * 32 + c2] = s;
      }
      continue;
    }
    it -= N_ADA;
    if (it < N_TWOUT) {
      const int l = it >> 8, kt = (it >> 4) & 15, nt = it & 15;
      tr_tile(P.in[I_WOUT] + (size_t)l * 1024 * 1024, 1024, kt * 64, nt * 64, 1024,
              (u16*)(P.ws + WS_WOUT) + (size_t)l * 1024 * 1024, 1024, nullptr, fs);
      continue;
    }
    it -= N_TWOUT;
    if (it < N_TDAIN) {
      const int l = it >> 10, kt = (it >> 6) & 15, nt = it & 63;
      tr_tile(P.in[I_DAWIN] + (size_t)l * 1024 * 4096, 4096, kt * 64, nt * 64, 4096,
              (u16*)(P.ws + WS_WDAIN) + (size_t)l * 4096 * 1024, 1024, nullptr, fs);
      continue;
    }
    it -= N_TDAIN;
    if (it < N_TMLAIN) {
      const int l = it / 448, r = it % 448, kt = r / 28, nt = r % 28;
      tr_tile(P.in[I_MWIN] + (size_t)l * 1024 * 1728, 1728, kt * 64, nt * 64, 1728,
              (u16*)(P.ws + WS_WMLAIN) + (size_t)l * 1792 * 1024, 1024, nullptr, fs);
      continue;
    }
    it -= N_TMLAIN;
    if (it < N_TQB) {
      const int l = it / 144, r = it % 144, kt = r / 24, nt = r % 24;
      tr_tile(P.in[I_WQB] + (size_t)l * 384 * 1536, 1536, kt * 64, nt * 64, 1536,
              (u16*)(P.ws + WS_WQB) + (size_t)l * 1536 * 384, 384, P.in[I_GQA] + l * 384, fs);
      continue;
    }
    it -= N_TQB;
    if (it < N_TKVB) {
      const int l = it >> 7, kt = (it >> 5) & 3, nt = it & 31;
      tr_tile(P.in[I_WKVB] + (size_t)l * 256 * 2048, 2048, kt * 64, nt * 64, 2048,
              (u16*)(P.ws + WS_WKVB) + (size_t)l * 2048 * 256, 256, nullptr, fs);
      tr_tile(P.in[I_WKVB] + (size_t)l * 256 * 2048, 2048, kt * 64, nt * 64, 2048,
              (u16*)(P.ws + WS_WKVBG) + (size_t)l * 2048 * 256, 256, P.in[I_GKVA] + l * 256, fs);
      continue;
    }
    it -= N_TKVB;
    if (it < N_TCV) {
      const int grp = it >> 3, sub = it & 7, bl = grp >> 4, jj = (grp >> 3) & 1, h = grp & 7, pt = sub >> 1, et = sub & 1;
      const float* src = P.in[I_CDV] + ((size_t)(bl * 2 + jj) * 256) * 1024 + h * 128;
      u16* dst = (u16*)(P.ws + WS_VTLATD) + (size_t)jj * VTLATD_J + (size_t)(bl * 8 + h) * 128 * 1280 + 1024;
      tr_tile(src, 1024, pt * 64, et * 64, 128, dst, 1280, nullptr, fs);
      continue;
    }
    it -= N_TCV;
    if (it < N_ROPE) {
      const int idx = it * 256 + tid, t = idx >> 5, p = idx & 31, f = p & 15;
      const float inv = exp2f(-(float)f * (13.287712379549449f / 16.f));
      const float pos = (p < 16) ? (float)(t >> 6) : (float)(t & 63);
      float sn, cs;
      sincosf(pos * inv, &sn, &cs);
      float* rc = (float*)(P.ws + WS_ROPE);
      rc[idx] = cs;
      rc[1024 * 32 + idx] = sn;
      continue;
    }
    it -= N_ROPE;
    if (it < N_LAM) {
      if (tid < 2) {
        const int jd = tid;
        float s1 = 0.f, s2 = 0.f;
        for (int d = 0; d < 64; ++d) {
          s1 += P.in[I_LQ1][jd * 64 + d] * P.in[I_LK1][jd * 64 + d];
          s2 += P.in[I_LQ2][jd * 64 + d] * P.in[I_LK2][jd * 64 + d];
        }
        const float li = 0.8f - 0.6f * expf(-0.3f * (float)(2 * jd));
        float* lamv = (float*)(P.ws + WS_MISC);
        lamv[jd * 2] = expf(s1) - expf(s2) + li;
        lamv[jd * 2 + 1] = li;
      }
      continue;
    }
    it -= N_LAM;
    if (it < N_CDK) {
      const size_t e0 = ((size_t)it * 256 + tid) * 8;
      const int col = e0 & 1023, p = (e0 >> 10) & 255, jj = (e0 >> 18) & 1, bl = (int)(e0 >> 19);
      const float4 a = *(const float4*)(P.in[I_CDK] + e0);
      const float4 b = *(const float4*)(P.in[I_CDK] + e0 + 4);
      uint4 u; u.x = pk2(a.x, a.y); u.y = pk2(a.z, a.w); u.z = pk2(b.x, b.y); u.w = pk2(b.z, b.w);
      *(uint4*)((u16*)(P.ws + WS_KDLAT) + (size_t)jj * KDLAT_J + ((size_t)(bl * 1280 + 1024 + p)) * 1024 + col) = u;
      continue;
    }
    it -= N_CDK;
    if (it < N_CCKV) {
      const size_t e0 = ((size_t)it * 256 + tid) * 8;
      const int col = e0 & 255, p = (e0 >> 8) & 255, jj = (e0 >> 16) & 1, bl = (int)(e0 >> 17);
      const float4 a = *(const float4*)(P.in[I_CCKV] + e0);
      const float4 b = *(const float4*)(P.in[I_CCKV] + e0 + 4);
      uint4 u; u.x = pk2(a.x, a.y); u.y = pk2(a.z, a.w); u.z = pk2(b.x, b.y); u.w = pk2(b.z, b.w);
      *(uint4*)((u16*)(P.ws + WS_CKVA) + (size_t)jj * CKVA_J + ((size_t)(4096 + bl * 1280 + 1024 + p)) * 256 + col) = u;
      continue;
    }
    it -= N_CCKV;
    {
      const size_t e0 = ((size_t)it * 256 + tid) * 8;
      const int d = e0 & 63, p = (e0 >> 6) & 255, jj = (e0 >> 14) & 1, bl = (int)(e0 >> 15);
      const float4 a = *(const float4*)(P.in[I_CKPE] + e0);
      const float4 b = *(const float4*)(P.in[I_CKPE] + e0 + 4);
      uint4 u; u.x = pk2(a.x, a.y); u.y = pk2(a.z, a.w); u.z = pk2(b.x, b.y); u.w = pk2(b.z, b.w);
      u16* dst = (u16*)(P.ws + WS_KMLAT) + (size_t)jj * KMLAT_J + ((size_t)(bl * 8) * 1280 + 1024 + p) * 192 + 128 + d;
#pragma unroll
      for (int h = 0; h < 8; ++h) *(uint4*)(dst + (size_t)h * 1280 * 192) = u;
    }
  }
}

DEVI void mla_b_phase(const Params& P, int j, u16* smem) {
  constexpr int NQ = 64 * 12, NKV = 72 * 16, NNORM = 64;
  for (int it = blockIdx.x; it < NKV + NQ + NNORM; it += gridDim.x) {
    if (it < NKV) tile_kvb(P, j, it, smem);
    else if (it < NKV + NQ) tile_qb(P, j, it - NKV, smem);
    else {
      const int lane = tidx() & 63, w = tidx() >> 6;
      const float* ssq = (const float*)(P.ws + WS_SSQKV);
      const float4 gk = *(const float4*)(P.in[I_GKVA] + j * 256 + lane * 4);
      for (int r = w; r < 64; r += 4) {
        const int row = (it - NKV - NQ) * 64 + r;
        const float4 s4 = *(const float4*)(ssq + (size_t)row * 4);
        const float rr = rsqrtf((s4.x + s4.y + s4.z + s4.w) * (1.f / 256.f) + EPS);
        float* p = P.out + OUT_CKV + ((size_t)(((row >> 8) * 2 + j) * 256 + (row & 255))) * 256 + lane * 4;
        float4 v = *(const float4*)((const float*)(P.ws + WS_KVRAW) + (size_t)row * 256 + lane * 4);
        v.x *= rr * gk.x; v.y *= rr * gk.y; v.z *= rr * gk.z; v.w *= rr * gk.w;
        *(float4*)p = v;
      }
    }
  }
}


#define XB_TMO      128
#define XB_XCNT(j)  (256  + 64 * (j))
#define XB_XSUB(j)  (1280 + 64 * (j))
#define XB_XGEN(j)  (2304 + 64 * (j))
#define XB_TOP      3328
#define XB_TOPGEN   3392
#define XCD_BAR_WORDS 3456
#define XB_SPIN_CAP (1u << 22)
#define LAS __attribute__((address_space(3)))
DEVI unsigned xb_ld(unsigned* p) { return __hip_atomic_load(p, __ATOMIC_RELAXED, __HIP_MEMORY_SCOPE_AGENT); }
DEVI unsigned xb_add(unsigned* p, unsigned v) { return __hip_atomic_fetch_add(p, v, __ATOMIC_RELAXED, __HIP_MEMORY_SCOPE_AGENT); }
DEVI unsigned xb_xcc_id() { return (unsigned)__builtin_amdgcn_s_getreg((3 << 11) | 20) & 0xFu; }
#define XB_SPIN(cond, bar) do { unsigned _sp = 0; while (cond) { __builtin_amdgcn_s_sleep(1); \
    if ((++_sp & 255u) == 0u) { if (xb_ld(&(bar)[XB_TMO])) break; if (_sp > XB_SPIN_CAP) { atomicAdd(&(bar)[XB_TMO], 1u); break; } } } } while (0)
struct XcdBarrier { unsigned* bar; unsigned x; volatile LAS unsigned* st; };
DEVI XcdBarrier xcd_barrier_post(unsigned* bar, volatile LAS unsigned* st) {
  XcdBarrier b; b.bar = bar; b.x = xb_xcc_id(); b.st = st;
  if (threadIdx.x == 0) (void)xb_add(&bar[XB_XCNT(b.x)], 1u);
  return b;
}
DEVI void xcd_barrier_complete(unsigned* bar, unsigned x, unsigned& nloc, unsigned& nx) {
  const unsigned G = gridDim.x * gridDim.y * gridDim.z;
  unsigned sum, cnt, mine, sp = 0u;
  for (;;) {
    sum = 0u; cnt = 0u; mine = 0u;
#pragma unroll
    for (unsigned j = 0; j < 16; ++j) { const unsigned c = xb_ld(&bar[XB_XCNT(j)]); sum += c; cnt += (c > 0u) ? 1u : 0u; mine = (j == x) ? c : mine; }
    if (sum == G) break;
    __builtin_amdgcn_s_sleep(1);
    if ((++sp & 255u) == 0u) { if (xb_ld(&bar[XB_TMO])) break; if (sp > XB_SPIN_CAP) { atomicAdd(&bar[XB_TMO], 1u); break; } }
  }
  nloc = mine > 0u ? mine : 1u; nx = cnt > 0u ? cnt : 1u;
}
DEVI void xcd_barrier(const XcdBarrier& b) {
  asm volatile("s_waitcnt vmcnt(0)" ::: "memory");
  __syncthreads();
  if (threadIdx.x == 0) {
    unsigned* bar = b.bar;
    __builtin_amdgcn_s_waitcnt(0);
    unsigned nloc = b.st[0], nx = b.st[1];
    if (nloc == 0u) { xcd_barrier_complete(bar, b.x, nloc, nx); b.st[0] = nloc; b.st[1] = nx; }
    const unsigned old = xb_add(&bar[XB_XSUB(b.x)], 1u);
    const unsigned gen = old / nloc;
    if (old + 1u == (gen + 1u) * nloc) {
      __builtin_amdgcn_fence(__ATOMIC_RELEASE, "agent");
      asm volatile("s_waitcnt vmcnt(0)" ::: "memory");
      const unsigned og = xb_add(&bar[XB_TOP], 1u);
      const unsigned tg = og / nx;
      if (og + 1u == (tg + 1u) * nx) xb_add(&bar[XB_TOPGEN], 1u);
      else XB_SPIN(xb_ld(&bar[XB_TOPGEN]) == tg, bar);
      __builtin_amdgcn_fence(__ATOMIC_ACQUIRE, "agent");
      xb_add(&bar[XB_XGEN(b.x)], 1u);
      asm volatile("s_waitcnt vmcnt(0)" ::: "memory");
    } else {
      XB_SPIN(xb_ld(&bar[XB_XGEN(b.x)]) == gen, bar);
      __builtin_amdgcn_fence(__ATOMIC_ACQUIRE, "agent");
      asm volatile("s_waitcnt vmcnt(0)" ::: "memory");
    }
  }
  __syncthreads();
}
constexpr size_t WS_BAR = WS_MISC + 65536;

#ifndef EN
#define EN 0xFF
#endif
DEVI void run_phase(const Params& P, int ph, u16* smem) {
  if (ph == 0) { if (EN & 1) prep_phase(P, smem); return; }
  if (ph == 1) { if (EN & 2) ew_phase(P, -1); return; }
  int layer, sub;
  if (ph < 6) { layer = 0; sub = ph - 2; }
  else if (ph < 11) { layer = 1; sub = ph - 6; }
  else if (ph < 15) { layer = 2; sub = ph - 11; }
  else { layer = 3; sub = ph - 15; }
  const int j = layer >> 1;
  if ((layer & 1) == 0) {
    if (sub == 0) { if (EN & 4) for (int t = blockIdx.x; t < 64 * 32; t += gridDim.x) tile_diff_in(P, j, t, smem); }
    else if (sub == 1) { if (EN & 8) attn_diff_phase(P, j, smem); }
    else if (sub == 2) { if (EN & 16) for (int t = blockIdx.x; t < 64 * 8; t += gridDim.x) tile_out(P, layer, t, smem); }
    else { if (EN & 2) ew_phase(P, layer); }
  } else {
    if (sub == 0) { if (EN & 32) for (int t = blockIdx.x; t < 64 * 14; t += gridDim.x) tile_mla_in(P, j, t, smem); }
    else if (sub == 1) { if (EN & 64) mla_b_phase(P, j, smem); }
    else if (sub == 2) { if (EN & 128) attn_mla_phase(P, j, smem); }
    else if (sub == 3) { if (EN & 16) for (int t = blockIdx.x; t < 64 * 8; t += gridDim.x) tile_out(P, layer, t, smem); }
    else { if (EN & 2) ew_phase(P, layer); }
  }
}

constexpr int N_PHASES = 20;

__global__ void __launch_bounds__(256, 2) fwd_megakernel(Params P) {
  __shared__ __attribute__((aligned(16))) u16 smem[SMEM_BYTES / 2];
  __shared__ uint4 xb_words;
  if (threadIdx.x == 0) xb_words = make_uint4(0u, 0u, 0u, 0u);
  __syncthreads();
  XcdBarrier xb = xcd_barrier_post((unsigned*)(P.ws + WS_BAR), (volatile LAS unsigned*)&xb_words);
  for (int ph = P.ph_lo; ph < P.ph_hi; ++ph) {
    Params Pl = P;
    {
      size_t zoff = 0;
      asm volatile("" : "+s"(zoff));
      Pl.ws = P.ws + zoff;
      Pl.out = P.out + zoff;
    }
    run_phase(Pl, ph, smem);
#ifdef REP_MASK
    {
      int kind;
      if (ph == 0) kind = 1; else if (ph == 1) kind = 2;
      else { int layer, sub; if (ph < 6) { layer = 0; sub = ph - 2; } else if (ph < 11) { layer = 1; sub = ph - 6; } else if (ph < 15) { layer = 2; sub = ph - 11; } else { layer = 3; sub = ph - 15; }
        if ((layer & 1) == 0) kind = sub == 0 ? 4 : sub == 1 ? 8 : sub == 2 ? 16 : 2;
        else kind = sub == 0 ? 32 : sub == 1 ? 64 : sub == 2 ? 128 : sub == 3 ? 16 : 2; }
      if (kind & REP_MASK) { xcd_barrier(xb); run_phase(Pl, ph, smem); }
    }
#endif
    if (ph + 1 < P.ph_hi) {
      if (P.ph_hi > 1000) cg::this_grid().sync();
      xcd_barrier(xb);
    }
#ifdef EXTRA_SYNCS
    for (int q = 0; q < EXTRA_SYNCS; ++q) xcd_barrier(xb);
#endif
  }
}

extern "C" void kernel_launch(void* const* d_in, const int* in_sizes, int n_in, void* d_out, int out_size, void* d_ws,
                              size_t ws_size, hipStream_t stream) {
  static int grid_blocks = 0;
  if (!grid_blocks) {
    int dev = 0, cus = 0, per_cu = 0;
    (void)hipGetDevice(&dev);
    (void)hipDeviceGetAttribute(&cus, hipDeviceAttributeMultiprocessorCount, dev);
    (void)hipOccupancyMaxActiveBlocksPerMultiprocessor(&per_cu, fwd_megakernel, 256, 0);
    if (per_cu < 1) per_cu = 1;
    if (per_cu > 2) per_cu = 2;
    grid_blocks = cus * per_cu;
  }
  if (hipMemsetAsync((unsigned char*)d_ws + WS_BAR, 0, 16384, stream) != hipSuccess) { fprintf(stderr, "memset failed\n"); return; }
  Params p{};
  for (int i = 0; i < 24; ++i) p.in[i] = (const float*)d_in[i];
  p.out = (float*)d_out;
  p.ws = (unsigned char*)d_ws;
#if MULTI_LAUNCH
  for (int ph = 0; ph < N_PHASES; ++ph) {
    p.ph_lo = ph; p.ph_hi = ph + 1;
    hipLaunchKernelGGL(fwd_megakernel, dim3(grid_blocks), dim3(256), 0, stream, p);
  }
#else
  p.ph_lo = 0; p.ph_hi = N_PHASES;
  void* args[] = {&p};
  hipError_t e = hipLaunchCooperativeKernel((void*)fwd_megakernel, dim3(grid_blocks), dim3(256), args, 0, stream);
  if (e != hipSuccess) fprintf(stderr, "cooperative launch failed: %s (grid %d)\n", hipGetErrorString(e), grid_blocks);
#endif
}
```

```cpp
#include <hip/hip_runtime.h>
#include <hip/hip_cooperative_groups.h>
#include <cstdio>
namespace cg = cooperative_groups;

#ifndef MULTI_LAUNCH
#define MULTI_LAUNCH 0
#endif

typedef unsigned short u16;
typedef __attribute__((ext_vector_type(8))) short bf16x8;
typedef __attribute__((ext_vector_type(4))) float f32x4;
typedef __attribute__((ext_vector_type(4))) unsigned u32x4;
typedef __attribute__((ext_vector_type(2))) unsigned u32x2;

#define DEVI __device__ __forceinline__

struct Params {
  const float* in[24];
  float* out;
  unsigned char* ws;
  int ph_lo, ph_hi;
};

constexpr size_t MBy = 1u << 20;
constexpr size_t WS_WOUT = 0;
constexpr size_t WS_WDAIN = 8 * MBy;
constexpr size_t WS_WMLAIN = 24 * MBy;
constexpr size_t WS_WQB = 31 * MBy;
constexpr size_t WS_WKVB = 34 * MBy;
constexpr size_t WS_WKVBG = 36 * MBy;
constexpr size_t WS_ADA = 38 * MBy;
constexpr size_t WS_ROPE = 39 * MBy;
constexpr size_t WS_MISC = 40 * MBy;
constexpr size_t WS_H = 41 * MBy;
constexpr size_t WS_O = WS_H;
constexpr size_t WS_Q = 57 * MBy;
constexpr size_t WS_T = WS_Q;
constexpr size_t WS_CTXK = 81 * MBy;
constexpr size_t WS_KDLAT = 93 * MBy;
constexpr size_t WS_VTCTX = 113 * MBy;
constexpr size_t WS_VTLATD = 121 * MBy;
constexpr size_t WS_VTLATM = 141 * MBy;
constexpr size_t WS_G = 151 * MBy;
constexpr size_t WS_QA = 167 * MBy;
constexpr size_t WS_CKVA = 173 * MBy;
constexpr size_t WS_SSQQ = 183 * MBy;
constexpr size_t WS_SSQKV = 184 * MBy;
constexpr size_t WS_KMLAT = 185 * MBy;
constexpr size_t WS_KVRAW = 215 * MBy;
constexpr size_t KDLAT_J = (size_t)4 * 1280 * 1024;
constexpr size_t VTLATD_J = (size_t)4 * 8 * 128 * 1280;
constexpr size_t CKVA_J = (size_t)9216 * 256;
constexpr size_t KMLAT_J = (size_t)4 * 8 * 1280 * 192;

constexpr size_t OUT_Y = 0;
constexpr size_t OUT_SK = 8388608;
constexpr size_t OUT_SV = 16777216;
constexpr size_t OUT_CKV = 25165824;
constexpr size_t OUT_KPE = 27262976;

constexpr float EPS = 1e-6f;
constexpr float LOG2E = 1.4426950408889634f;

enum { I_XP = 0, I_XS, I_CDK, I_CDV, I_CCKV, I_CKPE, I_C, I_CCTX, I_WADA, I_BADA, I_GPRE, I_GPOST, I_WOUT,
       I_DAWIN, I_LQ1, I_LK1, I_LQ2, I_LK2, I_GSUB, I_MWIN, I_GQA, I_WQB, I_GKVA, I_WKVB };

DEVI int tidx() { int t = threadIdx.x; asm volatile("" : "+v"(t)); return t; }
DEVI u16 f2bf(float f) {
  unsigned u = __float_as_uint(f);
  u += 0x7fffu + ((u >> 16) & 1u);
  return (u16)(u >> 16);
}
typedef __attribute__((ext_vector_type(2))) float f32x2_t;
typedef __attribute__((ext_vector_type(2))) __bf16 bf16x2_t;
DEVI unsigned pk2(float a, float b) {
  f32x2_t v = {a, b};
  bf16x2_t r = __builtin_convertvector(v, bf16x2_t);
  return __builtin_bit_cast(unsigned, r);
}
DEVI float bf2f(unsigned v) { return __uint_as_float(v << 16); }
DEVI void st_bf4(u16* p, f32x4 v) {
  uint2 u; u.x = pk2(v[0], v[1]); u.y = pk2(v[2], v[3]);
  *(uint2*)p = u;
}
DEVI void st_f4(float* p, f32x4 v) { *(float4*)p = make_float4(v[0], v[1], v[2], v[3]); }
DEVI f32x4 mfma16(bf16x8 a, bf16x8 b, f32x4 c) { return __builtin_amdgcn_mfma_f32_16x16x32_bf16(a, b, c, 0, 0, 0); }
DEVI float silu(float x) { return x * __builtin_amdgcn_rcpf(1.f + __builtin_amdgcn_exp2f(-1.4426950408889634f * x)); }
DEVI float xshfl(float v, int m) { return __shfl_xor(v, m, 64); }

DEVI void rope4(f32x4& x1, f32x4& x2, const float* cs, const float* sn) {
  float4 c = *(const float4*)cs; float4 s = *(const float4*)sn;
  f32x4 a = x1, b = x2;
  x1[0] = a[0] * c.x - b[0] * s.x; x2[0] = a[0] * s.x + b[0] * c.x;
  x1[1] = a[1] * c.y - b[1] * s.y; x2[1] = a[1] * s.y + b[1] * c.y;
  x1[2] = a[2] * c.z - b[2] * s.z; x2[2] = a[2] * s.z + b[2] * c.z;
  x1[3] = a[3] * c.w - b[3] * s.w; x2[3] = a[3] * s.w + b[3] * c.w;
}

constexpr int LDT = 64;
constexpr int TILE_ELEMS = 128 * LDT;
constexpr int SMEM_BYTES = (256 + 128) * 64 * 2;

template <bool SWAP>
DEVI void gemm_core(const u16* __restrict__ A, int lda, const u16* __restrict__ B, int ldb, int K,
                    int m0, int n0, u16* smem, f32x4 (&acc)[8][4]) {
  const int tid = tidx(), lane = tid & 63, w = tid >> 6;
  const int wm = w >> 1, wn = w & 1;
  const int g = lane >> 4, li = lane & 15;
  u16* As = smem;
  u16* Bs = smem + 256 * 64;
  const int lr = tid >> 3, lc = (tid & 7) * 8;
  const u16* ap = A + (size_t)(m0 + lr) * lda + lc;
  const u16* bp = B + (size_t)(n0 + lr) * ldb + lc;
  const int wsw = (((tid & 7) ^ (lr & 7)) * 8);
  u16* sa = As + lr * 64 + wsw;
  u16* sb = Bs + lr * 64 + wsw;
  const int rs0 = ((g ^ (li & 7)) * 8), rs1 = (((4 + g) ^ (li & 7)) * 8);
  const u16* Ard = As + (wm * 128 + li) * 64;
  const u16* Brd = Bs + (wn * 64 + li) * 64;
  u32x4 ra[8], rb[4];
#define GLOAD(KT_) { const int k0_ = (KT_) << 6; \
    _Pragma("unroll") for (int i = 0; i < 8; ++i) ra[i] = *(const u32x4*)(ap + (size_t)i * 32 * lda + k0_); \
    _Pragma("unroll") for (int i = 0; i < 4; ++i) rb[i] = *(const u32x4*)(bp + (size_t)i * 32 * ldb + k0_); }
#define SSTORE() { _Pragma("unroll") for (int i = 0; i < 8; ++i) *(u32x4*)(sa + 32 * i * 64) = ra[i]; \
    _Pragma("unroll") for (int i = 0; i < 4; ++i) *(u32x4*)(sb + 32 * i * 64) = rb[i]; }
#define FRAGS(RS) { _Pragma("unroll") for (int t = 0; t < 8; ++t) fa[t] = *(const bf16x8*)(Ard + t * 16 * 64 + (RS)); \
    _Pragma("unroll") for (int t = 0; t < 4; ++t) fb[t] = *(const bf16x8*)(Brd + t * 16 * 64 + (RS)); }
#define MMA() _Pragma("unroll") for (int mt = 0; mt < 8; ++mt) _Pragma("unroll") for (int nt = 0; nt < 4; ++nt) \
      acc[mt][nt] = SWAP ? mfma16(fb[nt], fa[mt], acc[mt][nt]) : mfma16(fa[mt], fb[nt], acc[mt][nt]);
  const int KT = K >> 6;
  bf16x8 fa[8], fb[4];
  GLOAD(0);
  for (int kt = 0; kt < KT; ++kt) {
    __syncthreads();
    SSTORE();
    __syncthreads();
    GLOAD((kt + 1 < KT ? kt + 1 : KT - 1));
    FRAGS(rs0);
    __builtin_amdgcn_sched_barrier(0);
    MMA();
    __builtin_amdgcn_sched_barrier(0);
    FRAGS(rs1);
    __builtin_amdgcn_sched_barrier(0);
    MMA();
  }
#undef GLOAD
#undef SSTORE
#undef FRAGS
#undef MMA
}

DEVI void zero_acc(f32x4 (&acc)[8][4]) {
#pragma unroll
  for (int i = 0; i < 8; ++i)
#pragma unroll
    for (int k = 0; k < 4; ++k) acc[i][k] = (f32x4){0.f, 0.f, 0.f, 0.f};
}


DEVI int xcd_remap(int l, int total) {
  int q = l >> 3;
  if ((q | 63) < (total >> 3))
    q = (q & ~63) | ((q & 31) << 1) | ((q >> 5) & 1);
  return (l & 7) * (total >> 3) + q;
}
DEVI void patch_tile(int v, int NT, int PN, int& mt, int& nt) {
  const int psz = 4 * PN, p = v / psz, i = v - p * psz, npn = NT / PN;
  const int pm = p / npn, pn = p - pm * npn;
  const int im = i / PN, in = i - im * PN;
  mt = pm * 4 + im;
  nt = pn * PN + in;
}

DEVI void tile_diff_in(const Params& P, int j, int tile, u16* smem) {
  int tm_, tn_; patch_tile(xcd_remap(tile, 1024), 32, 8, tm_, tn_);
  const int m0 = tm_ * 256, n0 = tn_ * 128;
  const int region = n0 >> 10;
  const u16* A = (const u16*)(P.ws + WS_H);
  const u16* B = (const u16*)(P.ws + WS_WDAIN) + (size_t)j * 4096 * 1024;
  f32x4 acc[8][4];
  zero_acc(acc);
  if (region == 2) gemm_core<false>(A, 1024, B, 1024, 1024, m0, n0, smem, acc);
  else gemm_core<true>(A, 1024, B, 1024, 1024, m0, n0, smem, acc);

  const int lane = tidx() & 63, w = tidx() >> 6, wm = w >> 1, wn = w & 1, g = lane >> 4, li = lane & 15;
  const int mb = m0 + wm * 128, nb = n0 + wn * 64;
  const bool isLat = mb >= 4096;
  const int b = mb >> 8, sb = mb & 255, bl = (mb - 4096) >> 10, tb = (mb - 4096) & 1023;
  const float* ropeC = (const float*)(P.ws + WS_ROPE);
  const float* ropeS = ropeC + 1024 * 32;
  if (region == 2) {
    const int cbase = nb - 2048;
    u16* vtc = (u16*)(P.ws + WS_VTCTX);
    u16* vtl = (u16*)(P.ws + WS_VTLATD) + (size_t)j * VTLATD_J;
#pragma unroll
    for (int mt = 0; mt < 8; ++mt) {
      const int r0 = mt * 16 + g * 4;
#pragma unroll
      for (int nt = 0; nt < 4; ++nt) {
        const int col = cbase + nt * 16 + li, h = col >> 7, e = col & 127;
        if (!isLat) {
          const int s = sb + r0;
          float* sv = P.out + OUT_SV + ((size_t)((b * 2 + j) * 256 + s)) * 1024 + col;
#pragma unroll
          for (int jj = 0; jj < 4; ++jj) sv[(size_t)jj * 1024] = acc[mt][nt][jj];
          st_bf4(vtc + ((size_t)((b * 8 + h) * 128 + e)) * 256 + s, acc[mt][nt]);
        } else {
          const int t = tb + r0;
          st_bf4(vtl + ((size_t)((bl * 8 + h) * 128 + e)) * 1280 + t, acc[mt][nt]);
        }
      }
    }
  } else {
    const float qs = 0.125f * LOG2E;
#pragma unroll
    for (int mt = 0; mt < 8; ++mt) {
      const int rl = mt * 16 + li, row = mb + rl;
      if (region <= 1 && isLat) {
        const int t = tb + rl;
#pragma unroll
        for (int nt = 0; nt < 2; ++nt)
          rope4(acc[mt][nt], acc[mt][nt + 2], ropeC + t * 32 + nt * 16 + g * 4, ropeS + t * 32 + nt * 16 + g * 4);
      }
#pragma unroll
      for (int nt = 0; nt < 4; ++nt) {
        const int col = nb + nt * 16 + g * 4;
        f32x4 v = acc[mt][nt];
        if (region == 0) {
          v *= qs;
          st_bf4((u16*)(P.ws + WS_Q) + (size_t)row * 1024 + col, v);
        } else if (region == 1) {
          const int c2 = col - 1024;
          if (!isLat) {
            st_f4(P.out + OUT_SK + ((size_t)((b * 2 + j) * 256 + sb + rl)) * 1024 + c2, v);
            st_bf4((u16*)(P.ws + WS_CTXK) + (size_t)row * 1024 + c2, v);
          } else {
            st_bf4((u16*)(P.ws + WS_KDLAT) + (size_t)j * KDLAT_J + ((size_t)(bl * 1280 + tb + rl)) * 1024 + c2, v);
          }
        } else {
#pragma unroll
          for (int jj = 0; jj < 4; ++jj) v[jj] = silu(v[jj]);
          st_bf4((u16*)(P.ws + WS_G) + (size_t)row * 1024 + (col - 3072), v);
        }
      }
    }
  }
}

DEVI void tile_mla_in(const Params& P, int j, int tile, u16* smem) {
  int tm_, tn_; patch_tile(xcd_remap(tile, 448), 14, 7, tm_, tn_);
  const int m0 = tm_ * 256, n0 = tn_ * 128;
  const u16* A = (const u16*)(P.ws + WS_H);
  const u16* B = (const u16*)(P.ws + WS_WMLAIN) + (size_t)j * 1792 * 1024;
  f32x4 acc[8][4];
  zero_acc(acc);
  gemm_core<true>(A, 1024, B, 1024, 1024, m0, n0, smem, acc);

  const int lane = tidx() & 63, w = tidx() >> 6, wm = w >> 1, wn = w & 1, g = lane >> 4, li = lane & 15;
  const int mb = m0 + wm * 128, nb = n0 + wn * 64;
  const bool isLat = mb >= 4096;
  const int b = mb >> 8, sb = mb & 255, bl = (mb - 4096) >> 10, tb = (mb - 4096) & 1023;
  const float* ropeC = (const float*)(P.ws + WS_ROPE);
  const float* ropeS = ropeC + 1024 * 32;
  if (nb >= 1728) return;
#pragma unroll
  for (int mt = 0; mt < 8; ++mt) {
    const int rl = mt * 16 + li, row = mb + rl;
    if (nb < 640) {
      float ss = 0.f;
#pragma unroll
      for (int nt = 0; nt < 4; ++nt)
#pragma unroll
        for (int jj = 0; jj < 4; ++jj) ss += acc[mt][nt][jj] * acc[mt][nt][jj];
      ss += xshfl(ss, 16);
      ss += xshfl(ss, 32);
      if (nb < 384) {
        if (g == 0) ((float*)(P.ws + WS_SSQQ))[row * 8 + (nb >> 6)] = ss;
#pragma unroll
        for (int nt = 0; nt < 4; ++nt)
          st_bf4((u16*)(P.ws + WS_QA) + (size_t)row * 384 + nb + nt * 16 + g * 4, acc[mt][nt]);
      } else {
        if (g == 0) ((float*)(P.ws + WS_SSQKV))[row * 4 + ((nb - 384) >> 6)] = ss;
        const int arow = isLat ? (4096 + bl * 1280 + tb + rl) : row;
#pragma unroll
        for (int nt = 0; nt < 4; ++nt) {
          const int c2 = nb - 384 + nt * 16 + g * 4;
          st_bf4((u16*)(P.ws + WS_CKVA) + (size_t)j * CKVA_J + (size_t)arow * 256 + c2, acc[mt][nt]);
          if (!isLat) st_f4((float*)(P.ws + WS_KVRAW) + (size_t)row * 256 + c2, acc[mt][nt]);
        }
      }
    } else if (nb == 640) {
      if (isLat) {
        const int t = tb + rl;
#pragma unroll
        for (int nt = 0; nt < 2; ++nt)
          rope4(acc[mt][nt], acc[mt][nt + 2], ropeC + t * 32 + nt * 16 + g * 4, ropeS + t * 32 + nt * 16 + g * 4);
      }
#pragma unroll
      for (int nt = 0; nt < 4; ++nt) {
        const int d = nt * 16 + g * 4;
        if (!isLat) {
          st_f4(P.out + OUT_KPE + ((size_t)((b * 2 + j) * 256 + sb + rl)) * 64 + d, acc[mt][nt]);
          u16* kd = (u16*)(P.ws + WS_CTXK) + ((size_t)(b * 8) * 256 + sb + rl) * 192 + 128 + d;
#pragma unroll
          for (int h = 0; h < 8; ++h) st_bf4(kd + (size_t)h * 256 * 192, acc[mt][nt]);
        } else {
          u16* kd = (u16*)(P.ws + WS_KMLAT) + (size_t)j * KMLAT_J + ((size_t)(bl * 8) * 1280 + tb + rl) * 192 + 128 + d;
#pragma unroll
          for (int h = 0; h < 8; ++h) st_bf4(kd + (size_t)h * 1280 * 192, acc[mt][nt]);
        }
      }
    } else {
#pragma unroll
      for (int nt = 0; nt < 4; ++nt) {
        f32x4 v = acc[mt][nt];
#pragma unroll
        for (int jj = 0; jj < 4; ++jj) v[jj] = silu(v[jj]);
        st_bf4((u16*)(P.ws + WS_G) + (size_t)row * 1024 + (nb - 704 + nt * 16 + g * 4), v);
      }
    }
  }
}

DEVI void tile_qb(const Params& P, int j, int tile, u16* smem) {
  int tm_, tn_; patch_tile(xcd_remap(tile, 384), 12, 6, tm_, tn_);
  const int m0 = tm_ * 256, n0 = tn_ * 128;
  const u16* A = (const u16*)(P.ws + WS_QA);
  const u16* B = (const u16*)(P.ws + WS_WQB) + (size_t)j * 1536 * 384;
  f32x4 acc[8][4];
  zero_acc(acc);
  gemm_core<true>(A, 384, B, 384, 384, m0, n0, smem, acc);
  const int lane = tidx() & 63, w = tidx() >> 6, wm = w >> 1, wn = w & 1, g = lane >> 4, li = lane & 15;
  const int mb = m0 + wm * 128, nb = n0 + wn * 64;
  const bool isLat = mb >= 4096;
  const int tb = (mb - 4096) & 1023;
  const float* ropeC = (const float*)(P.ws + WS_ROPE);
  const float* ropeS = ropeC + 1024 * 32;
  const float* ssq = (const float*)(P.ws + WS_SSQQ);
  const bool isRope = (nb % 192) == 128;
  const float qs = 0.07216878364870322f * LOG2E;
#pragma unroll
  for (int mt = 0; mt < 8; ++mt) {
    const int rl = mt * 16 + li, row = mb + rl;
    float ss = 0.f;
#pragma unroll
    for (int i = 0; i < 6; ++i) ss += ssq[row * 8 + i];
    const float r = rsqrtf(ss * (1.f / 384.f) + EPS) * qs;
    if (isRope && isLat) {
      const int t = tb + rl;
#pragma unroll
      for (int nt = 0; nt < 2; ++nt)
        rope4(acc[mt][nt], acc[mt][nt + 2], ropeC + t * 32 + nt * 16 + g * 4, ropeS + t * 32 + nt * 16 + g * 4);
    }
#pragma unroll
    for (int nt = 0; nt < 4; ++nt) {
      f32x4 v = acc[mt][nt] * r;
      st_bf4((u16*)(P.ws + WS_Q) + (size_t)row * 1536 + nb + nt * 16 + g * 4, v);
    }
  }
}

DEVI void tile_kvb(const Params& P, int j, int tile, u16* smem) {
  int tm_, tn_; patch_tile(xcd_remap(tile, 576), 16, 8, tm_, tn_);
  const int m0 = tm_ * 256, n0 = tn_ * 128;
  const bool tileLat = m0 >= 4096;
  const bool fresh = !tileLat || ((m0 - 4096) % 1280) < 1024;
  const u16* A = (const u16*)(P.ws + WS_CKVA) + (size_t)j * CKVA_J;
  const u16* B = (const u16*)(P.ws + (fresh ? WS_WKVBG : WS_WKVB)) + (size_t)j * 2048 * 256;
  const bool isV = (n0 >> 7) & 1;
  const int h = n0 >> 8;
  f32x4 acc[8][4];
  zero_acc(acc);
  if (isV) gemm_core<false>(A, 256, B, 256, 256, m0, n0, smem, acc);
  else gemm_core<true>(A, 256, B, 256, 256, m0, n0, smem, acc);
  const int lane = tidx() & 63, w = tidx() >> 6, wm = w >> 1, wn = w & 1, g = lane >> 4, li = lane & 15;
  const int mb = m0 + wm * 128;
  int b, keyb, Sk, tokb;
  u16 *Kd, *Vd;
  if (!tileLat) {
    b = mb >> 8; keyb = mb & 255; Sk = 256; tokb = mb;
    Kd = (u16*)(P.ws + WS_CTXK); Vd = (u16*)(P.ws + WS_VTCTX);
  } else {
    const int r2 = mb - 4096;
    b = r2 / 1280; keyb = r2 % 1280; Sk = 1280; tokb = 4096 + b * 1024 + keyb;
    Kd = (u16*)(P.ws + WS_KMLAT) + (size_t)j * KMLAT_J; Vd = (u16*)(P.ws + WS_VTLATM);
  }
  const float* ssq = (const float*)(P.ws + WS_SSQKV);
  if (!isV) {
#pragma unroll
    for (int mt = 0; mt < 8; ++mt) {
      const int rl = mt * 16 + li;
      float r = 1.f;
      if (fresh) {
        const float4 s4 = *(const float4*)(ssq + (size_t)(tokb + rl) * 4);
        r = rsqrtf((s4.x + s4.y + s4.z + s4.w) * (1.f / 256.f) + EPS);
      }
#pragma unroll
      for (int nt = 0; nt < 4; ++nt) {
        const int dd = wn * 64 + nt * 16 + g * 4;
        st_bf4(Kd + ((size_t)((b * 8 + h) * Sk + keyb + rl)) * 192 + dd, acc[mt][nt] * r);
      }
    }
  } else {
#pragma unroll
    for (int mt = 0; mt < 8; ++mt) {
      const int r0 = mt * 16 + g * 4;
      f32x4 rr = {1.f, 1.f, 1.f, 1.f};
      if (fresh) {
#pragma unroll
        for (int jj = 0; jj < 4; ++jj) {
          const float4 s4 = *(const float4*)(ssq + (size_t)(tokb + r0 + jj) * 4);
          rr[jj] = rsqrtf((s4.x + s4.y + s4.z + s4.w) * (1.f / 256.f) + EPS);
        }
      }
#pragma unroll
      for (int nt = 0; nt < 4; ++nt) {
        const int e = wn * 64 + nt * 16 + li;
        st_bf4(Vd + ((size_t)((b * 8 + h) * 128 + e)) * Sk + keyb + r0, acc[mt][nt] * rr);
      }
    }
  }
}

DEVI void tile_out(const Params& P, int layer, int tile, u16* smem) {
  int tm_, tn_; patch_tile(xcd_remap(tile, 256), 8, 8, tm_, tn_);
  const int m0 = tm_ * 256, n0 = tn_ * 128;
  const u16* A = (const u16*)(P.ws + WS_O);
  const u16* B = (const u16*)(P.ws + WS_WOUT) + (size_t)layer * 1024 * 1024;
  f32x4 acc[8][4];
  zero_acc(acc);
  gemm_core<true>(A, 1024, B, 1024, 1024, m0, n0, smem, acc);
  const int lane = tidx() & 63, w = tidx() >> 6, wm = w >> 1, wn = w & 1, g = lane >> 4, li = lane & 15;
  const int mb = m0 + wm * 128, nb = n0 + wn * 64;
  float* T = (float*)(P.ws + WS_T);
#pragma unroll
  for (int mt = 0; mt < 8; ++mt)
#pragma unroll
    for (int nt = 0; nt < 4; ++nt)
      st_f4(T + (size_t)(mb + mt * 16 + li) * 1024 + nb + nt * 16 + g * 4, acc[mt][nt]);
}

template <bool DIFF>
DEVI void attn_item(const Params& P, const u16* __restrict__ Qb, int ldq, int qrow0,
                    const u16* __restrict__ Kb, int ldk, const u16* __restrict__ Vt, int Sk,
                    int h, float lam, float lam_init, const float* gsub, u16* smem) {
  constexpr int KW = DIFF ? 128 : 192;
  constexpr int KLD = KW + 16;
  constexpr int NKK = DIFF ? 2 : 6;
  constexpr int KT = DIFF ? 64 : 32;
  constexpr int NS = KT / 16;
  constexpr int NU = KT / 32;
  constexpr int KCH = KW / 8;
  constexpr int NKL = (KT * KCH) / 256;
  constexpr int VCH = KT / 8;
  constexpr int NVL = (128 * VCH) / 256;
  constexpr int VLD = KT + 8;
  u16* Ks = smem;
  u16* Vs = smem + KT * KLD;
  const int tid = tidx(), lane = tid & 63, w = tid >> 6, g = lane >> 4, li = lane & 15;

  bf16x8 qf[2][NKK];
#pragma unroll
  for (int s = 0; s < 2; ++s) {
    const int qrow = DIFF ? (qrow0 + w * 16 + li) : (qrow0 + w * 32 + s * 16 + li);
    const int qcol = DIFF ? (h * 128 + s * 64) : (h * 192);
#pragma unroll
    for (int kk = 0; kk < NKK; ++kk)
      qf[s][kk] = *(const bf16x8*)(Qb + (size_t)qrow * ldq + qcol + kk * 32 + g * 8);
  }
  f32x4 oacc[2][8];
#pragma unroll
  for (int s = 0; s < 2; ++s)
#pragma unroll
    for (int et = 0; et < 8; ++et) oacc[s][et] = (f32x4){0.f, 0.f, 0.f, 0.f};
  float mrow[2] = {-1e30f, -1e30f}, lrow[2] = {0.f, 0.f};

  u32x4 rk[NKL], rv[NVL];
  auto gload = [&](int key0) {
#pragma unroll
    for (int i = 0; i < NKL; ++i) {
      const int c = tid + 256 * i, r = c / KCH, cc = c % KCH;
      rk[i] = *(const u32x4*)(Kb + (size_t)(key0 + r) * ldk + cc * 8);
    }
#pragma unroll
    for (int i = 0; i < NVL; ++i) {
      const int c = tid + 256 * i, r = c / VCH, cc = c % VCH;
      rv[i] = *(const u32x4*)(Vt + (size_t)r * Sk + key0 + cc * 8);
    }
  };
  gload(0);
  const int NT = Sk / KT;
  for (int kt0 = 0; kt0 < NT; ++kt0) {
    __syncthreads();
#pragma unroll
    for (int i = 0; i < NKL; ++i) {
      const int c = tid + 256 * i, r = c / KCH, cc = c % KCH;
      *(u32x4*)(Ks + r * KLD + cc * 8) = rk[i];
    }
#pragma unroll
    for (int i = 0; i < NVL; ++i) {
      const int c = tid + 256 * i, r = c / VCH, cc = c % VCH;
      *(u32x4*)(Vs + r * VLD + cc * 8) = rv[i];
    }
    __syncthreads();
    if (kt0 + 1 < NT) gload((kt0 + 1) * KT);

    f32x4 st[2][NS];
#pragma unroll
    for (int s = 0; s < 2; ++s)
#pragma unroll
      for (int kt = 0; kt < NS; ++kt) st[s][kt] = (f32x4){0.f, 0.f, 0.f, 0.f};
    {
      constexpr int NF = DIFF ? NKK * NS * 2 : NKK * NS;
      auto kaddr = [&](int f) -> const u16* {
        if (DIFF) { const int s2 = f & 1, kt = (f >> 1) % NS, kk = (f >> 1) / NS; return Ks + (kt * 16 + li) * KLD + s2 * 64 + kk * 32 + g * 8; }
        else { const int kt = f % NS, kk = f / NS; return Ks + (kt * 16 + li) * KLD + kk * 32 + g * 8; }
      };
      bf16x8 kf[3];
      kf[0] = *(const bf16x8*)kaddr(0);
      kf[1] = *(const bf16x8*)kaddr(1);
#pragma unroll
      for (int f = 0; f < NF; ++f) {
        if (f + 2 < NF) kf[(f + 2) % 3] = *(const bf16x8*)kaddr(f + 2);
        __builtin_amdgcn_sched_barrier(0);
        if (DIFF) {
          const int s2 = f & 1, kt = (f >> 1) % NS, kk = (f >> 1) / NS;
          st[s2][kt] = mfma16(kf[f % 3], qf[s2][kk], st[s2][kt]);
        } else {
          const int kt = f % NS, kk = f / NS;
          st[0][kt] = mfma16(kf[f % 3], qf[0][kk], st[0][kt]);
          st[1][kt] = mfma16(kf[f % 3], qf[1][kk], st[1][kt]);
        }
        __builtin_amdgcn_sched_barrier(0);
      }
    }
    bf16x8 pf[2][NU];
#pragma unroll
    for (int s = 0; s < 2; ++s) {
      float mx = st[s][0][0];
#pragma unroll
      for (int kt = 0; kt < NS; ++kt)
#pragma unroll
        for (int jj = 0; jj < 4; ++jj) mx = fmaxf(mx, st[s][kt][jj]);
      mx = fmaxf(mx, xshfl(mx, 16));
      mx = fmaxf(mx, xshfl(mx, 32));
      const bool need = mx > mrow[s] + 8.f;
      float mnew = mrow[s];
      if (__builtin_amdgcn_ballot_w64(need) != 0ull) {
        mnew = need ? mx : mrow[s];
        const float alpha = __builtin_amdgcn_exp2f(mrow[s] - mnew);
        mrow[s] = mnew;
        lrow[s] *= alpha;
#pragma unroll
        for (int et = 0; et < 8; ++et) oacc[s][et] *= alpha;
      }
      float ps = 0.f;
#pragma unroll
      for (int kt = 0; kt < NS; ++kt)
#pragma unroll
        for (int jj = 0; jj < 4; ++jj) {
          const float p = __builtin_amdgcn_exp2f(st[s][kt][jj] - mnew);
          st[s][kt][jj] = p;
          ps += p;
        }
      lrow[s] += ps;
#pragma unroll
      for (int u = 0; u < NU; ++u) {
        union { bf16x8 v; unsigned d[4]; } pu;
        pu.d[0] = pk2(st[s][2 * u][0], st[s][2 * u][1]);
        pu.d[1] = pk2(st[s][2 * u][2], st[s][2 * u][3]);
        pu.d[2] = pk2(st[s][2 * u + 1][0], st[s][2 * u + 1][1]);
        pu.d[3] = pk2(st[s][2 * u + 1][2], st[s][2 * u + 1][3]);
        pf[s][u] = pu.v;
      }
    }
    {
      constexpr int NF = NU * 8;
      union VU { bf16x8 v; u32x2 d[2]; };
      VU vf[3];
      auto vload = [&](VU& o, int f) {
        const int u = f >> 3, et = f & 7;
        o.d[0] = *(const u32x2*)(Vs + (et * 16 + li) * VLD + (2 * u) * 16 + g * 4);
        o.d[1] = *(const u32x2*)(Vs + (et * 16 + li) * VLD + (2 * u + 1) * 16 + g * 4);
      };
      vload(vf[0], 0);
      vload(vf[1], 1);
#pragma unroll
      for (int f = 0; f < NF; ++f) {
        if (f + 2 < NF) vload(vf[(f + 2) % 3], f + 2);
        __builtin_amdgcn_sched_barrier(0);
        const int u = f >> 3, et = f & 7;
        oacc[0][et] = mfma16(vf[f % 3].v, pf[0][u], oacc[0][et]);
        oacc[1][et] = mfma16(vf[f % 3].v, pf[1][u], oacc[1][et]);
        __builtin_amdgcn_sched_barrier(0);
      }
    }
  }
#pragma unroll
  for (int s = 0; s < 2; ++s) {
    lrow[s] += xshfl(lrow[s], 16);
    lrow[s] += xshfl(lrow[s], 32);
  }
  const u16* G = (const u16*)(P.ws + WS_G);
  u16* O = (u16*)(P.ws + WS_O);
  if (DIFF) {
    const float i0 = 1.f / lrow[0], i1 = lam / lrow[1];
    float ss = 0.f;
#pragma unroll
    for (int et = 0; et < 8; ++et) {
      oacc[0][et] = oacc[0][et] * i0 - oacc[1][et] * i1;
#pragma unroll
      for (int jj = 0; jj < 4; ++jj) ss += oacc[0][et][jj] * oacc[0][et][jj];
    }
    ss += xshfl(ss, 16);
    ss += xshfl(ss, 32);
    const float rr = rsqrtf(ss * (1.f / 128.f) + EPS) * (1.f - lam_init);
    const size_t tok = (size_t)(qrow0 + w * 16 + li);
#pragma unroll
    for (int et = 0; et < 8; ++et) {
      const int e = et * 16 + g * 4;
      const float4 gs = *(const float4*)(gsub + e);
      const uint2 gg = *(const uint2*)(G + tok * 1024 + h * 128 + e);
      f32x4 v = oacc[0][et] * rr;
      v[0] *= gs.x * bf2f(gg.x & 0xffffu);
      v[1] *= gs.y * bf2f(gg.x >> 16);
      v[2] *= gs.z * bf2f(gg.y & 0xffffu);
      v[3] *= gs.w * bf2f(gg.y >> 16);
      st_bf4(O + tok * 1024 + h * 128 + e, v);
    }
  } else {
#pragma unroll
    for (int s = 0; s < 2; ++s) {
      const float inv = 1.f / lrow[s];
      const size_t tok = (size_t)(qrow0 + w * 32 + s * 16 + li);
#pragma unroll
      for (int et = 0; et < 8; ++et) {
        const int e = et * 16 + g * 4;
        const uint2 gg = *(const uint2*)(G + tok * 1024 + h * 128 + e);
        f32x4 v = oacc[s][et] * inv;
        v[0] *= bf2f(gg.x & 0xffffu);
        v[1] *= bf2f(gg.x >> 16);
        v[2] *= bf2f(gg.y & 0xffffu);
        v[3] *= bf2f(gg.y >> 16);
        st_bf4(O + tok * 1024 + h * 128 + e, v);
      }
    }
  }
}

DEVI void attn_diff_phase(const Params& P, int j, u16* smem) {
  const float* lamv = (const float*)(P.ws + WS_MISC);
  const float lam = lamv[j * 2], lam_init = lamv[j * 2 + 1];
  const float* gsub = P.in[I_GSUB] + j * 128;
  const u16* Q = (const u16*)(P.ws + WS_Q);
  for (int it = blockIdx.x; it < 1024; it += gridDim.x) {
    if (it < 512) {
      const int iv = xcd_remap(it, 512);
      const int bl = iv >> 7, h = (iv >> 4) & 7, qt = iv & 15;
      const u16* Kb = (const u16*)(P.ws + WS_KDLAT) + (size_t)j * KDLAT_J + (size_t)bl * 1280 * 1024 + h * 128;
      const u16* Vt = (const u16*)(P.ws + WS_VTLATD) + (size_t)j * VTLATD_J + (size_t)(bl * 8 + h) * 128 * 1280;
      attn_item<true>(P, Q, 1024, 4096 + bl * 1024 + qt * 64, Kb, 1024, Vt, 1280, h, lam, lam_init, gsub, smem);
    } else {
      const int i2 = xcd_remap(it - 512, 512), b = i2 >> 5, h = (i2 >> 2) & 7, qt = i2 & 3;
      const u16* Kb = (const u16*)(P.ws + WS_CTXK) + (size_t)b * 256 * 1024 + h * 128;
      const u16* Vt = (const u16*)(P.ws + WS_VTCTX) + (size_t)(b * 8 + h) * 128 * 256;
      attn_item<true>(P, Q, 1024, b * 256 + qt * 64, Kb, 1024, Vt, 256, h, lam, lam_init, gsub, smem);
    }
  }
}

DEVI void attn_mla_phase(const Params& P, int j, u16* smem) {
  const u16* Q = (const u16*)(P.ws + WS_Q);
  for (int it = blockIdx.x; it < 512; it += gridDim.x) {
    if (it < 256) {
      const int iv = xcd_remap(it, 256);
      const int bl = iv >> 6, h = (iv >> 3) & 7, qt = iv & 7;
      const u16* Kb = (const u16*)(P.ws + WS_KMLAT) + (size_t)j * KMLAT_J + (size_t)(bl * 8 + h) * 1280 * 192;
      const u16* Vt = (const u16*)(P.ws + WS_VTLATM) + (size_t)(bl * 8 + h) * 128 * 1280;
      attn_item<false>(P, Q, 1536, 4096 + bl * 1024 + qt * 128, Kb, 192, Vt, 1280, h, 0.f, 0.f, nullptr, smem);
    } else {
      const int i2 = xcd_remap(it - 256, 256), b = i2 >> 4, h = (i2 >> 1) & 7, qt = i2 & 1;
      const u16* Kb = (const u16*)(P.ws + WS_CTXK) + (size_t)(b * 8 + h) * 256 * 192;
      const u16* Vt = (const u16*)(P.ws + WS_VTCTX) + (size_t)(b * 8 + h) * 128 * 256;
      attn_item<false>(P, Q, 1536, b * 256 + qt * 128, Kb, 192, Vt, 256, h, 0.f, 0.f, nullptr, smem);
    }
  }
}

DEVI float wave_sum(float v) {
  v += xshfl(v, 1); v += xshfl(v, 2); v += xshfl(v, 4); v += xshfl(v, 8); v += xshfl(v, 16); v += xshfl(v, 32);
  return v;
}

DEVI void ew_phase(const Params& P, int layer) {
  const int lane = tidx() & 63, w = tidx() >> 6;
  const float* ada = (const float*)(P.ws + WS_ADA);
  const float* T = (const float*)(P.ws + WS_T);
  u16* H = (u16*)(P.ws + WS_H);
  const int nl = layer + 1;
  for (int r0 = blockIdx.x * 4 + w; r0 < 4096; r0 += gridDim.x * 4) {
    float4 x[2][4], t[2][4];
#pragma unroll
    for (int q = 0; q < 2; ++q) {
      const int row = r0 + q * 4096;
      const float* xsrc = (layer <= 0) ? (q == 0 ? P.in[I_XP] + (size_t)row * 1024 : P.in[I_XS] + (size_t)(row - 4096) * 1024)
                                       : P.out + OUT_Y + (size_t)row * 1024;
#pragma unroll
      for (int i = 0; i < 4; ++i) x[q][i] = *(const float4*)(xsrc + lane * 4 + i * 256);
      if (layer >= 0) {
#pragma unroll
        for (int i = 0; i < 4; ++i) t[q][i] = *(const float4*)(T + (size_t)row * 1024 + lane * 4 + i * 256);
      }
    }
#pragma unroll
    for (int q = 0; q < 2; ++q) {
      const int row = r0 + q * 4096;
      const int cond = q == 0 ? 0 : 1 + (r0 >> 10);
      if (layer >= 0) {
        float ss = 0.f;
#pragma unroll
        for (int i = 0; i < 4; ++i)
          ss += t[q][i].x * t[q][i].x + t[q][i].y * t[q][i].y + t[q][i].z * t[q][i].z + t[q][i].w * t[q][i].w;
        ss = wave_sum(ss);
        const float rt = rsqrtf(ss * (1.f / 1024.f) + EPS);
        const float* gate = ada + (size_t)(layer * 5 + cond) * 3072 + 2048;
        const float* gp = P.in[I_GPOST] + layer * 1024;
#pragma unroll
        for (int i = 0; i < 4; ++i) {
          const int c = lane * 4 + i * 256;
          const float4 ga = *(const float4*)(gate + c);
          const float4 gq = *(const float4*)(gp + c);
          x[q][i].x += ga.x * (t[q][i].x * rt * gq.x);
          x[q][i].y += ga.y * (t[q][i].y * rt * gq.y);
          x[q][i].z += ga.z * (t[q][i].z * rt * gq.z);
          x[q][i].w += ga.w * (t[q][i].w * rt * gq.w);
          *(float4*)(P.out + OUT_Y + (size_t)row * 1024 + c) = x[q][i];
        }
      }
      if (nl < 4) {
        float ss = 0.f;
#pragma unroll
        for (int i = 0; i < 4; ++i)
          ss += x[q][i].x * x[q][i].x + x[q][i].y * x[q][i].y + x[q][i].z * x[q][i].z + x[q][i].w * x[q][i].w;
        ss = wave_sum(ss);
        const float rx = rsqrtf(ss * (1.f / 1024.f) + EPS);
        const float* sh = ada + (size_t)(nl * 5 + cond) * 3072;
        const float* sc = sh + 1024;
        const float* gpre = P.in[I_GPRE] + nl * 1024;
#pragma unroll
        for (int i = 0; i < 4; ++i) {
          const int c = lane * 4 + i * 256;
          const float4 s1 = *(const float4*)(sh + c);
          const float4 s2 = *(const float4*)(sc + c);
          const float4 gq = *(const float4*)(gpre + c);
          f32x4 hv;
          hv[0] = x[q][i].x * rx * gq.x * (1.f + s2.x) + s1.x;
          hv[1] = x[q][i].y * rx * gq.y * (1.f + s2.y) + s1.y;
          hv[2] = x[q][i].z * rx * gq.z * (1.f + s2.z) + s1.z;
          hv[3] = x[q][i].w * rx * gq.w * (1.f + s2.w) + s1.w;
          st_bf4(H + (size_t)row * 1024 + c, hv);
        }
      }
    }
  }
}

DEVI void tr_tile(const float* __restrict__ src, int lds, int k0, int n0, int nvalid, u16* __restrict__ dst, int ldd,
                  const float* kscale, float* tile) {
  const int tid = tidx();
  float4 v[4];
#pragma unroll
  for (int i = 0; i < 4; ++i) {
    const int idx = tid + 256 * i, kk = idx >> 4, c4 = (idx & 15) * 4;
    v[i] = (n0 + c4 < nvalid) ? *(const float4*)(src + (size_t)(k0 + kk) * lds + n0 + c4) : make_float4(0.f, 0.f, 0.f, 0.f);
    if (kscale) { const float ks = kscale[k0 + kk]; v[i].x *= ks; v[i].y *= ks; v[i].z *= ks; v[i].w *= ks; }
  }
  __syncthreads();
#pragma unroll
  for (int i = 0; i < 4; ++i) {
    const int idx = tid + 256 * i, kk = idx >> 4, c4 = (idx & 15) * 4;
    float* tp = tile + kk * 65 + c4;
    tp[0] = v[i].x; tp[1] = v[i].y; tp[2] = v[i].z; tp[3] = v[i].w;
  }
  __syncthreads();
#pragma unroll
  for (int i = 0; i < 2; ++i) {
    const int c = tid + 256 * i, nn = c >> 3, kc = (c & 7) * 8;
    const float* tp = tile + kc * 65 + nn;
    u32x4 u;
    u[0] = pk2(tp[0], tp[65]); u[1] = pk2(tp[2 * 65], tp[3 * 65]); u[2] = pk2(tp[4 * 65], tp[5 * 65]); u[3] = pk2(tp[6 * 65], tp[7 * 65]);
    *(u32x4*)(dst + (size_t)(n0 + nn) * ldd + k0 + kc) = u;
  }
}

constexpr int N_ADA = 384;
constexpr int N_TWOUT = 1024, N_TDAIN = 2048, N_TMLAIN = 896, N_TQB = 288, N_TKVB = 256, N_TCV = 512;
constexpr int N_ROPE = 128, N_LAM = 1, N_CDK = 1024, N_CCKV = 256, N_CKPE = 64;
constexpr int P0_ITEMS = N_ADA + N_TWOUT + N_TDAIN + N_TMLAIN + N_TQB + N_TKVB + N_TCV + N_ROPE + N_LAM + N_CDK + N_CCKV + N_CKPE;

DEVI void prep_phase(const Params& P, u16* smem) {
  float* fs = (float*)smem;
  const int tid = tidx();
  for (int item = blockIdx.x; item < P0_ITEMS; item += gridDim.x) {
    int it = item;
    if (it < N_ADA) {
      const int layer = it / 96, cgp = it % 96;
      float* sc = fs;
      float* red = fs + 5120;
      __syncthreads();
      for (int idx = tid; idx < 5120; idx += 256) {
        const int cnd = idx >> 10, k = idx & 1023;
        const float v = cnd == 0 ? P.in[I_CCTX][k] : P.in[I_C][(cnd - 1) * 1024 + k];
        sc[idx] = silu(v);
      }
      __syncthreads();
      const int col = tid & 31, kg = tid >> 5;
      const float* wp = P.in[I_WADA] + (size_t)layer * 1024 * 3072 + cgp * 32 + col;
      float a0 = 0.f, a1 = 0.f, a2 = 0.f, a3 = 0.f, a4 = 0.f;
#pragma unroll 16
      for (int k = kg * 128; k < kg * 128 + 128; ++k) {
        const float wv = wp[(size_t)k * 3072];
        a0 += sc[k] * wv; a1 += sc[1024 + k] * wv; a2 += sc[2048 + k] * wv; a3 += sc[3072 + k] * wv; a4 += sc[4096 + k] * wv;
      }
      red[(kg * 5 + 0) * 32 + col] = a0; red[(kg * 5 + 1) * 32 + col] = a1; red[(kg * 5 + 2) * 32 + col] = a2;
      red[(kg * 5 + 3) * 32 + col] = a3; red[(kg * 5 + 4) * 32 + col] = a4;
      __syncthreads();
      if (tid < 160) {
        const int cnd = tid >> 5, c2 = tid & 31;
        float s = P.in[I_BADA][layer * 3072 + cgp * 32 + c2];
#pragma unroll
        for (int q = 0; q < 8; ++q) s += red[(q * 5 + cnd) * 32 + c2];
        ((float*)(P.ws + WS_ADA))[(size_t)(layer * 5 + cnd) * 3072 + cgp * 32 + c2] = s;
      }
      continue;
    }
    it -= N_ADA;
    if (it < N_TWOUT) {
      const int l = it >> 8, kt = (it >> 4) & 15, nt = it & 15;
      tr_tile(P.in[I_WOUT] + (size_t)l * 1024 * 1024, 1024, kt * 64, nt * 64, 1024,
              (u16*)(P.ws + WS_WOUT) + (size_t)l * 1024 * 1024, 1024, nullptr, fs);
      continue;
    }
    it -= N_TWOUT;
    if (it < N_TDAIN) {
      const int l = it >> 10, kt = (it >> 6) & 15, nt = it & 63;
      tr_tile(P.in[I_DAWIN] + (size_t)l * 1024 * 4096, 4096, kt * 64, nt * 64, 4096,
              (u16*)(P.ws + WS_WDAIN) + (size_t)l * 4096 * 1024, 1024, nullptr, fs);
      continue;
    }
    it -= N_TDAIN;
    if (it < N_TMLAIN) {
      const int l = it / 448, r = it % 448, kt = r / 28, nt = r % 28;
      tr_tile(P.in[I_MWIN] + (size_t)l * 1024 * 1728, 1728, kt * 64, nt * 64, 1728,
              (u16*)(P.ws + WS_WMLAIN) + (size_t)l * 1792 * 1024, 1024, nullptr, fs);
      continue;
    }
    it -= N_TMLAIN;
    if (it < N_TQB) {
      const int l = it / 144, r = it % 144, kt = r / 24, nt = r % 24;
      tr_tile(P.in[I_WQB] + (size_t)l * 384 * 1536, 1536, kt * 64, nt * 64, 1536,
              (u16*)(P.ws + WS_WQB) + (size_t)l * 1536 * 384, 384, P.in[I_GQA] + l * 384, fs);
      continue;
    }
    it -= N_TQB;
    if (it < N_TKVB) {
      const int l = it >> 7, kt = (it >> 5) & 3, nt = it & 31;
      tr_tile(P.in[I_WKVB] + (size_t)l * 256 * 2048, 2048, kt * 64, nt * 64, 2048,
              (u16*)(P.ws + WS_WKVB) + (size_t)l * 2048 * 256, 256, nullptr, fs);
      tr_tile(P.in[I_WKVB] + (size_t)l * 256 * 2048, 2048, kt * 64, nt * 64, 2048,
              (u16*)(P.ws + WS_WKVBG) + (size_t)l * 2048 * 256, 256, P.in[I_GKVA] + l * 256, fs);
      continue;
    }
    it -= N_TKVB;
    if (it < N_TCV) {
      const int grp = it >> 3, sub = it & 7, bl = grp >> 4, jj = (grp >> 3) & 1, h = grp & 7, pt = sub >> 1, et = sub & 1;
      const float* src = P.in[I_CDV] + ((size_t)(bl * 2 + jj) * 256) * 1024 + h * 128;
      u16* dst = (u16*)(P.ws + WS_VTLATD) + (size_t)jj * VTLATD_J + (size_t)(bl * 8 + h) * 128 * 1280 + 1024;
      tr_tile(src, 1024, pt * 64, et * 64, 128, dst, 1280, nullptr, fs);
      continue;
    }
    it -= N_TCV;
    if (it < N_ROPE) {
      const int idx = it * 256 + tid, t = idx >> 5, p = idx & 31, f = p & 15;
      const float inv = exp2f(-(float)f * (13.287712379549449f / 16.f));
      const float pos = (p < 16) ? (float)(t >> 6) : (float)(t & 63);
      float sn, cs;
      sincosf(pos * inv, &sn, &cs);
      float* rc = (float*)(P.ws + WS_ROPE);
      rc[idx] = cs;
      rc[1024 * 32 + idx] = sn;
      continue;
    }
    it -= N_ROPE;
    if (it < N_LAM) {
      if (tid < 2) {
        const int jd = tid;
        float s1 = 0.f, s2 = 0.f;
        for (int d = 0; d < 64; ++d) {
          s1 += P.in[I_LQ1][jd * 64 + d] * P.in[I_LK1][jd * 64 + d];
          s2 += P.in[I_LQ2][jd * 64 + d] * P.in[I_LK2][jd * 64 + d];
        }
        const float li = 0.8f - 0.6f * expf(-0.3f * (float)(2 * jd));
        float* lamv = (float*)(P.ws + WS_MISC);
        lamv[jd * 2] = expf(s1) - expf(s2) + li;
        lamv[jd * 2 + 1] = li;
      }
      continue;
    }
    it -= N_LAM;
    if (it < N_CDK) {
      const size_t e0 = ((size_t)it * 256 + tid) * 8;
      const int col = e0 & 1023, p = (e0 >> 10) & 255, jj = (e0 >> 18) & 1, bl = (int)(e0 >> 19);
      const float4 a = *(const float4*)(P.in[I_CDK] + e0);
      const float4 b = *(const float4*)(P.in[I_CDK] + e0 + 4);
      uint4 u; u.x = pk2(a.x, a.y); u.y = pk2(a.z, a.w); u.z = pk2(b.x, b.y); u.w = pk2(b.z, b.w);
      *(uint4*)((u16*)(P.ws + WS_KDLAT) + (size_t)jj * KDLAT_J + ((size_t)(bl * 1280 + 1024 + p)) * 1024 + col) = u;
      continue;
    }
    it -= N_CDK;
    if (it < N_CCKV) {
      const size_t e0 = ((size_t)it * 256 + tid) * 8;
      const int col = e0 & 255, p = (e0 >> 8) & 255, jj = (e0 >> 16) & 1, bl = (int)(e0 >> 17);
      const float4 a = *(const float4*)(P.in[I_CCKV] + e0);
      const float4 b = *(const float4*)(P.in[I_CCKV] + e0 + 4);
      uint4 u; u.x = pk2(a.x, a.y); u.y = pk2(a.z, a.w); u.z = pk2(b.x, b.y); u.w = pk2(b.z, b.w);
      *(uint4*)((u16*)(P.ws + WS_CKVA) + (size_t)jj * CKVA_J + ((size_t)(4096 + bl * 1280 + 1024 + p)) * 256 + col) = u;
      continue;
    }
    it -= N_CCKV;
    {
      const size_t e0 = ((size_t)it * 256 + tid) * 8;
      const int d = e0 & 63, p = (e0 >> 6) & 255, jj = (e0 >> 14) & 1, bl = (int)(e0 >> 15);
      const float4 a = *(const float4*)(P.in[I_CKPE] + e0);
      const float4 b = *(const float4*)(P.in[I_CKPE] + e0 + 4);
      uint4 u; u.x = pk2(a.x, a.y); u.y = pk2(a.z, a.w); u.z = pk2(b.x, b.y); u.w = pk2(b.z, b.w);
      u16* dst = (u16*)(P.ws + WS_KMLAT) + (size_t)jj * KMLAT_J + ((size_t)(bl * 8) * 1280 + 1024 + p) * 192 + 128 + d;
#pragma unroll
      for (int h = 0; h < 8; ++h) *(uint4*)(dst + (size_t)h * 1280 * 192) = u;
    }
  }
}

DEVI void mla_b_phase(const Params& P, int j, u16* smem) {
  constexpr int NQ = 32 * 12, NKV = 36 * 16, NNORM = 64;
  for (int it = blockIdx.x; it < NKV + NQ + NNORM; it += gridDim.x) {
    if (it < NKV) tile_kvb(P, j, it, smem);
    else if (it < NKV + NQ) tile_qb(P, j, it - NKV, smem);
    else {
      const int lane = tidx() & 63, w = tidx() >> 6;
      const float* ssq = (const float*)(P.ws + WS_SSQKV);
      const float4 gk = *(const float4*)(P.in[I_GKVA] + j * 256 + lane * 4);
      for (int r = w; r < 64; r += 4) {
        const int row = (it - NKV - NQ) * 64 + r;
        const float4 s4 = *(const float4*)(ssq + (size_t)row * 4);
        const float rr = rsqrtf((s4.x + s4.y + s4.z + s4.w) * (1.f / 256.f) + EPS);
        float* p = P.out + OUT_CKV + ((size_t)(((row >> 8) * 2 + j) * 256 + (row & 255))) * 256 + lane * 4;
        float4 v = *(const float4*)((const float*)(P.ws + WS_KVRAW) + (size_t)row * 256 + lane * 4);
        v.x *= rr * gk.x; v.y *= rr * gk.y; v.z *= rr * gk.z; v.w *= rr * gk.w;
        *(float4*)p = v;
      }
    }
  }
}


#define XB_TMO      128
#define XB_XCNT(j)  (256  + 64 * (j))
#define XB_XSUB(j)  (1280 + 64 * (j))
#define XB_XGEN(j)  (2304 + 64 * (j))
#define XB_TOP      3328
#define XB_TOPGEN   3392
#define XCD_BAR_WORDS 3456
#define XB_SPIN_CAP (1u << 22)
#define LAS __attribute__((address_space(3)))
DEVI unsigned xb_ld(unsigned* p) { return __hip_atomic_load(p, __ATOMIC_RELAXED, __HIP_MEMORY_SCOPE_AGENT); }
DEVI unsigned xb_add(unsigned* p, unsigned v) { return __hip_atomic_fetch_add(p, v, __ATOMIC_RELAXED, __HIP_MEMORY_SCOPE_AGENT); }
DEVI unsigned xb_xcc_id() { return (unsigned)__builtin_amdgcn_s_getreg((3 << 11) | 20) & 0xFu; }
#define XB_SPIN(cond, bar) do { unsigned _sp = 0; while (cond) { __builtin_amdgcn_s_sleep(1); \
    if ((++_sp & 255u) == 0u) { if (xb_ld(&(bar)[XB_TMO])) break; if (_sp > XB_SPIN_CAP) { atomicAdd(&(bar)[XB_TMO], 1u); break; } } } } while (0)
struct XcdBarrier { unsigned* bar; unsigned x; volatile LAS unsigned* st; };
DEVI XcdBarrier xcd_barrier_post(unsigned* bar, volatile LAS unsigned* st) {
  XcdBarrier b; b.bar = bar; b.x = xb_xcc_id(); b.st = st;
  if (threadIdx.x == 0) (void)xb_add(&bar[XB_XCNT(b.x)], 1u);
  return b;
}
DEVI void xcd_barrier_complete(unsigned* bar, unsigned x, unsigned& nloc, unsigned& nx) {
  const unsigned G = gridDim.x * gridDim.y * gridDim.z;
  unsigned sum, cnt, mine, sp = 0u;
  for (;;) {
    sum = 0u; cnt = 0u; mine = 0u;
#pragma unroll
    for (unsigned j = 0; j < 16; ++j) { const unsigned c = xb_ld(&bar[XB_XCNT(j)]); sum += c; cnt += (c > 0u) ? 1u : 0u; mine = (j == x) ? c : mine; }
    if (sum == G) break;
    __builtin_amdgcn_s_sleep(1);
    if ((++sp & 255u) == 0u) { if (xb_ld(&bar[XB_TMO])) break; if (sp > XB_SPIN_CAP) { atomicAdd(&bar[XB_TMO], 1u); break; } }
  }
  nloc = mine > 0u ? mine : 1u; nx = cnt > 0u ? cnt : 1u;
}
DEVI void xcd_barrier(const XcdBarrier& b) {
  asm volatile("s_waitcnt vmcnt(0)" ::: "memory");
  __syncthreads();
  if (threadIdx.x == 0) {
    unsigned* bar = b.bar;
    __builtin_amdgcn_s_waitcnt(0);
    unsigned nloc = b.st[0], nx = b.st[1];
    if (nloc == 0u) { xcd_barrier_complete(bar, b.x, nloc, nx); b.st[0] = nloc; b.st[1] = nx; }
    const unsigned old = xb_add(&bar[XB_XSUB(b.x)], 1u);
    const unsigned gen = old / nloc;
    if (old + 1u == (gen + 1u) * nloc) {
      __builtin_amdgcn_fence(__ATOMIC_RELEASE, "agent");
      asm volatile("s_waitcnt vmcnt(0)" ::: "memory");
      const unsigned og = xb_add(&bar[XB_TOP], 1u);
      const unsigned tg = og / nx;
      if (og + 1u == (tg + 1u) * nx) xb_add(&bar[XB_TOPGEN], 1u);
      else XB_SPIN(xb_ld(&bar[XB_TOPGEN]) == tg, bar);
      __builtin_amdgcn_fence(__ATOMIC_ACQUIRE, "agent");
      xb_add(&bar[XB_XGEN(b.x)], 1u);
      asm volatile("s_waitcnt vmcnt(0)" ::: "memory");
    } else {
      XB_SPIN(xb_ld(&bar[XB_XGEN(b.x)]) == gen, bar);
      __builtin_amdgcn_fence(__ATOMIC_ACQUIRE, "agent");
      asm volatile("s_waitcnt vmcnt(0)" ::: "memory");
    }
  }
  __syncthreads();
}
constexpr size_t WS_BAR = WS_MISC + 65536;

#ifndef EN
#define EN 0xFF
#endif
DEVI void run_phase(const Params& P, int ph, u16* smem) {
  if (ph == 0) { if (EN & 1) prep_phase(P, smem); return; }
  if (ph == 1) { if (EN & 2) ew_phase(P, -1); return; }
  int layer, sub;
  if (ph < 6) { layer = 0; sub = ph - 2; }
  else if (ph < 11) { layer = 1; sub = ph - 6; }
  else if (ph < 15) { layer = 2; sub = ph - 11; }
  else { layer = 3; sub = ph - 15; }
  const int j = layer >> 1;
  if ((layer & 1) == 0) {
    if (sub == 0) { if (EN & 4) for (int t = blockIdx.x; t < 32 * 32; t += gridDim.x) tile_diff_in(P, j, t, smem); }
    else if (sub == 1) { if (EN & 8) attn_diff_phase(P, j, smem); }
    else if (sub == 2) { if (EN & 16) for (int t = blockIdx.x; t < 32 * 8; t += gridDim.x) tile_out(P, layer, t, smem); }
    else { if (EN & 2) ew_phase(P, layer); }
  } else {
    if (sub == 0) { if (EN & 32) for (int t = blockIdx.x; t < 32 * 14; t += gridDim.x) tile_mla_in(P, j, t, smem); }
    else if (sub == 1) { if (EN & 64) mla_b_phase(P, j, smem); }
    else if (sub == 2) { if (EN & 128) attn_mla_phase(P, j, smem); }
    else if (sub == 3) { if (EN & 16) for (int t = blockIdx.x; t < 32 * 8; t += gridDim.x) tile_out(P, layer, t, smem); }
    else { if (EN & 2) ew_phase(P, layer); }
  }
}

constexpr int N_PHASES = 20;

__global__ void __launch_bounds__(256, 2) fwd_megakernel(Params P) {
  __shared__ __attribute__((aligned(16))) u16 smem[SMEM_BYTES / 2];
  __shared__ uint4 xb_words;
  if (threadIdx.x == 0) xb_words = make_uint4(0u, 0u, 0u, 0u);
  __syncthreads();
  XcdBarrier xb = xcd_barrier_post((unsigned*)(P.ws + WS_BAR), (volatile LAS unsigned*)&xb_words);
  for (int ph = P.ph_lo; ph < P.ph_hi; ++ph) {
    Params Pl = P;
    {
      size_t zoff = 0;
      asm volatile("" : "+s"(zoff));
      Pl.ws = P.ws + zoff;
      Pl.out = P.out + zoff;
    }
    run_phase(Pl, ph, smem);
#ifdef REP_MASK
    {
      int kind;
      if (ph == 0) kind = 1; else if (ph == 1) kind = 2;
      else { int layer, sub; if (ph < 6) { layer = 0; sub = ph - 2; } else if (ph < 11) { layer = 1; sub = ph - 6; } else if (ph < 15) { layer = 2; sub = ph - 11; } else { layer = 3; sub = ph - 15; }
        if ((layer & 1) == 0) kind = sub == 0 ? 4 : sub == 1 ? 8 : sub == 2 ? 16 : 2;
        else kind = sub == 0 ? 32 : sub == 1 ? 64 : sub == 2 ? 128 : sub == 3 ? 16 : 2; }
      if (kind & REP_MASK) { xcd_barrier(xb); run_phase(Pl, ph, smem); }
    }
#endif
    if (ph + 1 < P.ph_hi) {
      if (P.ph_hi > 1000) cg::this_grid().sync();
      xcd_barrier(xb);
    }
#ifdef EXTRA_SYNCS
    for (int q = 0; q < EXTRA_SYNCS; ++q) xcd_barrier(xb);
#endif
  }
}

extern "C" void kernel_launch(void* const* d_in, const int* in_sizes, int n_in, void* d_out, int out_size, void* d_ws,
                              size_t ws_size, hipStream_t stream) {
  static int grid_blocks = 0;
  if (!grid_blocks) {
    int dev = 0, cus = 0, per_cu = 0;
    (void)hipGetDevice(&dev);
    (void)hipDeviceGetAttribute(&cus, hipDeviceAttributeMultiprocessorCount, dev);
    (void)hipOccupancyMaxActiveBlocksPerMultiprocessor(&per_cu, fwd_megakernel, 256, 0);
    if (per_cu < 1) per_cu = 1;
    if (per_cu > 2) per_cu = 2;
    grid_blocks = cus * per_cu;
  }
  if (hipMemsetAsync((unsigned char*)d_ws + WS_BAR, 0, 16384, stream) != hipSuccess) { fprintf(stderr, "memset failed\n"); return; }
  Params p{};
  for (int i = 0; i < 24; ++i) p.in[i] = (const float*)d_in[i];
  p.out = (float*)d_out;
  p.ws = (unsigned char*)d_ws;
#if MULTI_LAUNCH
  for (int ph = 0; ph < N_PHASES; ++ph) {
    p.ph_lo = ph; p.ph_hi = ph + 1;
    hipLaunchKernelGGL(fwd_megakernel, dim3(grid_blocks), dim3(256), 0, stream, p);
  }
#else
  p.ph_lo = 0; p.ph_hi = N_PHASES;
  void* args[] = {&p};
  hipError_t e = hipLaunchCooperativeKernel((void*)fwd_megakernel, dim3(grid_blocks), dim3(256), args, 0, stream);
  if (e != hipSuccess) fprintf(stderr, "cooperative launch failed: %s (grid %d)\n", hipGetErrorString(e), grid_blocks);
#endif
}
```

```cpp
#include <hip/hip_runtime.h>
#include <hip/hip_cooperative_groups.h>
#include <cstdio>
namespace cg = cooperative_groups;

#ifndef MULTI_LAUNCH
#define MULTI_LAUNCH 0
#endif

typedef unsigned short u16;
typedef __attribute__((ext_vector_type(8))) short bf16x8;
typedef __attribute__((ext_vector_type(4))) float f32x4;
typedef __attribute__((ext_vector_type(4))) unsigned u32x4;
typedef __attribute__((ext_vector_type(2))) unsigned u32x2;

#define DEVI __device__ __forceinline__

struct Params {
  const float* in[24];
  float* out;
  unsigned char* ws;
  int ph_lo, ph_hi;
};

constexpr size_t MBy = 1u << 20;
constexpr size_t WS_WOUT = 0;
constexpr size_t WS_WDAIN = 8 * MBy;
constexpr size_t WS_WMLAIN = 24 * MBy;
constexpr size_t WS_WQB = 31 * MBy;
constexpr size_t WS_WKVB = 34 * MBy;
constexpr size_t WS_WKVBG = 36 * MBy;
constexpr size_t WS_ADA = 38 * MBy;
constexpr size_t WS_ROPE = 39 * MBy;
constexpr size_t WS_MISC = 40 * MBy;
constexpr size_t WS_H = 41 * MBy;
constexpr size_t WS_O = WS_H;
constexpr size_t WS_Q = 57 * MBy;
constexpr size_t WS_T = WS_Q;
constexpr size_t WS_CTXK = 81 * MBy;
constexpr size_t WS_KDLAT = 93 * MBy;
constexpr size_t WS_VTCTX = 113 * MBy;
constexpr size_t WS_VTLATD = 121 * MBy;
constexpr size_t WS_VTLATM = 141 * MBy;
constexpr size_t WS_G = 151 * MBy;
constexpr size_t WS_QA = 167 * MBy;
constexpr size_t WS_CKVA = 173 * MBy;
constexpr size_t WS_SSQQ = 183 * MBy;
constexpr size_t WS_SSQKV = 184 * MBy;
constexpr size_t WS_KMLAT = 185 * MBy;
constexpr size_t WS_KVRAW = 215 * MBy;
constexpr size_t KDLAT_J = (size_t)4 * 1280 * 1024;
constexpr size_t VTLATD_J = (size_t)4 * 8 * 128 * 1280;
constexpr size_t CKVA_J = (size_t)9216 * 256;
constexpr size_t KMLAT_J = (size_t)4 * 8 * 1280 * 192;

constexpr size_t OUT_Y = 0;
constexpr size_t OUT_SK = 8388608;
constexpr size_t OUT_SV = 16777216;
constexpr size_t OUT_CKV = 25165824;
constexpr size_t OUT_KPE = 27262976;

constexpr float EPS = 1e-6f;
constexpr float LOG2E = 1.4426950408889634f;

enum { I_XP = 0, I_XS, I_CDK, I_CDV, I_CCKV, I_CKPE, I_C, I_CCTX, I_WADA, I_BADA, I_GPRE, I_GPOST, I_WOUT,
       I_DAWIN, I_LQ1, I_LK1, I_LQ2, I_LK2, I_GSUB, I_MWIN, I_GQA, I_WQB, I_GKVA, I_WKVB };

DEVI int tidx() { int t = threadIdx.x; asm volatile("" : "+v"(t)); return t; }
DEVI u16 f2bf(float f) {
  unsigned u = __float_as_uint(f);
  u += 0x7fffu + ((u >> 16) & 1u);
  return (u16)(u >> 16);
}
typedef __attribute__((ext_vector_type(2))) float f32x2_t;
typedef __attribute__((ext_vector_type(2))) __bf16 bf16x2_t;
DEVI unsigned pk2(float a, float b) {
  f32x2_t v = {a, b};
  bf16x2_t r = __builtin_convertvector(v, bf16x2_t);
  return __builtin_bit_cast(unsigned, r);
}
DEVI float bf2f(unsigned v) { return __uint_as_float(v << 16); }
DEVI void st_bf4(u16* p, f32x4 v) {
  uint2 u; u.x = pk2(v[0], v[1]); u.y = pk2(v[2], v[3]);
  *(uint2*)p = u;
}
DEVI void st_pair(u16* p, int g, f32x4 a, f32x4 b) {
  const bool odd = g & 1;
  f32x4 send, recv;
#pragma unroll
  for (int i = 0; i < 4; ++i) send[i] = odd ? a[i] : b[i];
#pragma unroll
  for (int i = 0; i < 4; ++i) recv[i] = __shfl_xor(send[i], 16, 64);
  f32x4 lo, hi;
#pragma unroll
  for (int i = 0; i < 4; ++i) { lo[i] = odd ? recv[i] : a[i]; hi[i] = odd ? b[i] : recv[i]; }
  u32x4 u;
  u[0] = pk2(lo[0], lo[1]); u[1] = pk2(lo[2], lo[3]); u[2] = pk2(hi[0], hi[1]); u[3] = pk2(hi[2], hi[3]);
  *(u32x4*)(p + (odd ? 16 : 0) + (g >> 1) * 8) = u;
}
DEVI void st_f4(float* p, f32x4 v) { *(float4*)p = make_float4(v[0], v[1], v[2], v[3]); }
DEVI f32x4 mfma16(bf16x8 a, bf16x8 b, f32x4 c) { return __builtin_amdgcn_mfma_f32_16x16x32_bf16(a, b, c, 0, 0, 0); }
DEVI float silu(float x) { return x * __builtin_amdgcn_rcpf(1.f + __builtin_amdgcn_exp2f(-1.4426950408889634f * x)); }
DEVI float xshfl(float v, int m) { return __shfl_xor(v, m, 64); }

DEVI void rope4(f32x4& x1, f32x4& x2, const float* cs, const float* sn) {
  float4 c = *(const float4*)cs; float4 s = *(const float4*)sn;
  f32x4 a = x1, b = x2;
  x1[0] = a[0] * c.x - b[0] * s.x; x2[0] = a[0] * s.x + b[0] * c.x;
  x1[1] = a[1] * c.y - b[1] * s.y; x2[1] = a[1] * s.y + b[1] * c.y;
  x1[2] = a[2] * c.z - b[2] * s.z; x2[2] = a[2] * s.z + b[2] * c.z;
  x1[3] = a[3] * c.w - b[3] * s.w; x2[3] = a[3] * s.w + b[3] * c.w;
}

constexpr int LDT = 64;
constexpr int TILE_ELEMS = 128 * LDT;
constexpr int SMEM_BYTES = 2 * (64 * 144 + 128 * 72) * 2;

template <bool SWAP>
DEVI void gemm_core(const u16* __restrict__ A, int lda, const u16* __restrict__ B, int ldb, int K,
                    int m0, int n0, u16* smem, f32x4 (&acc)[8][4]) {
  const int tid = tidx(), lane = tid & 63, w = tid >> 6;
  const int wm = w >> 1, wn = w & 1;
  const int g = lane >> 4, li = lane & 15;
  u16* As = smem;
  u16* Bs = smem + 256 * 64;
  const int lr = tid >> 3, lc = (tid & 7) * 8;
  const u16* ap = A + (size_t)(m0 + lr) * lda + lc;
  const u16* bp = B + (size_t)(n0 + lr) * ldb + lc;
  const int wsw = (((tid & 7) ^ (lr & 7)) * 8);
  u16* sa = As + lr * 64 + wsw;
  u16* sb = Bs + lr * 64 + wsw;
  const int rs0 = ((g ^ (li & 7)) * 8), rs1 = (((4 + g) ^ (li & 7)) * 8);
  const u16* Ard = As + (wm * 128 + li) * 64;
  const u16* Brd = Bs + (wn * 64 + li) * 64;
  u32x4 ra[8], rb[4];
#define GLOAD(KT_) { const int k0_ = (KT_) << 6; \
    _Pragma("unroll") for (int i = 0; i < 8; ++i) ra[i] = *(const u32x4*)(ap + (size_t)i * 32 * lda + k0_); \
    _Pragma("unroll") for (int i = 0; i < 4; ++i) rb[i] = *(const u32x4*)(bp + (size_t)i * 32 * ldb + k0_); }
#define SSTORE() { _Pragma("unroll") for (int i = 0; i < 8; ++i) *(u32x4*)(sa + 32 * i * 64) = ra[i]; \
    _Pragma("unroll") for (int i = 0; i < 4; ++i) *(u32x4*)(sb + 32 * i * 64) = rb[i]; }
#define FRAGS(RS) { _Pragma("unroll") for (int t = 0; t < 8; ++t) fa[t] = *(const bf16x8*)(Ard + t * 16 * 64 + (RS)); \
    _Pragma("unroll") for (int t = 0; t < 4; ++t) fb[t] = *(const bf16x8*)(Brd + t * 16 * 64 + (RS)); }
#define MMA() _Pragma("unroll") for (int mt = 0; mt < 8; ++mt) _Pragma("unroll") for (int nt = 0; nt < 4; ++nt) \
      acc[mt][nt] = SWAP ? mfma16(fb[nt], fa[mt], acc[mt][nt]) : mfma16(fa[mt], fb[nt], acc[mt][nt]);
  const int KT = K >> 6;
  bf16x8 fa[8], fb[4];
  GLOAD(0);
  for (int kt = 0; kt < KT; ++kt) {
    __syncthreads();
    SSTORE();
    __syncthreads();
    GLOAD((kt + 1 < KT ? kt + 1 : KT - 1));
    FRAGS(rs0);
    __builtin_amdgcn_sched_barrier(0);
    MMA();
    __builtin_amdgcn_sched_barrier(0);
    FRAGS(rs1);
    __builtin_amdgcn_sched_barrier(0);
    MMA();
  }
#undef GLOAD
#undef SSTORE
#undef FRAGS
#undef MMA
}

DEVI void zero_acc(f32x4 (&acc)[8][4]) {
#pragma unroll
  for (int i = 0; i < 8; ++i)
#pragma unroll
    for (int k = 0; k < 4; ++k) acc[i][k] = (f32x4){0.f, 0.f, 0.f, 0.f};
}


DEVI int xcd_remap(int l, int total) {
  int q = l >> 3;
  if ((q | 63) < (total >> 3))
    q = (q & ~63) | ((q & 31) << 1) | ((q >> 5) & 1);
  return (l & 7) * (total >> 3) + q;
}
DEVI void patch_tile(int v, int NT, int PN, int& mt, int& nt) {
  const int psz = 4 * PN, p = v / psz, i = v - p * psz, npn = NT / PN;
  const int pm = p / npn, pn = p - pm * npn;
  const int im = i / PN, in = i - im * PN;
  mt = pm * 4 + im;
  nt = pn * PN + in;
}

DEVI void tile_diff_in(const Params& P, int j, int tile, u16* smem) {
  int tm_, tn_; patch_tile(xcd_remap(tile, 1024), 32, 8, tm_, tn_);
  const int m0 = tm_ * 256, n0 = tn_ * 128;
  const int region = n0 >> 10;
  const u16* A = (const u16*)(P.ws + WS_H);
  const u16* B = (const u16*)(P.ws + WS_WDAIN) + (size_t)j * 4096 * 1024;
  f32x4 acc[8][4];
  zero_acc(acc);
  if (region == 2) gemm_core<false>(A, 1024, B, 1024, 1024, m0, n0, smem, acc);
  else gemm_core<true>(A, 1024, B, 1024, 1024, m0, n0, smem, acc);

  const int lane = tidx() & 63, w = tidx() >> 6, wm = w >> 1, wn = w & 1, g = lane >> 4, li = lane & 15;
  const int mb = m0 + wm * 128, nb = n0 + wn * 64;
  const bool isLat = mb >= 4096;
  const int b = mb >> 8, sb = mb & 255, bl = (mb - 4096) >> 10, tb = (mb - 4096) & 1023;
  const float* ropeC = (const float*)(P.ws + WS_ROPE);
  const float* ropeS = ropeC + 1024 * 32;
  if (region == 2) {
    const int cbase = nb - 2048;
    u16* vtc = (u16*)(P.ws + WS_VTCTX);
    u16* vtl = (u16*)(P.ws + WS_VTLATD) + (size_t)j * VTLATD_J;
#pragma unroll
    for (int mt = 0; mt < 8; ++mt) {
      const int r0 = mt * 16 + g * 4;
#pragma unroll
      for (int nt = 0; nt < 4; ++nt) {
        const int col = cbase + nt * 16 + li, h = col >> 7, e = col & 127;
        if (!isLat) {
          const int s = sb + r0;
          float* sv = P.out + OUT_SV + ((size_t)((b * 2 + j) * 256 + s)) * 1024 + col;
#pragma unroll
          for (int jj = 0; jj < 4; ++jj) sv[(size_t)jj * 1024] = acc[mt][nt][jj];
          st_bf4(vtc + ((size_t)((b * 8 + h) * 128 + e)) * 256 + s, acc[mt][nt]);
        } else {
          const int t = tb + r0;
          st_bf4(vtl + ((size_t)((bl * 8 + h) * 128 + e)) * 1280 + t, acc[mt][nt]);
        }
      }
    }
  } else {
    const float qs = 0.125f * LOG2E;
#pragma unroll
    for (int mt = 0; mt < 8; ++mt) {
      const int rl = mt * 16 + li, row = mb + rl;
      if (region <= 1 && isLat) {
        const int t = tb + rl;
#pragma unroll
        for (int nt = 0; nt < 2; ++nt)
          rope4(acc[mt][nt], acc[mt][nt + 2], ropeC + t * 32 + nt * 16 + g * 4, ropeS + t * 32 + nt * 16 + g * 4);
      }
      if (region == 1 && !isLat) {
#pragma unroll
        for (int nt = 0; nt < 4; ++nt)
          st_f4(P.out + OUT_SK + ((size_t)((b * 2 + j) * 256 + sb + rl)) * 1024 + (nb - 1024) + nt * 16 + g * 4, acc[mt][nt]);
      }
      u16* dst;
      if (region == 0) dst = (u16*)(P.ws + WS_Q) + (size_t)row * 1024 + nb;
      else if (region == 1) dst = isLat ? (u16*)(P.ws + WS_KDLAT) + (size_t)j * KDLAT_J + ((size_t)(bl * 1280 + tb + rl)) * 1024 + (nb - 1024)
                                        : (u16*)(P.ws + WS_CTXK) + (size_t)row * 1024 + (nb - 1024);
      else dst = (u16*)(P.ws + WS_G) + (size_t)row * 1024 + (nb - 3072);
#pragma unroll
      for (int np = 0; np < 2; ++np) {
        f32x4 va = acc[mt][2 * np], vb = acc[mt][2 * np + 1];
        if (region == 0) { va *= qs; vb *= qs; }
        else if (region == 3) {
#pragma unroll
          for (int jj = 0; jj < 4; ++jj) { va[jj] = silu(va[jj]); vb[jj] = silu(vb[jj]); }
        }
        st_pair(dst + np * 32, g, va, vb);
      }
    }
  }
}

DEVI void tile_mla_in(const Params& P, int j, int tile, u16* smem) {
  int tm_, tn_; patch_tile(xcd_remap(tile, 448), 14, 7, tm_, tn_);
  const int m0 = tm_ * 256, n0 = tn_ * 128;
  const u16* A = (const u16*)(P.ws + WS_H);
  const u16* B = (const u16*)(P.ws + WS_WMLAIN) + (size_t)j * 1792 * 1024;
  f32x4 acc[8][4];
  zero_acc(acc);
  gemm_core<true>(A, 1024, B, 1024, 1024, m0, n0, smem, acc);

  const int lane = tidx() & 63, w = tidx() >> 6, wm = w >> 1, wn = w & 1, g = lane >> 4, li = lane & 15;
  const int mb = m0 + wm * 128, nb = n0 + wn * 64;
  const bool isLat = mb >= 4096;
  const int b = mb >> 8, sb = mb & 255, bl = (mb - 4096) >> 10, tb = (mb - 4096) & 1023;
  const float* ropeC = (const float*)(P.ws + WS_ROPE);
  const float* ropeS = ropeC + 1024 * 32;
  if (nb >= 1728) return;
#pragma unroll
  for (int mt = 0; mt < 8; ++mt) {
    const int rl = mt * 16 + li, row = mb + rl;
    if (nb < 640) {
      float ss = 0.f;
#pragma unroll
      for (int nt = 0; nt < 4; ++nt)
#pragma unroll
        for (int jj = 0; jj < 4; ++jj) ss += acc[mt][nt][jj] * acc[mt][nt][jj];
      ss += xshfl(ss, 16);
      ss += xshfl(ss, 32);
      if (nb < 384) {
        if (g == 0) ((float*)(P.ws + WS_SSQQ))[row * 8 + (nb >> 6)] = ss;
#pragma unroll
        for (int np = 0; np < 2; ++np)
          st_pair((u16*)(P.ws + WS_QA) + (size_t)row * 384 + nb + np * 32, g, acc[mt][2 * np], acc[mt][2 * np + 1]);
      } else {
        if (g == 0) ((float*)(P.ws + WS_SSQKV))[row * 4 + ((nb - 384) >> 6)] = ss;
        const int arow = isLat ? (4096 + bl * 1280 + tb + rl) : row;
#pragma unroll
        for (int nt = 0; nt < 4; ++nt) {
          const int c2 = nb - 384 + nt * 16 + g * 4;
          if (!isLat) st_f4((float*)(P.ws + WS_KVRAW) + (size_t)row * 256 + c2, acc[mt][nt]);
        }
#pragma unroll
        for (int np = 0; np < 2; ++np)
          st_pair((u16*)(P.ws + WS_CKVA) + (size_t)j * CKVA_J + (size_t)arow * 256 + (nb - 384) + np * 32, g, acc[mt][2 * np], acc[mt][2 * np + 1]);
      }
    } else if (nb == 640) {
      if (isLat) {
        const int t = tb + rl;
#pragma unroll
        for (int nt = 0; nt < 2; ++nt)
          rope4(acc[mt][nt], acc[mt][nt + 2], ropeC + t * 32 + nt * 16 + g * 4, ropeS + t * 32 + nt * 16 + g * 4);
      }
#pragma unroll
      for (int nt = 0; nt < 4; ++nt) {
        const int d = nt * 16 + g * 4;
        if (!isLat) {
          st_f4(P.out + OUT_KPE + ((size_t)((b * 2 + j) * 256 + sb + rl)) * 64 + d, acc[mt][nt]);
          u16* kd = (u16*)(P.ws + WS_CTXK) + ((size_t)(b * 8) * 256 + sb + rl) * 192 + 128 + d;
#pragma unroll
          for (int h = 0; h < 8; ++h) st_bf4(kd + (size_t)h * 256 * 192, acc[mt][nt]);
        } else {
          u16* kd = (u16*)(P.ws + WS_KMLAT) + (size_t)j * KMLAT_J + ((size_t)(bl * 8) * 1280 + tb + rl) * 192 + 128 + d;
#pragma unroll
          for (int h = 0; h < 8; ++h) st_bf4(kd + (size_t)h * 1280 * 192, acc[mt][nt]);
        }
      }
    } else {
#pragma unroll
      for (int np = 0; np < 2; ++np) {
        f32x4 va = acc[mt][2 * np], vb = acc[mt][2 * np + 1];
#pragma unroll
        for (int jj = 0; jj < 4; ++jj) { va[jj] = silu(va[jj]); vb[jj] = silu(vb[jj]); }
        st_pair((u16*)(P.ws + WS_G) + (size_t)row * 1024 + (nb - 704) + np * 32, g, va, vb);
      }
    }
  }
}

DEVI void tile_qb(const Params& P, int j, int tile, u16* smem) {
  int tm_, tn_; patch_tile(xcd_remap(tile, 384), 12, 6, tm_, tn_);
  const int m0 = tm_ * 256, n0 = tn_ * 128;
  const u16* A = (const u16*)(P.ws + WS_QA);
  const u16* B = (const u16*)(P.ws + WS_WQB) + (size_t)j * 1536 * 384;
  f32x4 acc[8][4];
  zero_acc(acc);
  gemm_core<true>(A, 384, B, 384, 384, m0, n0, smem, acc);
  const int lane = tidx() & 63, w = tidx() >> 6, wm = w >> 1, wn = w & 1, g = lane >> 4, li = lane & 15;
  const int mb = m0 + wm * 128, nb = n0 + wn * 64;
  const bool isLat = mb >= 4096;
  const int tb = (mb - 4096) & 1023;
  const float* ropeC = (const float*)(P.ws + WS_ROPE);
  const float* ropeS = ropeC + 1024 * 32;
  const float* ssq = (const float*)(P.ws + WS_SSQQ);
  const bool isRope = (nb % 192) == 128;
  const float qs = 0.07216878364870322f * LOG2E;
#pragma unroll
  for (int mt = 0; mt < 8; ++mt) {
    const int rl = mt * 16 + li, row = mb + rl;
    float ss = 0.f;
#pragma unroll
    for (int i = 0; i < 6; ++i) ss += ssq[row * 8 + i];
    const float r = rsqrtf(ss * (1.f / 384.f) + EPS) * qs;
    if (isRope && isLat) {
      const int t = tb + rl;
#pragma unroll
      for (int nt = 0; nt < 2; ++nt)
        rope4(acc[mt][nt], acc[mt][nt + 2], ropeC + t * 32 + nt * 16 + g * 4, ropeS + t * 32 + nt * 16 + g * 4);
    }
#pragma unroll
    for (int np = 0; np < 2; ++np)
      st_pair((u16*)(P.ws + WS_Q) + (size_t)row * 1536 + nb + np * 32, g, acc[mt][2 * np] * r, acc[mt][2 * np + 1] * r);
  }
}

DEVI void tile_kvb(const Params& P, int j, int tile, u16* smem) {
  int tm_, tn_; patch_tile(xcd_remap(tile, 576), 16, 8, tm_, tn_);
  const int m0 = tm_ * 256, n0 = tn_ * 128;
  const bool tileLat = m0 >= 4096;
  const bool fresh = !tileLat || ((m0 - 4096) % 1280) < 1024;
  const u16* A = (const u16*)(P.ws + WS_CKVA) + (size_t)j * CKVA_J;
  const u16* B = (const u16*)(P.ws + (fresh ? WS_WKVBG : WS_WKVB)) + (size_t)j * 2048 * 256;
  const bool isV = (n0 >> 7) & 1;
  const int h = n0 >> 8;
  f32x4 acc[8][4];
  zero_acc(acc);
  if (isV) gemm_core<false>(A, 256, B, 256, 256, m0, n0, smem, acc);
  else gemm_core<true>(A, 256, B, 256, 256, m0, n0, smem, acc);
  const int lane = tidx() & 63, w = tidx() >> 6, wm = w >> 1, wn = w & 1, g = lane >> 4, li = lane & 15;
  const int mb = m0 + wm * 128;
  int b, keyb, Sk, tokb;
  u16 *Kd, *Vd;
  if (!tileLat) {
    b = mb >> 8; keyb = mb & 255; Sk = 256; tokb = mb;
    Kd = (u16*)(P.ws + WS_CTXK); Vd = (u16*)(P.ws + WS_VTCTX);
  } else {
    const int r2 = mb - 4096;
    b = r2 / 1280; keyb = r2 % 1280; Sk = 1280; tokb = 4096 + b * 1024 + keyb;
    Kd = (u16*)(P.ws + WS_KMLAT) + (size_t)j * KMLAT_J; Vd = (u16*)(P.ws + WS_VTLATM);
  }
  const float* ssq = (const float*)(P.ws + WS_SSQKV);
  if (!isV) {
#pragma unroll
    for (int mt = 0; mt < 8; ++mt) {
      const int rl = mt * 16 + li;
      float r = 1.f;
      if (fresh) {
        const float4 s4 = *(const float4*)(ssq + (size_t)(tokb + rl) * 4);
        r = rsqrtf((s4.x + s4.y + s4.z + s4.w) * (1.f / 256.f) + EPS);
      }
#pragma unroll
      for (int np = 0; np < 2; ++np)
        st_pair(Kd + ((size_t)((b * 8 + h) * Sk + keyb + rl)) * 192 + wn * 64 + np * 32, g, acc[mt][2 * np] * r, acc[mt][2 * np + 1] * r);
    }
  } else {
#pragma unroll
    for (int mt = 0; mt < 8; ++mt) {
      const int r0 = mt * 16 + g * 4;
      f32x4 rr = {1.f, 1.f, 1.f, 1.f};
      if (fresh) {
#pragma unroll
        for (int jj = 0; jj < 4; ++jj) {
          const float4 s4 = *(const float4*)(ssq + (size_t)(tokb + r0 + jj) * 4);
          rr[jj] = rsqrtf((s4.x + s4.y + s4.z + s4.w) * (1.f / 256.f) + EPS);
        }
      }
#pragma unroll
      for (int nt = 0; nt < 4; ++nt) {
        const int e = wn * 64 + nt * 16 + li;
        st_bf4(Vd + ((size_t)((b * 8 + h) * 128 + e)) * Sk + keyb + r0, acc[mt][nt] * rr);
      }
    }
  }
}

DEVI void tile_out(const Params& P, int layer, int tile, u16* smem) {
  int tm_, tn_; patch_tile(xcd_remap(tile, 256), 8, 8, tm_, tn_);
  const int m0 = tm_ * 256, n0 = tn_ * 128;
  const u16* A = (const u16*)(P.ws + WS_O);
  const u16* B = (const u16*)(P.ws + WS_WOUT) + (size_t)layer * 1024 * 1024;
  f32x4 acc[8][4];
  zero_acc(acc);
  gemm_core<true>(A, 1024, B, 1024, 1024, m0, n0, smem, acc);
  const int lane = tidx() & 63, w = tidx() >> 6, wm = w >> 1, wn = w & 1, g = lane >> 4, li = lane & 15;
  const int mb = m0 + wm * 128, nb = n0 + wn * 64;
  u16* T = (u16*)(P.ws + WS_T);
#pragma unroll
  for (int mt = 0; mt < 8; ++mt)
#pragma unroll
    for (int np = 0; np < 2; ++np)
      st_pair(T + (size_t)(mb + mt * 16 + li) * 1024 + nb + np * 32, g, acc[mt][2 * np], acc[mt][2 * np + 1]);
}

template <bool DIFF>
DEVI void attn_item(const Params& P, const u16* __restrict__ Qb, int ldq, int qrow0,
                    const u16* __restrict__ Kb, int ldk, const u16* __restrict__ Vt, int Sk,
                    int h, float lam, float lam_init, const float* gsub, u16* smem) {
  constexpr int KW = DIFF ? 128 : 192;
  constexpr int KLD = KW + 16;
  constexpr int NKK = DIFF ? 2 : 6;
  constexpr int KT = DIFF ? 64 : 32;
  constexpr int NS = KT / 16;
  constexpr int NU = KT / 32;
  constexpr int KCH = KW / 8;
  constexpr int NKL = (KT * KCH) / 256;
  constexpr int VCH = KT / 8;
  constexpr int NVL = (128 * VCH) / 256;
  constexpr int VLD = KT + 8;
  constexpr int STAGE = KT * KLD + 128 * VLD;
  const int tid = tidx(), lane = tid & 63, w = tid >> 6, g = lane >> 4, li = lane & 15;

  bf16x8 qf[2][NKK];
#pragma unroll
  for (int s = 0; s < 2; ++s) {
    const int qrow = DIFF ? (qrow0 + w * 16 + li) : (qrow0 + w * 32 + s * 16 + li);
    const int qcol = DIFF ? (h * 128 + s * 64) : (h * 192);
#pragma unroll
    for (int kk = 0; kk < NKK; ++kk)
      qf[s][kk] = *(const bf16x8*)(Qb + (size_t)qrow * ldq + qcol + kk * 32 + g * 8);
  }
  f32x4 oacc[2][8];
#pragma unroll
  for (int s = 0; s < 2; ++s)
#pragma unroll
    for (int et = 0; et < 8; ++et) oacc[s][et] = (f32x4){0.f, 0.f, 0.f, 0.f};
  float mrow[2] = {-1e30f, -1e30f}, lrow[2] = {0.f, 0.f};

  u32x4 rk[NKL], rv[NVL];
  auto gload = [&](int key0) {
#pragma unroll
    for (int i = 0; i < NKL; ++i) {
      const int c = tid + 256 * i, r = c / KCH, cc = c % KCH;
      rk[i] = *(const u32x4*)(Kb + (size_t)(key0 + r) * ldk + cc * 8);
    }
#pragma unroll
    for (int i = 0; i < NVL; ++i) {
      const int c = tid + 256 * i, r = c / VCH, cc = c % VCH;
      rv[i] = *(const u32x4*)(Vt + (size_t)r * Sk + key0 + cc * 8);
    }
  };
  auto sstore = [&](int buf) {
    u16* Kw = smem + buf * STAGE;
    u16* Vw = Kw + KT * KLD;
#pragma unroll
    for (int i = 0; i < NKL; ++i) {
      const int c = tid + 256 * i, r = c / KCH, cc = c % KCH;
      *(u32x4*)(Kw + r * KLD + cc * 8) = rk[i];
    }
#pragma unroll
    for (int i = 0; i < NVL; ++i) {
      const int c = tid + 256 * i, r = c / VCH, cc = c % VCH;
      *(u32x4*)(Vw + r * VLD + cc * 8) = rv[i];
    }
  };
  const int NT = Sk / KT;
  gload(0);
  __syncthreads();
  sstore(0);
  gload(NT > 1 ? KT : 0);
  __syncthreads();
  for (int kt0 = 0; kt0 < NT; ++kt0) {
    const u16* Ks = smem + (kt0 & 1) * STAGE;
    const u16* Vs = Ks + KT * KLD;
    if (kt0 + 1 < NT) {
      sstore((kt0 + 1) & 1);
      gload((kt0 + 2 < NT ? kt0 + 2 : NT - 1) * KT);
    }

    f32x4 st[2][NS];
#pragma unroll
    for (int s = 0; s < 2; ++s)
#pragma unroll
      for (int kt = 0; kt < NS; ++kt) st[s][kt] = (f32x4){0.f, 0.f, 0.f, 0.f};
    {
      constexpr int NF = DIFF ? NKK * NS * 2 : NKK * NS;
      auto kaddr = [&](int f) -> const u16* {
        if (DIFF) { const int s2 = f & 1, kt = (f >> 1) % NS, kk = (f >> 1) / NS; return Ks + (kt * 16 + li) * KLD + s2 * 64 + kk * 32 + g * 8; }
        else { const int kt = f % NS, kk = f / NS; return Ks + (kt * 16 + li) * KLD + kk * 32 + g * 8; }
      };
      bf16x8 kf[3];
      kf[0] = *(const bf16x8*)kaddr(0);
      kf[1] = *(const bf16x8*)kaddr(1);
#pragma unroll
      for (int f = 0; f < NF; ++f) {
        if (f + 2 < NF) kf[(f + 2) % 3] = *(const bf16x8*)kaddr(f + 2);
        __builtin_amdgcn_sched_barrier(0);
        if (DIFF) {
          const int s2 = f & 1, kt = (f >> 1) % NS, kk = (f >> 1) / NS;
          st[s2][kt] = mfma16(kf[f % 3], qf[s2][kk], st[s2][kt]);
        } else {
          const int kt = f % NS, kk = f / NS;
          st[0][kt] = mfma16(kf[f % 3], qf[0][kk], st[0][kt]);
          st[1][kt] = mfma16(kf[f % 3], qf[1][kk], st[1][kt]);
        }
        __builtin_amdgcn_sched_barrier(0);
      }
    }
    bf16x8 pf[2][NU];
#pragma unroll
    for (int s = 0; s < 2; ++s) {
      float mx = st[s][0][0];
#pragma unroll
      for (int kt = 0; kt < NS; ++kt)
#pragma unroll
        for (int jj = 0; jj < 4; ++jj) mx = fmaxf(mx, st[s][kt][jj]);
      mx = fmaxf(mx, xshfl(mx, 16));
      mx = fmaxf(mx, xshfl(mx, 32));
      const bool need = mx > mrow[s] + 8.f;
      float mnew = mrow[s];
      if (__builtin_amdgcn_ballot_w64(need) != 0ull) {
        mnew = need ? mx : mrow[s];
        const float alpha = __builtin_amdgcn_exp2f(mrow[s] - mnew);
        mrow[s] = mnew;
        lrow[s] *= alpha;
#pragma unroll
        for (int et = 0; et < 8; ++et) oacc[s][et] *= alpha;
      }
      float ps = 0.f;
#pragma unroll
      for (int kt = 0; kt < NS; ++kt)
#pragma unroll
        for (int jj = 0; jj < 4; ++jj) {
          const float p = __builtin_amdgcn_exp2f(st[s][kt][jj] - mnew);
          st[s][kt][jj] = p;
          ps += p;
        }
      lrow[s] += ps;
#pragma unroll
      for (int u = 0; u < NU; ++u) {
        union { bf16x8 v; unsigned d[4]; } pu;
        pu.d[0] = pk2(st[s][2 * u][0], st[s][2 * u][1]);
        pu.d[1] = pk2(st[s][2 * u][2], st[s][2 * u][3]);
        pu.d[2] = pk2(st[s][2 * u + 1][0], st[s][2 * u + 1][1]);
        pu.d[3] = pk2(st[s][2 * u + 1][2], st[s][2 * u + 1][3]);
        pf[s][u] = pu.v;
      }
    }
    {
      constexpr int NF = NU * 8;
      union VU { bf16x8 v; u32x2 d[2]; };
      VU vf[3];
      auto vload = [&](VU& o, int f) {
        const int u = f >> 3, et = f & 7;
        o.d[0] = *(const u32x2*)(Vs + (et * 16 + li) * VLD + (2 * u) * 16 + g * 4);
        o.d[1] = *(const u32x2*)(Vs + (et * 16 + li) * VLD + (2 * u + 1) * 16 + g * 4);
      };
      vload(vf[0], 0);
      vload(vf[1], 1);
#pragma unroll
      for (int f = 0; f < NF; ++f) {
        if (f + 2 < NF) vload(vf[(f + 2) % 3], f + 2);
        __builtin_amdgcn_sched_barrier(0);
        const int u = f >> 3, et = f & 7;
        oacc[0][et] = mfma16(vf[f % 3].v, pf[0][u], oacc[0][et]);
        oacc[1][et] = mfma16(vf[f % 3].v, pf[1][u], oacc[1][et]);
        __builtin_amdgcn_sched_barrier(0);
      }
    }
    __syncthreads();
  }
#pragma unroll
  for (int s = 0; s < 2; ++s) {
    lrow[s] += xshfl(lrow[s], 16);
    lrow[s] += xshfl(lrow[s], 32);
  }
  const u16* G = (const u16*)(P.ws + WS_G);
  u16* O = (u16*)(P.ws + WS_O);
  if (DIFF) {
    const float i0 = 1.f / lrow[0], i1 = lam / lrow[1];
    float ss = 0.f;
#pragma unroll
    for (int et = 0; et < 8; ++et) {
      oacc[0][et] = oacc[0][et] * i0 - oacc[1][et] * i1;
#pragma unroll
      for (int jj = 0; jj < 4; ++jj) ss += oacc[0][et][jj] * oacc[0][et][jj];
    }
    ss += xshfl(ss, 16);
    ss += xshfl(ss, 32);
    const float rr = rsqrtf(ss * (1.f / 128.f) + EPS) * (1.f - lam_init);
    const size_t tok = (size_t)(qrow0 + w * 16 + li);
#pragma unroll
    for (int et = 0; et < 8; ++et) {
      const int e = et * 16 + g * 4;
      const float4 gs = *(const float4*)(gsub + e);
      const uint2 gg = *(const uint2*)(G + tok * 1024 + h * 128 + e);
      f32x4 v = oacc[0][et] * rr;
      v[0] *= gs.x * bf2f(gg.x & 0xffffu);
      v[1] *= gs.y * bf2f(gg.x >> 16);
      v[2] *= gs.z * bf2f(gg.y & 0xffffu);
      v[3] *= gs.w * bf2f(gg.y >> 16);
      st_bf4(O + tok * 1024 + h * 128 + e, v);
    }
  } else {
#pragma unroll
    for (int s = 0; s < 2; ++s) {
      const float inv = 1.f / lrow[s];
      const size_t tok = (size_t)(qrow0 + w * 32 + s * 16 + li);
#pragma unroll
      for (int et = 0; et < 8; ++et) {
        const int e = et * 16 + g * 4;
        const uint2 gg = *(const uint2*)(G + tok * 1024 + h * 128 + e);
        f32x4 v = oacc[s][et] * inv;
        v[0] *= bf2f(gg.x & 0xffffu);
        v[1] *= bf2f(gg.x >> 16);
        v[2] *= bf2f(gg.y & 0xffffu);
        v[3] *= bf2f(gg.y >> 16);
        st_bf4(O + tok * 1024 + h * 128 + e, v);
      }
    }
  }
}

DEVI void attn_diff_phase(const Params& P, int j, u16* smem) {
  const float* lamv = (const float*)(P.ws + WS_MISC);
  const float lam = lamv[j * 2], lam_init = lamv[j * 2 + 1];
  const float* gsub = P.in[I_GSUB] + j * 128;
  const u16* Q = (const u16*)(P.ws + WS_Q);
  for (int it = blockIdx.x; it < 1024; it += gridDim.x) {
    if (it < 512) {
      const int iv = xcd_remap(it, 512);
      const int bl = iv >> 7, h = (iv >> 4) & 7, qt = iv & 15;
      const u16* Kb = (const u16*)(P.ws + WS_KDLAT) + (size_t)j * KDLAT_J + (size_t)bl * 1280 * 1024 + h * 128;
      const u16* Vt = (const u16*)(P.ws + WS_VTLATD) + (size_t)j * VTLATD_J + (size_t)(bl * 8 + h) * 128 * 1280;
      attn_item<true>(P, Q, 1024, 4096 + bl * 1024 + qt * 64, Kb, 1024, Vt, 1280, h, lam, lam_init, gsub, smem);
    } else {
      const int i2 = xcd_remap(it - 512, 512), b = i2 >> 5, h = (i2 >> 2) & 7, qt = i2 & 3;
      const u16* Kb = (const u16*)(P.ws + WS_CTXK) + (size_t)b * 256 * 1024 + h * 128;
      const u16* Vt = (const u16*)(P.ws + WS_VTCTX) + (size_t)(b * 8 + h) * 128 * 256;
      attn_item<true>(P, Q, 1024, b * 256 + qt * 64, Kb, 1024, Vt, 256, h, lam, lam_init, gsub, smem);
    }
  }
}

DEVI void attn_mla_phase(const Params& P, int j, u16* smem) {
  const u16* Q = (const u16*)(P.ws + WS_Q);
  for (int it = blockIdx.x; it < 512; it += gridDim.x) {
    if (it < 256) {
      const int iv = xcd_remap(it, 256);
      const int bl = iv >> 6, h = (iv >> 3) & 7, qt = iv & 7;
      const u16* Kb = (const u16*)(P.ws + WS_KMLAT) + (size_t)j * KMLAT_J + (size_t)(bl * 8 + h) * 1280 * 192;
      const u16* Vt = (const u16*)(P.ws + WS_VTLATM) + (size_t)(bl * 8 + h) * 128 * 1280;
      attn_item<false>(P, Q, 1536, 4096 + bl * 1024 + qt * 128, Kb, 192, Vt, 1280, h, 0.f, 0.f, nullptr, smem);
    } else {
      const int i2 = xcd_remap(it - 256, 256), b = i2 >> 4, h = (i2 >> 1) & 7, qt = i2 & 1;
      const u16* Kb = (const u16*)(P.ws + WS_CTXK) + (size_t)(b * 8 + h) * 256 * 192;
      const u16* Vt = (const u16*)(P.ws + WS_VTCTX) + (size_t)(b * 8 + h) * 128 * 256;
      attn_item<false>(P, Q, 1536, b * 256 + qt * 128, Kb, 192, Vt, 256, h, 0.f, 0.f, nullptr, smem);
    }
  }
}

DEVI float wave_sum(float v) {
  v += xshfl(v, 1); v += xshfl(v, 2); v += xshfl(v, 4); v += xshfl(v, 8); v += xshfl(v, 16); v += xshfl(v, 32);
  return v;
}

DEVI void ew_phase(const Params& P, int layer) {
  const int lane = tidx() & 63, w = tidx() >> 6;
  const float* ada = (const float*)(P.ws + WS_ADA);
  const u16* T = (const u16*)(P.ws + WS_T);
  u16* H = (u16*)(P.ws + WS_H);
  const int nl = layer + 1;
  for (int r0 = blockIdx.x * 4 + w; r0 < 4096; r0 += gridDim.x * 4) {
    float4 x[2][4], t[2][4];
#pragma unroll
    for (int q = 0; q < 2; ++q) {
      const int row = r0 + q * 4096;
      const float* xsrc = (layer <= 0) ? (q == 0 ? P.in[I_XP] + (size_t)row * 1024 : P.in[I_XS] + (size_t)(row - 4096) * 1024)
                                       : P.out + OUT_Y + (size_t)row * 1024;
#pragma unroll
      for (int i = 0; i < 4; ++i) x[q][i] = *(const float4*)(xsrc + lane * 4 + i * 256);
      if (layer >= 0) {
#pragma unroll
        for (int i = 0; i < 4; ++i) {
          const u32x2 tv = *(const u32x2*)(T + (size_t)row * 1024 + lane * 4 + i * 256);
          t[q][i] = make_float4(bf2f(tv[0] & 0xffffu), bf2f(tv[0] >> 16), bf2f(tv[1] & 0xffffu), bf2f(tv[1] >> 16));
        }
      }
    }
#pragma unroll
    for (int q = 0; q < 2; ++q) {
      const int row = r0 + q * 4096;
      const int cond = q == 0 ? 0 : 1 + (r0 >> 10);
      if (layer >= 0) {
        float ss = 0.f;
#pragma unroll
        for (int i = 0; i < 4; ++i)
          ss += t[q][i].x * t[q][i].x + t[q][i].y * t[q][i].y + t[q][i].z * t[q][i].z + t[q][i].w * t[q][i].w;
        ss = wave_sum(ss);
        const float rt = rsqrtf(ss * (1.f / 1024.f) + EPS);
        const float* gate = ada + (size_t)(layer * 5 + cond) * 3072 + 2048;
        const float* gp = P.in[I_GPOST] + layer * 1024;
#pragma unroll
        for (int i = 0; i < 4; ++i) {
          const int c = lane * 4 + i * 256;
          const float4 ga = *(const float4*)(gate + c);
          const float4 gq = *(const float4*)(gp + c);
          x[q][i].x += ga.x * (t[q][i].x * rt * gq.x);
          x[q][i].y += ga.y * (t[q][i].y * rt * gq.y);
          x[q][i].z += ga.z * (t[q][i].z * rt * gq.z);
          x[q][i].w += ga.w * (t[q][i].w * rt * gq.w);
          *(float4*)(P.out + OUT_Y + (size_t)row * 1024 + c) = x[q][i];
        }
      }
      if (nl < 4) {
        float ss = 0.f;
#pragma unroll
        for (int i = 0; i < 4; ++i)
          ss += x[q][i].x * x[q][i].x + x[q][i].y * x[q][i].y + x[q][i].z * x[q][i].z + x[q][i].w * x[q][i].w;
        ss = wave_sum(ss);
        const float rx = rsqrtf(ss * (1.f / 1024.f) + EPS);
        const float* sh = ada + (size_t)(nl * 5 + cond) * 3072;
        const float* sc = sh + 1024;
        const float* gpre = P.in[I_GPRE] + nl * 1024;
#pragma unroll
        for (int i = 0; i < 4; ++i) {
          const int c = lane * 4 + i * 256;
          const float4 s1 = *(const float4*)(sh + c);
          const float4 s2 = *(const float4*)(sc + c);
          const float4 gq = *(const float4*)(gpre + c);
          f32x4 hv;
          hv[0] = x[q][i].x * rx * gq.x * (1.f + s2.x) + s1.x;
          hv[1] = x[q][i].y * rx * gq.y * (1.f + s2.y) + s1.y;
          hv[2] = x[q][i].z * rx * gq.z * (1.f + s2.z) + s1.z;
          hv[3] = x[q][i].w * rx * gq.w * (1.f + s2.w) + s1.w;
          st_bf4(H + (size_t)row * 1024 + c, hv);
        }
      }
    }
  }
}

DEVI void tr_tile(const float* __restrict__ src, int lds, int k0, int n0, int nvalid, u16* __restrict__ dst, int ldd,
                  const float* kscale, float* tile) {
  const int tid = tidx();
  float4 v[4];
#pragma unroll
  for (int i = 0; i < 4; ++i) {
    const int idx = tid + 256 * i, kk = idx >> 4, c4 = (idx & 15) * 4;
    v[i] = (n0 + c4 < nvalid) ? *(const float4*)(src + (size_t)(k0 + kk) * lds + n0 + c4) : make_float4(0.f, 0.f, 0.f, 0.f);
    if (kscale) { const float ks = kscale[k0 + kk]; v[i].x *= ks; v[i].y *= ks; v[i].z *= ks; v[i].w *= ks; }
  }
  __syncthreads();
#pragma unroll
  for (int i = 0; i < 4; ++i) {
    const int idx = tid + 256 * i, kk = idx >> 4, c4 = (idx & 15) * 4;
    float* tp = tile + kk * 65 + c4;
    tp[0] = v[i].x; tp[1] = v[i].y; tp[2] = v[i].z; tp[3] = v[i].w;
  }
  __syncthreads();
#pragma unroll
  for (int i = 0; i < 2; ++i) {
    const int c = tid + 256 * i, nn = c >> 3, kc = (c & 7) * 8;
    const float* tp = tile + kc * 65 + nn;
    u32x4 u;
    u[0] = pk2(tp[0], tp[65]); u[1] = pk2(tp[2 * 65], tp[3 * 65]); u[2] = pk2(tp[4 * 65], tp[5 * 65]); u[3] = pk2(tp[6 * 65], tp[7 * 65]);
    *(u32x4*)(dst + (size_t)(n0 + nn) * ldd + k0 + kc) = u;
  }
}

constexpr int N_ADA = 384;
constexpr int N_TWOUT = 1024, N_TDAIN = 2048, N_TMLAIN = 896, N_TQB = 288, N_TKVB = 256, N_TCV = 512;
constexpr int N_ROPE = 128, N_LAM = 1, N_CDK = 1024, N_CCKV = 256, N_CKPE = 64;
constexpr int P0_ITEMS = N_ADA + N_TWOUT + N_TDAIN + N_TMLAIN + N_TQB + N_TKVB + N_TCV + N_ROPE + N_LAM + N_CDK + N_CCKV + N_CKPE;

constexpr int PI_A = N_ADA, PI_D = PI_A + N_TWOUT, PI_M = PI_D + N_TDAIN, PI_Q = PI_M + N_TMLAIN, PI_K = PI_Q + N_TQB, PI_C = PI_K + N_TKVB;
DEVI int prep_map(int set, int n) {
  int lo[4], hi[4];
  if (set == 0)      { lo[0] = 0;          hi[0] = PI_A;        lo[1] = PI_A;       hi[1] = PI_A + 256;  lo[2] = PI_D;        hi[2] = PI_D + 1024; lo[3] = PI_C;       hi[3] = P0_ITEMS; }
  else if (set == 1) { lo[0] = PI_M;       hi[0] = PI_M + 448;  lo[1] = PI_Q;       hi[1] = PI_Q + 144;  lo[2] = PI_K;        hi[2] = PI_K + 128;  lo[3] = PI_A + 256; hi[3] = PI_A + 512; }
  else if (set == 2) { lo[0] = PI_D + 1024; hi[0] = PI_D + 2048; lo[1] = PI_A + 512; hi[1] = PI_A + 768;  lo[2] = 0;           hi[2] = 0;           lo[3] = 0;          hi[3] = 0; }
  else               { lo[0] = PI_M + 448; hi[0] = PI_M + 896;  lo[1] = PI_Q + 144; hi[1] = PI_Q + 288;  lo[2] = PI_K + 128;  hi[2] = PI_K + 256;  lo[3] = PI_A + 768; hi[3] = PI_A + 1024; }
#pragma unroll
  for (int r = 0; r < 4; ++r) {
    const int c = hi[r] - lo[r];
    if (n < c) return lo[r] + n;
    n -= c;
  }
  return -1;
}

DEVI void prep_phase(const Params& P, u16* smem, int set, int bid, int nb) {
  float* fs = (float*)smem;
  const int tid = tidx();
  for (int n = bid; ; n += nb) {
    const int item = prep_map(set, n);
    if (item < 0) break;
    int it = item;
    if (it < N_ADA) {
      const int layer = it / 96, cgp = it % 96;
      float* sc = fs;
      float* red = fs + 5120;
      __syncthreads();
      for (int idx = tid; idx < 5120; idx += 256) {
        const int cnd = idx >> 10, k = idx & 1023;
        const float v = cnd == 0 ? P.in[I_CCTX][k] : P.in[I_C][(cnd - 1) * 1024 + k];
        sc[idx] = silu(v);
      }
      __syncthreads();
      const int col = tid & 31, kg = tid >> 5;
      const float* wp = P.in[I_WADA] + (size_t)layer * 1024 * 3072 + cgp * 32 + col;
      float a0 = 0.f, a1 = 0.f, a2 = 0.f, a3 = 0.f, a4 = 0.f;
#pragma unroll 16
      for (int k = kg * 128; k < kg * 128 + 128; ++k) {
        const float wv = wp[(size_t)k * 3072];
        a0 += sc[k] * wv; a1 += sc[1024 + k] * wv; a2 += sc[2048 + k] * wv; a3 += sc[3072 + k] * wv; a4 += sc[4096 + k] * wv;
      }
      red[(kg * 5 + 0) * 32 + col] = a0; red[(kg * 5 + 1) * 32 + col] = a1; red[(kg * 5 + 2) * 32 + col] = a2;
      red[(kg * 5 + 3) * 32 + col] = a3; red[(kg * 5 + 4) * 32 + col] = a4;
      __syncthreads();
      if (tid < 160) {
        const int cnd = tid >> 5, c2 = tid & 31;
        float s = P.in[I_BADA][layer * 3072 + cgp * 32 + c2];
#pragma unroll
        for (int q = 0; q < 8; ++q) s += red[(q * 5 + cnd) * 32 + c2];
        ((float*)(P.ws + WS_ADA))[(size_t)(layer * 5 + cnd) * 3072 + cgp * 32 + c2] = s;
      }
      continue;
    }
    it -= N_ADA;
    if (it < N_TWOUT) {
      const int l = it >> 8, kt = (it >> 4) & 15, nt = it & 15;
      tr_tile(P.in[I_WOUT] + (size_t)l * 1024 * 1024, 1024, kt * 64, nt * 64, 1024,
              (u16*)(P.ws + WS_WOUT) + (size_t)l * 1024 * 1024, 1024, nullptr, fs);
      continue;
    }
    it -= N_TWOUT;
    if (it < N_TDAIN) {
      const int l = it >> 10, kt = (it >> 6) & 15, nt = it & 63;
      tr_tile(P.in[I_DAWIN] + (size_t)l * 1024 * 4096, 4096, kt * 64, nt * 64, 4096,
              (u16*)(P.ws + WS_WDAIN) + (size_t)l * 4096 * 1024, 1024, nullptr, fs);
      continue;
    }
    it -= N_TDAIN;
    if (it < N_TMLAIN) {
      const int l = it / 448, r = it % 448, kt = r / 28, nt = r % 28;
      tr_tile(P.in[I_MWIN] + (size_t)l * 1024 * 1728, 1728, kt * 64, nt * 64, 1728,
              (u16*)(P.ws + WS_WMLAIN) + (size_t)l * 1792 * 1024, 1024, nullptr, fs);
      continue;
    }
    it -= N_TMLAIN;
    if (it < N_TQB) {
      const int l = it / 144, r = it % 144, kt = r / 24, nt = r % 24;
      tr_tile(P.in[I_WQB] + (size_t)l * 384 * 1536, 1536, kt * 64, nt * 64, 1536,
              (u16*)(P.ws + WS_WQB) + (size_t)l * 1536 * 384, 384, P.in[I_GQA] + l * 384, fs);
      continue;
    }
    it -= N_TQB;
    if (it < N_TKVB) {
      const int l = it >> 7, kt = (it >> 5) & 3, nt = it & 31;
      tr_tile(P.in[I_WKVB] + (size_t)l * 256 * 2048, 2048, kt * 64, nt * 64, 2048,
              (u16*)(P.ws + WS_WKVB) + (size_t)l * 2048 * 256, 256, nullptr, fs);
      tr_tile(P.in[I_WKVB] + (size_t)l * 256 * 2048, 2048, kt * 64, nt * 64, 2048,
              (u16*)(P.ws + WS_WKVBG) + (size_t)l * 2048 * 256, 256, P.in[I_GKVA] + l * 256, fs);
      continue;
    }
    it -= N_TKVB;
    if (it < N_TCV) {
      const int grp = it >> 3, sub = it & 7, bl = grp >> 4, jj = (grp >> 3) & 1, h = grp & 7, pt = sub >> 1, et = sub & 1;
      const float* src = P.in[I_CDV] + ((size_t)(bl * 2 + jj) * 256) * 1024 + h * 128;
      u16* dst = (u16*)(P.ws + WS_VTLATD) + (size_t)jj * VTLATD_J + (size_t)(bl * 8 + h) * 128 * 1280 + 1024;
      tr_tile(src, 1024, pt * 64, et * 64, 128, dst, 1280, nullptr, fs);
      continue;
    }
    it -= N_TCV;
    if (it < N_ROPE) {
      const int idx = it * 256 + tid, t = idx >> 5, p = idx & 31, f = p & 15;
      const float inv = exp2f(-(float)f * (13.287712379549449f / 16.f));
      const float pos = (p < 16) ? (float)(t >> 6) : (float)(t & 63);
      float sn, cs;
      sincosf(pos * inv, &sn, &cs);
      float* rc = (float*)(P.ws + WS_ROPE);
      rc[idx] = cs;
      rc[1024 * 32 + idx] = sn;
      continue;
    }
    it -= N_ROPE;
    if (it < N_LAM) {
      if (tid < 2) {
        const int jd = tid;
        float s1 = 0.f, s2 = 0.f;
        for (int d = 0; d < 64; ++d) {
          s1 += P.in[I_LQ1][jd * 64 + d] * P.in[I_LK1][jd * 64 + d];
          s2 += P.in[I_LQ2][jd * 64 + d] * P.in[I_LK2][jd * 64 + d];
        }
        const float li = 0.8f - 0.6f * expf(-0.3f * (float)(2 * jd));
        float* lamv = (float*)(P.ws + WS_MISC);
        lamv[jd * 2] = expf(s1) - expf(s2) + li;
        lamv[jd * 2 + 1] = li;
      }
      continue;
    }
    it -= N_LAM;
    if (it < N_CDK) {
      const size_t e0 = ((size_t)it * 256 + tid) * 8;
      const int col = e0 & 1023, p = (e0 >> 10) & 255, jj = (e0 >> 18) & 1, bl = (int)(e0 >> 19);
      const float4 a = *(const float4*)(P.in[I_CDK] + e0);
      const float4 b = *(const float4*)(P.in[I_CDK] + e0 + 4);
      uint4 u; u.x = pk2(a.x, a.y); u.y = pk2(a.z, a.w); u.z = pk2(b.x, b.y); u.w = pk2(b.z, b.w);
      *(uint4*)((u16*)(P.ws + WS_KDLAT) + (size_t)jj * KDLAT_J + ((size_t)(bl * 1280 + 1024 + p)) * 1024 + col) = u;
      continue;
    }
    it -= N_CDK;
    if (it < N_CCKV) {
      const size_t e0 = ((size_t)it * 256 + tid) * 8;
      const int col = e0 & 255, p = (e0 >> 8) & 255, jj = (e0 >> 16) & 1, bl = (int)(e0 >> 17);
      const float4 a = *(const float4*)(P.in[I_CCKV] + e0);
      const float4 b = *(const float4*)(P.in[I_CCKV] + e0 + 4);
      uint4 u; u.x = pk2(a.x, a.y); u.y = pk2(a.z, a.w); u.z = pk2(b.x, b.y); u.w = pk2(b.z, b.w);
      *(uint4*)((u16*)(P.ws + WS_CKVA) + (size_t)jj * CKVA_J + ((size_t)(4096 + bl * 1280 + 1024 + p)) * 256 + col) = u;
      continue;
    }
    it -= N_CCKV;
    {
      const size_t e0 = ((size_t)it * 256 + tid) * 8;
      const int d = e0 & 63, p = (e0 >> 6) & 255, jj = (e0 >> 14) & 1, bl = (int)(e0 >> 15);
      const float4 a = *(const float4*)(P.in[I_CKPE] + e0);
      const float4 b = *(const float4*)(P.in[I_CKPE] + e0 + 4);
      uint4 u; u.x = pk2(a.x, a.y); u.y = pk2(a.z, a.w); u.z = pk2(b.x, b.y); u.w = pk2(b.z, b.w);
      u16* dst = (u16*)(P.ws + WS_KMLAT) + (size_t)jj * KMLAT_J + ((size_t)(bl * 8) * 1280 + 1024 + p) * 192 + 128 + d;
#pragma unroll
      for (int h = 0; h < 8; ++h) *(uint4*)(dst + (size_t)h * 1280 * 192) = u;
    }
  }
}

DEVI void mla_b_phase(const Params& P, int j, u16* smem) {
  constexpr int NQ = 32 * 12, NKV = 36 * 16, NNORM = 64;
  for (int it = blockIdx.x; it < NKV + NQ + NNORM; it += gridDim.x) {
    if (it < NKV) tile_kvb(P, j, it, smem);
    else if (it < NKV + NQ) tile_qb(P, j, it - NKV, smem);
    else {
      const int lane = tidx() & 63, w = tidx() >> 6;
      const float* ssq = (const float*)(P.ws + WS_SSQKV);
      const float4 gk = *(const float4*)(P.in[I_GKVA] + j * 256 + lane * 4);
      for (int r = w; r < 64; r += 4) {
        const int row = (it - NKV - NQ) * 64 + r;
        const float4 s4 = *(const float4*)(ssq + (size_t)row * 4);
        const float rr = rsqrtf((s4.x + s4.y + s4.z + s4.w) * (1.f / 256.f) + EPS);
        float* p = P.out + OUT_CKV + ((size_t)(((row >> 8) * 2 + j) * 256 + (row & 255))) * 256 + lane * 4;
        float4 v = *(const float4*)((const float*)(P.ws + WS_KVRAW) + (size_t)row * 256 + lane * 4);
        v.x *= rr * gk.x; v.y *= rr * gk.y; v.z *= rr * gk.z; v.w *= rr * gk.w;
        *(float4*)p = v;
      }
    }
  }
}


#define XB_TMO      128
#define XB_XCNT(j)  (256  + 64 * (j))
#define XB_XSUB(j)  (1280 + 64 * (j))
#define XB_XGEN(j)  (2304 + 64 * (j))
#define XB_TOP      3328
#define XB_TOPGEN   3392
#define XCD_BAR_WORDS 3456
#define XB_SPIN_CAP (1u << 22)
#define LAS __attribute__((address_space(3)))
DEVI unsigned xb_ld(unsigned* p) { return __hip_atomic_load(p, __ATOMIC_RELAXED, __HIP_MEMORY_SCOPE_AGENT); }
DEVI unsigned xb_add(unsigned* p, unsigned v) { return __hip_atomic_fetch_add(p, v, __ATOMIC_RELAXED, __HIP_MEMORY_SCOPE_AGENT); }
DEVI unsigned xb_xcc_id() { return (unsigned)__builtin_amdgcn_s_getreg((3 << 11) | 20) & 0xFu; }
#define XB_SPIN(cond, bar) do { unsigned _sp = 0; while (cond) { __builtin_amdgcn_s_sleep(1); \
    if ((++_sp & 255u) == 0u) { if (xb_ld(&(bar)[XB_TMO])) break; if (_sp > XB_SPIN_CAP) { atomicAdd(&(bar)[XB_TMO], 1u); break; } } } } while (0)
struct XcdBarrier { unsigned* bar; unsigned x; volatile LAS unsigned* st; };
DEVI XcdBarrier xcd_barrier_post(unsigned* bar, volatile LAS unsigned* st) {
  XcdBarrier b; b.bar = bar; b.x = xb_xcc_id(); b.st = st;
  if (threadIdx.x == 0) (void)xb_add(&bar[XB_XCNT(b.x)], 1u);
  return b;
}
DEVI void xcd_barrier_complete(unsigned* bar, unsigned x, unsigned& nloc, unsigned& nx) {
  const unsigned G = gridDim.x * gridDim.y * gridDim.z;
  unsigned sum, cnt, mine, sp = 0u;
  for (;;) {
    sum = 0u; cnt = 0u; mine = 0u;
#pragma unroll
    for (unsigned j = 0; j < 16; ++j) { const unsigned c = xb_ld(&bar[XB_XCNT(j)]); sum += c; cnt += (c > 0u) ? 1u : 0u; mine = (j == x) ? c : mine; }
    if (sum == G) break;
    __builtin_amdgcn_s_sleep(1);
    if ((++sp & 255u) == 0u) { if (xb_ld(&bar[XB_TMO])) break; if (sp > XB_SPIN_CAP) { atomicAdd(&bar[XB_TMO], 1u); break; } }
  }
  nloc = mine > 0u ? mine : 1u; nx = cnt > 0u ? cnt : 1u;
}
DEVI void xcd_barrier(const XcdBarrier& b) {
  asm volatile("s_waitcnt vmcnt(0)" ::: "memory");
  __syncthreads();
  if (threadIdx.x == 0) {
    unsigned* bar = b.bar;
    __builtin_amdgcn_s_waitcnt(0);
    unsigned nloc = b.st[0], nx = b.st[1];
    if (nloc == 0u) { xcd_barrier_complete(bar, b.x, nloc, nx); b.st[0] = nloc; b.st[1] = nx; }
    const unsigned old = xb_add(&bar[XB_XSUB(b.x)], 1u);
    const unsigned gen = old / nloc;
    if (old + 1u == (gen + 1u) * nloc) {
      __builtin_amdgcn_fence(__ATOMIC_RELEASE, "agent");
      asm volatile("s_waitcnt vmcnt(0)" ::: "memory");
      const unsigned og = xb_add(&bar[XB_TOP], 1u);
      const unsigned tg = og / nx;
      if (og + 1u == (tg + 1u) * nx) xb_add(&bar[XB_TOPGEN], 1u);
      else XB_SPIN(xb_ld(&bar[XB_TOPGEN]) == tg, bar);
      __builtin_amdgcn_fence(__ATOMIC_ACQUIRE, "agent");
      xb_add(&bar[XB_XGEN(b.x)], 1u);
      asm volatile("s_waitcnt vmcnt(0)" ::: "memory");
    } else {
      XB_SPIN(xb_ld(&bar[XB_XGEN(b.x)]) == gen, bar);
      __builtin_amdgcn_fence(__ATOMIC_ACQUIRE, "agent");
      asm volatile("s_waitcnt vmcnt(0)" ::: "memory");
    }
  }
  __syncthreads();
}
constexpr size_t WS_BAR = WS_MISC + 65536;

#ifndef EN
#define EN 0xFF
#endif
DEVI void run_phase(const Params& P, int ph, u16* smem) {
  if (ph == 0) { if (EN & 1) prep_phase(P, smem, 0, blockIdx.x, gridDim.x); return; }
  if (ph == 1) { if (EN & 2) ew_phase(P, -1); return; }
  int layer, sub;
  if (ph < 6) { layer = 0; sub = ph - 2; }
  else if (ph < 11) { layer = 1; sub = ph - 6; }
  else if (ph < 15) { layer = 2; sub = ph - 11; }
  else { layer = 3; sub = ph - 15; }
  const int j = layer >> 1;
  if ((layer & 1) == 0) {
    if (sub == 0) { if (EN & 4) for (int t = blockIdx.x; t < 32 * 32; t += gridDim.x) tile_diff_in(P, j, t, smem); }
    else if (sub == 1) { if (EN & 8) attn_diff_phase(P, j, smem); }
    else if (sub == 2) {
      if (EN & 16) for (int t = blockIdx.x; t < 32 * 8; t += gridDim.x) tile_out(P, layer, t, smem);
      const int pset = layer == 0 ? 1 : 3;
      if (gridDim.x >= 512) { if (blockIdx.x >= 256) prep_phase(P, smem, pset, blockIdx.x - 256, gridDim.x - 256); }
      else prep_phase(P, smem, pset, blockIdx.x, gridDim.x);
    }
    else { if (EN & 2) ew_phase(P, layer); }
  } else {
    if (sub == 0) { if (EN & 32) for (int t = blockIdx.x; t < 32 * 14; t += gridDim.x) tile_mla_in(P, j, t, smem); }
    else if (sub == 1) { if (EN & 64) mla_b_phase(P, j, smem); }
    else if (sub == 2) { if (EN & 128) attn_mla_phase(P, j, smem); }
    else if (sub == 3) {
      if (EN & 16) for (int t = blockIdx.x; t < 32 * 8; t += gridDim.x) tile_out(P, layer, t, smem);
      if (layer == 1) {
        if (gridDim.x >= 512) { if (blockIdx.x >= 256) prep_phase(P, smem, 2, blockIdx.x - 256, gridDim.x - 256); }
        else prep_phase(P, smem, 2, blockIdx.x, gridDim.x);
      }
    }
    else { if (EN & 2) ew_phase(P, layer); }
  }
}

constexpr int N_PHASES = 20;

__global__ void __launch_bounds__(256, 2) fwd_megakernel(Params P) {
  __shared__ __attribute__((aligned(16))) u16 smem[SMEM_BYTES / 2];
  __shared__ uint4 xb_words;
  if (threadIdx.x == 0) xb_words = make_uint4(0u, 0u, 0u, 0u);
  __syncthreads();
  XcdBarrier xb = xcd_barrier_post((unsigned*)(P.ws + WS_BAR), (volatile LAS unsigned*)&xb_words);
  for (int ph = P.ph_lo; ph < P.ph_hi; ++ph) {
    Params Pl = P;
    {
      size_t zoff = 0;
      asm volatile("" : "+s"(zoff));
      Pl.ws = P.ws + zoff;
      Pl.out = P.out + zoff;
    }
    run_phase(Pl, ph, smem);
#ifdef REP_MASK
    {
      int kind;
      if (ph == 0) kind = 1; else if (ph == 1) kind = 2;
      else { int layer, sub; if (ph < 6) { layer = 0; sub = ph - 2; } else if (ph < 11) { layer = 1; sub = ph - 6; } else if (ph < 15) { layer = 2; sub = ph - 11; } else { layer = 3; sub = ph - 15; }
        if ((layer & 1) == 0) kind = sub == 0 ? 4 : sub == 1 ? 8 : sub == 2 ? 16 : 2;
        else kind = sub == 0 ? 32 : sub == 1 ? 64 : sub == 2 ? 128 : sub == 3 ? 16 : 2; }
      if (kind & REP_MASK) { xcd_barrier(xb); run_phase(Pl, ph, smem); }
    }
#endif
    if (ph + 1 < P.ph_hi) {
      if (P.ph_hi > 1000) cg::this_grid().sync();
      xcd_barrier(xb);
    }
#ifdef EXTRA_SYNCS
    for (int q = 0; q < EXTRA_SYNCS; ++q) xcd_barrier(xb);
#endif
  }
}

extern "C" void kernel_launch(void* const* d_in, const int* in_sizes, int n_in, void* d_out, int out_size, void* d_ws,
                              size_t ws_size, hipStream_t stream) {
  static int grid_blocks = 0;
  if (!grid_blocks) {
    int dev = 0, cus = 0, per_cu = 0;
    (void)hipGetDevice(&dev);
    (void)hipDeviceGetAttribute(&cus, hipDeviceAttributeMultiprocessorCount, dev);
    (void)hipOccupancyMaxActiveBlocksPerMultiprocessor(&per_cu, fwd_megakernel, 256, 0);
    if (per_cu < 1) per_cu = 1;
    if (per_cu > 2) per_cu = 2;
    grid_blocks = cus * per_cu;
  }
  if (hipMemsetAsync((unsigned char*)d_ws + WS_BAR, 0, 16384, stream) != hipSuccess) { fprintf(stderr, "memset failed\n"); return; }
  Params p{};
  for (int i = 0; i < 24; ++i) p.in[i] = (const float*)d_in[i];
  p.out = (float*)d_out;
  p.ws = (unsigned char*)d_ws;
#if MULTI_LAUNCH
  for (int ph = 0; ph < N_PHASES; ++ph) {
    p.ph_lo = ph; p.ph_hi = ph + 1;
    hipLaunchKernelGGL(fwd_megakernel, dim3(grid_blocks), dim3(256), 0, stream, p);
  }
#else
  p.ph_lo = 0; p.ph_hi = N_PHASES;
  void* args[] = {&p};
  hipError_t e = hipLaunchCooperativeKernel((void*)fwd_megakernel, dim3(grid_blocks), dim3(256), args, 0, stream);
  if (e != hipSuccess) fprintf(stderr, "cooperative launch failed: %s (grid %d)\n", hipGetErrorString(e), grid_blocks);
#endif
}
```

```cpp
#include <hip/hip_runtime.h>
#include <hip/hip_cooperative_groups.h>
#include <cstdio>
namespace cg = cooperative_groups;

#ifndef MULTI_LAUNCH
#define MULTI_LAUNCH 0
#endif

typedef unsigned short u16;
typedef __attribute__((ext_vector_type(8))) short bf16x8;
typedef __attribute__((ext_vector_type(4))) float f32x4;
typedef __attribute__((ext_vector_type(4))) unsigned u32x4;
typedef __attribute__((ext_vector_type(2))) unsigned u32x2;

#define DEVI __device__ __forceinline__

struct Params {
  const float* in[24];
  float* out;
  unsigned char* ws;
  int ph_lo, ph_hi;
};

constexpr size_t MBy = 1u << 20;
constexpr size_t WS_WOUT = 0;
constexpr size_t WS_WDAIN = 8 * MBy;
constexpr size_t WS_WMLAIN = 24 * MBy;
constexpr size_t WS_WQB = 31 * MBy;
constexpr size_t WS_WKVB = 34 * MBy;
constexpr size_t WS_WKVBG = 36 * MBy;
constexpr size_t WS_ADA = 38 * MBy;
constexpr size_t WS_ROPE = 39 * MBy;
constexpr size_t WS_MISC = 40 * MBy;
constexpr size_t WS_H = 41 * MBy;
constexpr size_t WS_O = WS_H;
constexpr size_t WS_Q = 57 * MBy;
constexpr size_t WS_T = WS_Q;
constexpr size_t WS_CTXK = 81 * MBy;
constexpr size_t WS_KDLAT = 93 * MBy;
constexpr size_t WS_VTCTX = 113 * MBy;
constexpr size_t WS_VTLATD = 121 * MBy;
constexpr size_t WS_VTLATM = 141 * MBy;
constexpr size_t WS_G = 151 * MBy;
constexpr size_t WS_QA = 167 * MBy;
constexpr size_t WS_CKVA = 173 * MBy;
constexpr size_t WS_SSQQ = 183 * MBy;
constexpr size_t WS_SSQKV = 184 * MBy;
constexpr size_t WS_KMLAT = 185 * MBy;
constexpr size_t WS_KVRAW = 215 * MBy;
constexpr size_t WS_BAR = WS_MISC + 65536;
constexpr size_t WS_ADAP = 219 * MBy;
constexpr size_t KDLAT_J = (size_t)4 * 1280 * 1024;
constexpr size_t VTLATD_J = (size_t)4 * 8 * 128 * 1280;
constexpr size_t CKVA_J = (size_t)9216 * 256;
constexpr size_t KMLAT_J = (size_t)4 * 8 * 1280 * 192;

constexpr size_t OUT_Y = 0;
constexpr size_t OUT_SK = 8388608;
constexpr size_t OUT_SV = 16777216;
constexpr size_t OUT_CKV = 25165824;
constexpr size_t OUT_KPE = 27262976;

constexpr float EPS = 1e-6f;
constexpr float LOG2E = 1.4426950408889634f;

enum { I_XP = 0, I_XS, I_CDK, I_CDV, I_CCKV, I_CKPE, I_C, I_CCTX, I_WADA, I_BADA, I_GPRE, I_GPOST, I_WOUT,
       I_DAWIN, I_LQ1, I_LK1, I_LQ2, I_LK2, I_GSUB, I_MWIN, I_GQA, I_WQB, I_GKVA, I_WKVB };

DEVI int tidx() { int t = threadIdx.x; asm volatile("" : "+v"(t)); return t; }
DEVI u16 f2bf(float f) {
  unsigned u = __float_as_uint(f);
  u += 0x7fffu + ((u >> 16) & 1u);
  return (u16)(u >> 16);
}
typedef __attribute__((ext_vector_type(2))) float f32x2_t;
typedef __attribute__((ext_vector_type(2))) __bf16 bf16x2_t;
DEVI unsigned pk2(float a, float b) {
  f32x2_t v = {a, b};
  bf16x2_t r = __builtin_convertvector(v, bf16x2_t);
  return __builtin_bit_cast(unsigned, r);
}
DEVI float bf2f(unsigned v) { return __uint_as_float(v << 16); }
DEVI void st_bf4(u16* p, f32x4 v) {
  uint2 u; u.x = pk2(v[0], v[1]); u.y = pk2(v[2], v[3]);
  *(uint2*)p = u;
}
DEVI void st_pair(u16* p, int g, f32x4 a, f32x4 b) {
  const bool odd = g & 1;
  f32x4 send, recv;
#pragma unroll
  for (int i = 0; i < 4; ++i) send[i] = odd ? a[i] : b[i];
#pragma unroll
  for (int i = 0; i < 4; ++i) recv[i] = __shfl_xor(send[i], 16, 64);
  f32x4 lo, hi;
#pragma unroll
  for (int i = 0; i < 4; ++i) { lo[i] = odd ? recv[i] : a[i]; hi[i] = odd ? b[i] : recv[i]; }
  u32x4 u;
  u[0] = pk2(lo[0], lo[1]); u[1] = pk2(lo[2], lo[3]); u[2] = pk2(hi[0], hi[1]); u[3] = pk2(hi[2], hi[3]);
  *(u32x4*)(p + (odd ? 16 : 0) + (g >> 1) * 8) = u;
}
DEVI void st_f4(float* p, f32x4 v) { *(float4*)p = make_float4(v[0], v[1], v[2], v[3]); }
DEVI f32x4 mfma16(bf16x8 a, bf16x8 b, f32x4 c) { return __builtin_amdgcn_mfma_f32_16x16x32_bf16(a, b, c, 0, 0, 0); }
DEVI float silu(float x) { return x * __builtin_amdgcn_rcpf(1.f + __builtin_amdgcn_exp2f(-1.4426950408889634f * x)); }
DEVI float xshfl(float v, int m) { return __shfl_xor(v, m, 64); }

DEVI void rope4(f32x4& x1, f32x4& x2, const float* cs, const float* sn) {
  float4 c = *(const float4*)cs; float4 s = *(const float4*)sn;
  f32x4 a = x1, b = x2;
  x1[0] = a[0] * c.x - b[0] * s.x; x2[0] = a[0] * s.x + b[0] * c.x;
  x1[1] = a[1] * c.y - b[1] * s.y; x2[1] = a[1] * s.y + b[1] * c.y;
  x1[2] = a[2] * c.z - b[2] * s.z; x2[2] = a[2] * s.z + b[2] * c.z;
  x1[3] = a[3] * c.w - b[3] * s.w; x2[3] = a[3] * s.w + b[3] * c.w;
}

constexpr int LDT = 64;
constexpr int TILE_ELEMS = 128 * LDT;
constexpr int SMEM_BYTES = 2 * (64 * 144 + 128 * 72) * 2;

template <bool SWAP>
DEVI void gemm_core(const u16* __restrict__ A, int lda, const u16* __restrict__ B, int ldb, int K,
                    int m0, int n0, u16* smem, f32x4 (&acc)[8][4]) {
  const int tid = tidx(), lane = tid & 63, w = tid >> 6;
  const int wm = w >> 1, wn = w & 1;
  const int g = lane >> 4, li = lane & 15;
  u16* As = smem;
  u16* Bs = smem + 256 * 64;
  const int lr = tid >> 3, lc = (tid & 7) * 8;
  const u16* ap = A + (size_t)(m0 + lr) * lda + lc;
  const u16* bp = B + (size_t)(n0 + lr) * ldb + lc;
  const int wsw = (((tid & 7) ^ (lr & 7)) * 8);
  u16* sa = As + lr * 64 + wsw;
  u16* sb = Bs + lr * 64 + wsw;
  const int rs0 = ((g ^ (li & 7)) * 8), rs1 = (((4 + g) ^ (li & 7)) * 8);
  const u16* Ard = As + (wm * 128 + li) * 64;
  const u16* Brd = Bs + (wn * 64 + li) * 64;
  u32x4 ra[8], rb[4];
#define GLOAD(KT_) { const int k0_ = (KT_) << 6; \
    _Pragma("unroll") for (int i = 0; i < 8; ++i) ra[i] = *(const u32x4*)(ap + (size_t)i * 32 * lda + k0_); \
    _Pragma("unroll") for (int i = 0; i < 4; ++i) rb[i] = *(const u32x4*)(bp + (size_t)i * 32 * ldb + k0_); }
#define SSTORE() { _Pragma("unroll") for (int i = 0; i < 8; ++i) *(u32x4*)(sa + 32 * i * 64) = ra[i]; \
    _Pragma("unroll") for (int i = 0; i < 4; ++i) *(u32x4*)(sb + 32 * i * 64) = rb[i]; }
#define FRAGS(RS) { _Pragma("unroll") for (int t = 0; t < 8; ++t) fa[t] = *(const bf16x8*)(Ard + t * 16 * 64 + (RS)); \
    _Pragma("unroll") for (int t = 0; t < 4; ++t) fb[t] = *(const bf16x8*)(Brd + t * 16 * 64 + (RS)); }
#define MMA() _Pragma("unroll") for (int mt = 0; mt < 8; ++mt) _Pragma("unroll") for (int nt = 0; nt < 4; ++nt) \
      acc[mt][nt] = SWAP ? mfma16(fb[nt], fa[mt], acc[mt][nt]) : mfma16(fa[mt], fb[nt], acc[mt][nt]);
  const int KT = K >> 6;
  bf16x8 fa[8], fb[4];
  GLOAD(0);
  for (int kt = 0; kt < KT; ++kt) {
    __syncthreads();
    SSTORE();
    __syncthreads();
    GLOAD((kt + 1 < KT ? kt + 1 : KT - 1));
    FRAGS(rs0);
    __builtin_amdgcn_sched_barrier(0);
    MMA();
    __builtin_amdgcn_sched_barrier(0);
    FRAGS(rs1);
    __builtin_amdgcn_sched_barrier(0);
    MMA();
  }
#undef GLOAD
#undef SSTORE
#undef FRAGS
#undef MMA
}

DEVI void zero_acc(f32x4 (&acc)[8][4]) {
#pragma unroll
  for (int i = 0; i < 8; ++i)
#pragma unroll
    for (int k = 0; k < 4; ++k) acc[i][k] = (f32x4){0.f, 0.f, 0.f, 0.f};
}


DEVI int xcd_remap(int l, int total) {
  int q = l >> 3;
  if ((q | 63) < (total >> 3))
    q = (q & ~63) | ((q & 31) << 1) | ((q >> 5) & 1);
  return (l & 7) * (total >> 3) + q;
}
DEVI void patch_tile(int v, int NT, int PN, int& mt, int& nt) {
  const int psz = 4 * PN, p = v / psz, i = v - p * psz, npn = NT / PN;
  const int pm = p / npn, pn = p - pm * npn;
  const int im = i / PN, in = i - im * PN;
  mt = pm * 4 + im;
  nt = pn * PN + in;
}

DEVI void tile_diff_in(const Params& P, int j, int tile, u16* smem) {
  int tm_, tn_; patch_tile(xcd_remap(tile, 1024), 32, 8, tm_, tn_);
  const int m0 = tm_ * 256, n0 = tn_ * 128;
  const int region = n0 >> 10;
  const u16* A = (const u16*)(P.ws + WS_H);
  const u16* B = (const u16*)(P.ws + WS_WDAIN) + (size_t)j * 4096 * 1024;
  f32x4 acc[8][4];
  zero_acc(acc);
  if (region == 2) gemm_core<false>(A, 1024, B, 1024, 1024, m0, n0, smem, acc);
  else gemm_core<true>(A, 1024, B, 1024, 1024, m0, n0, smem, acc);

  const int lane = tidx() & 63, w = tidx() >> 6, wm = w >> 1, wn = w & 1, g = lane >> 4, li = lane & 15;
  const int mb = m0 + wm * 128, nb = n0 + wn * 64;
  const bool isLat = mb >= 4096;
  const int b = mb >> 8, sb = mb & 255, bl = (mb - 4096) >> 10, tb = (mb - 4096) & 1023;
  const float* ropeC = (const float*)(P.ws + WS_ROPE);
  const float* ropeS = ropeC + 1024 * 32;
  if (region == 2) {
    const int cbase = nb - 2048;
    u16* vtc = (u16*)(P.ws + WS_VTCTX);
    u16* vtl = (u16*)(P.ws + WS_VTLATD) + (size_t)j * VTLATD_J;
#pragma unroll
    for (int mt = 0; mt < 8; ++mt) {
      const int r0 = mt * 16 + g * 4;
#pragma unroll
      for (int nt = 0; nt < 4; ++nt) {
        const int col = cbase + nt * 16 + li, h = col >> 7, e = col & 127;
        if (!isLat) {
          const int s = sb + r0;
          float* sv = P.out + OUT_SV + ((size_t)((b * 2 + j) * 256 + s)) * 1024 + col;
#pragma unroll
          for (int jj = 0; jj < 4; ++jj) sv[(size_t)jj * 1024] = acc[mt][nt][jj];
          st_bf4(vtc + ((size_t)((b * 8 + h) * 128 + e)) * 256 + s, acc[mt][nt]);
        } else {
          const int t = tb + r0;
          st_bf4(vtl + ((size_t)((bl * 8 + h) * 128 + e)) * 1280 + t, acc[mt][nt]);
        }
      }
    }
  } else {
    const float qs = 0.125f * LOG2E;
#pragma unroll
    for (int mt = 0; mt < 8; ++mt) {
      const int rl = mt * 16 + li, row = mb + rl;
      if (region <= 1 && isLat) {
        const int t = tb + rl;
#pragma unroll
        for (int nt = 0; nt < 2; ++nt)
          rope4(acc[mt][nt], acc[mt][nt + 2], ropeC + t * 32 + nt * 16 + g * 4, ropeS + t * 32 + nt * 16 + g * 4);
      }
      if (region == 1 && !isLat) {
#pragma unroll
        for (int nt = 0; nt < 4; ++nt)
          st_f4(P.out + OUT_SK + ((size_t)((b * 2 + j) * 256 + sb + rl)) * 1024 + (nb - 1024) + nt * 16 + g * 4, acc[mt][nt]);
      }
      u16* dst;
      if (region == 0) dst = (u16*)(P.ws + WS_Q) + (size_t)row * 1024 + nb;
      else if (region == 1) dst = isLat ? (u16*)(P.ws + WS_KDLAT) + (size_t)j * KDLAT_J + ((size_t)(bl * 1280 + tb + rl)) * 1024 + (nb - 1024)
                                        : (u16*)(P.ws + WS_CTXK) + (size_t)row * 1024 + (nb - 1024);
      else dst = (u16*)(P.ws + WS_G) + (size_t)row * 1024 + (nb - 3072);
#pragma unroll
      for (int np = 0; np < 2; ++np) {
        f32x4 va = acc[mt][2 * np], vb = acc[mt][2 * np + 1];
        if (region == 0) { va *= qs; vb *= qs; }
        else if (region == 3) {
#pragma unroll
          for (int jj = 0; jj < 4; ++jj) { va[jj] = silu(va[jj]); vb[jj] = silu(vb[jj]); }
        }
        st_pair(dst + np * 32, g, va, vb);
      }
    }
  }
}

DEVI void tile_mla_in(const Params& P, int j, int tile, u16* smem) {
  int tm_, tn_; patch_tile(xcd_remap(tile, 448), 14, 7, tm_, tn_);
  const int m0 = tm_ * 256, n0 = tn_ * 128;
  const u16* A = (const u16*)(P.ws + WS_H);
  const u16* B = (const u16*)(P.ws + WS_WMLAIN) + (size_t)j * 1792 * 1024;
  f32x4 acc[8][4];
  zero_acc(acc);
  gemm_core<true>(A, 1024, B, 1024, 1024, m0, n0, smem, acc);

  const int lane = tidx() & 63, w = tidx() >> 6, wm = w >> 1, wn = w & 1, g = lane >> 4, li = lane & 15;
  const int mb = m0 + wm * 128, nb = n0 + wn * 64;
  const bool isLat = mb >= 4096;
  const int b = mb >> 8, sb = mb & 255, bl = (mb - 4096) >> 10, tb = (mb - 4096) & 1023;
  const float* ropeC = (const float*)(P.ws + WS_ROPE);
  const float* ropeS = ropeC + 1024 * 32;
  if (nb >= 1728) return;
#pragma unroll
  for (int mt = 0; mt < 8; ++mt) {
    const int rl = mt * 16 + li, row = mb + rl;
    if (nb < 640) {
      float ss = 0.f;
#pragma unroll
      for (int nt = 0; nt < 4; ++nt)
#pragma unroll
        for (int jj = 0; jj < 4; ++jj) ss += acc[mt][nt][jj] * acc[mt][nt][jj];
      ss += xshfl(ss, 16);
      ss += xshfl(ss, 32);
      if (nb < 384) {
        if (g == 0) ((float*)(P.ws + WS_SSQQ))[row * 8 + (nb >> 6)] = ss;
#pragma unroll
        for (int np = 0; np < 2; ++np)
          st_pair((u16*)(P.ws + WS_QA) + (size_t)row * 384 + nb + np * 32, g, acc[mt][2 * np], acc[mt][2 * np + 1]);
      } else {
        if (g == 0) ((float*)(P.ws + WS_SSQKV))[row * 4 + ((nb - 384) >> 6)] = ss;
        const int arow = isLat ? (4096 + bl * 1280 + tb + rl) : row;
#pragma unroll
        for (int nt = 0; nt < 4; ++nt) {
          const int c2 = nb - 384 + nt * 16 + g * 4;
          if (!isLat) st_f4((float*)(P.ws + WS_KVRAW) + (size_t)row * 256 + c2, acc[mt][nt]);
        }
#pragma unroll
        for (int np = 0; np < 2; ++np)
          st_pair((u16*)(P.ws + WS_CKVA) + (size_t)j * CKVA_J + (size_t)arow * 256 + (nb - 384) + np * 32, g, acc[mt][2 * np], acc[mt][2 * np + 1]);
      }
    } else if (nb == 640) {
      if (isLat) {
        const int t = tb + rl;
#pragma unroll
        for (int nt = 0; nt < 2; ++nt)
          rope4(acc[mt][nt], acc[mt][nt + 2], ropeC + t * 32 + nt * 16 + g * 4, ropeS + t * 32 + nt * 16 + g * 4);
      }
#pragma unroll
      for (int nt = 0; nt < 4; ++nt) {
        const int d = nt * 16 + g * 4;
        if (!isLat) {
          st_f4(P.out + OUT_KPE + ((size_t)((b * 2 + j) * 256 + sb + rl)) * 64 + d, acc[mt][nt]);
          u16* kd = (u16*)(P.ws + WS_CTXK) + ((size_t)(b * 8) * 256 + sb + rl) * 192 + 128 + d;
#pragma unroll
          for (int h = 0; h < 8; ++h) st_bf4(kd + (size_t)h * 256 * 192, acc[mt][nt]);
        } else {
          u16* kd = (u16*)(P.ws + WS_KMLAT) + (size_t)j * KMLAT_J + ((size_t)(bl * 8) * 1280 + tb + rl) * 192 + 128 + d;
#pragma unroll
          for (int h = 0; h < 8; ++h) st_bf4(kd + (size_t)h * 1280 * 192, acc[mt][nt]);
        }
      }
    } else {
#pragma unroll
      for (int np = 0; np < 2; ++np) {
        f32x4 va = acc[mt][2 * np], vb = acc[mt][2 * np + 1];
#pragma unroll
        for (int jj = 0; jj < 4; ++jj) { va[jj] = silu(va[jj]); vb[jj] = silu(vb[jj]); }
        st_pair((u16*)(P.ws + WS_G) + (size_t)row * 1024 + (nb - 704) + np * 32, g, va, vb);
      }
    }
  }
}

DEVI void tile_qb(const Params& P, int j, int tile, u16* smem) {
  int tm_, tn_; patch_tile(xcd_remap(tile, 384), 12, 6, tm_, tn_);
  const int m0 = tm_ * 256, n0 = tn_ * 128;
  const u16* A = (const u16*)(P.ws + WS_QA);
  const u16* B = (const u16*)(P.ws + WS_WQB) + (size_t)j * 1536 * 384;
  f32x4 acc[8][4];
  zero_acc(acc);
  gemm_core<true>(A, 384, B, 384, 384, m0, n0, smem, acc);
  const int lane = tidx() & 63, w = tidx() >> 6, wm = w >> 1, wn = w & 1, g = lane >> 4, li = lane & 15;
  const int mb = m0 + wm * 128, nb = n0 + wn * 64;
  const bool isLat = mb >= 4096;
  const int tb = (mb - 4096) & 1023;
  const float* ropeC = (const float*)(P.ws + WS_ROPE);
  const float* ropeS = ropeC + 1024 * 32;
  const float* ssq = (const float*)(P.ws + WS_SSQQ);
  const bool isRope = (nb % 192) == 128;
  const float qs = 0.07216878364870322f * LOG2E;
#pragma unroll
  for (int mt = 0; mt < 8; ++mt) {
    const int rl = mt * 16 + li, row = mb + rl;
    float ss = 0.f;
#pragma unroll
    for (int i = 0; i < 6; ++i) ss += ssq[row * 8 + i];
    const float r = rsqrtf(ss * (1.f / 384.f) + EPS) * qs;
    if (isRope && isLat) {
      const int t = tb + rl;
#pragma unroll
      for (int nt = 0; nt < 2; ++nt)
        rope4(acc[mt][nt], acc[mt][nt + 2], ropeC + t * 32 + nt * 16 + g * 4, ropeS + t * 32 + nt * 16 + g * 4);
    }
#pragma unroll
    for (int np = 0; np < 2; ++np)
      st_pair((u16*)(P.ws + WS_Q) + (size_t)row * 1536 + nb + np * 32, g, acc[mt][2 * np] * r, acc[mt][2 * np + 1] * r);
  }
}

DEVI void tile_kvb(const Params& P, int j, int tile, u16* smem) {
  int tm_, tn_; patch_tile(xcd_remap(tile, 576), 16, 8, tm_, tn_);
  const int m0 = tm_ * 256, n0 = tn_ * 128;
  const bool tileLat = m0 >= 4096;
  const bool fresh = !tileLat || ((m0 - 4096) % 1280) < 1024;
  const u16* A = (const u16*)(P.ws + WS_CKVA) + (size_t)j * CKVA_J;
  const u16* B = (const u16*)(P.ws + (fresh ? WS_WKVBG : WS_WKVB)) + (size_t)j * 2048 * 256;
  const bool isV = (n0 >> 7) & 1;
  const int h = n0 >> 8;
  f32x4 acc[8][4];
  zero_acc(acc);
  if (isV) gemm_core<false>(A, 256, B, 256, 256, m0, n0, smem, acc);
  else gemm_core<true>(A, 256, B, 256, 256, m0, n0, smem, acc);
  const int lane = tidx() & 63, w = tidx() >> 6, wm = w >> 1, wn = w & 1, g = lane >> 4, li = lane & 15;
  const int mb = m0 + wm * 128;
  int b, keyb, Sk, tokb;
  u16 *Kd, *Vd;
  if (!tileLat) {
    b = mb >> 8; keyb = mb & 255; Sk = 256; tokb = mb;
    Kd = (u16*)(P.ws + WS_CTXK); Vd = (u16*)(P.ws + WS_VTCTX);
  } else {
    const int r2 = mb - 4096;
    b = r2 / 1280; keyb = r2 % 1280; Sk = 1280; tokb = 4096 + b * 1024 + keyb;
    Kd = (u16*)(P.ws + WS_KMLAT) + (size_t)j * KMLAT_J; Vd = (u16*)(P.ws + WS_VTLATM);
  }
  const float* ssq = (const float*)(P.ws + WS_SSQKV);
  if (!isV) {
#pragma unroll
    for (int mt = 0; mt < 8; ++mt) {
      const int rl = mt * 16 + li;
      float r = 1.f;
      if (fresh) {
        const float4 s4 = *(const float4*)(ssq + (size_t)(tokb + rl) * 4);
        r = rsqrtf((s4.x + s4.y + s4.z + s4.w) * (1.f / 256.f) + EPS);
      }
#pragma unroll
      for (int np = 0; np < 2; ++np)
        st_pair(Kd + ((size_t)((b * 8 + h) * Sk + keyb + rl)) * 192 + wn * 64 + np * 32, g, acc[mt][2 * np] * r, acc[mt][2 * np + 1] * r);
    }
  } else {
#pragma unroll
    for (int mt = 0; mt < 8; ++mt) {
      const int r0 = mt * 16 + g * 4;
      f32x4 rr = {1.f, 1.f, 1.f, 1.f};
      if (fresh) {
#pragma unroll
        for (int jj = 0; jj < 4; ++jj) {
          const float4 s4 = *(const float4*)(ssq + (size_t)(tokb + r0 + jj) * 4);
          rr[jj] = rsqrtf((s4.x + s4.y + s4.z + s4.w) * (1.f / 256.f) + EPS);
        }
      }
#pragma unroll
      for (int nt = 0; nt < 4; ++nt) {
        const int e = wn * 64 + nt * 16 + li;
        st_bf4(Vd + ((size_t)((b * 8 + h) * 128 + e)) * Sk + keyb + r0, acc[mt][nt] * rr);
      }
    }
  }
}

DEVI void tile_out(const Params& P, int layer, int tile, u16* smem) {
  int tm_, tn_; patch_tile(xcd_remap(tile, 256), 8, 8, tm_, tn_);
  const int m0 = tm_ * 256, n0 = tn_ * 128;
  const u16* A = (const u16*)(P.ws + WS_O);
  const u16* B = (const u16*)(P.ws + WS_WOUT) + (size_t)layer * 1024 * 1024;
  f32x4 acc[8][4];
  zero_acc(acc);
  gemm_core<true>(A, 1024, B, 1024, 1024, m0, n0, smem, acc);
  const int lane = tidx() & 63, w = tidx() >> 6, wm = w >> 1, wn = w & 1, g = lane >> 4, li = lane & 15;
  const int mb = m0 + wm * 128, nb = n0 + wn * 64;
  u16* T = (u16*)(P.ws + WS_T);
#pragma unroll
  for (int mt = 0; mt < 8; ++mt)
#pragma unroll
    for (int np = 0; np < 2; ++np)
      st_pair(T + (size_t)(mb + mt * 16 + li) * 1024 + nb + np * 32, g, acc[mt][2 * np], acc[mt][2 * np + 1]);
}

template <bool DIFF>
DEVI void attn_item(const Params& P, const u16* __restrict__ Qb, int ldq, int qrow0,
                    const u16* __restrict__ Kb, int ldk, const u16* __restrict__ Vt, int Sk,
                    int h, float lam, float lam_init, const float* gsub, u16* smem) {
  constexpr int KW = DIFF ? 128 : 192;
  constexpr int KLD = KW + 16;
  constexpr int NKK = DIFF ? 2 : 6;
  constexpr int KT = DIFF ? 64 : 32;
  constexpr int NS = KT / 16;
  constexpr int NU = KT / 32;
  constexpr int KCH = KW / 8;
  constexpr int NKL = (KT * KCH) / 256;
  constexpr int VCH = KT / 8;
  constexpr int NVL = (128 * VCH) / 256;
  constexpr int VLD = KT + 8;
  constexpr int STAGE = KT * KLD + 128 * VLD;
  const int tid = tidx(), lane = tid & 63, w = tid >> 6, g = lane >> 4, li = lane & 15;

  bf16x8 qf[2][NKK];
#pragma unroll
  for (int s = 0; s < 2; ++s) {
    const int qrow = DIFF ? (qrow0 + w * 16 + li) : (qrow0 + w * 32 + s * 16 + li);
    const int qcol = DIFF ? (h * 128 + s * 64) : (h * 192);
#pragma unroll
    for (int kk = 0; kk < NKK; ++kk)
      qf[s][kk] = *(const bf16x8*)(Qb + (size_t)qrow * ldq + qcol + kk * 32 + g * 8);
  }
  f32x4 oacc[2][8];
#pragma unroll
  for (int s = 0; s < 2; ++s)
#pragma unroll
    for (int et = 0; et < 8; ++et) oacc[s][et] = (f32x4){0.f, 0.f, 0.f, 0.f};
  float mrow[2] = {-1e30f, -1e30f}, lrow[2] = {0.f, 0.f};

  u32x4 rk[NKL], rv[NVL];
  auto gload = [&](int key0) {
#pragma unroll
    for (int i = 0; i < NKL; ++i) {
      const int c = tid + 256 * i, r = c / KCH, cc = c % KCH;
      rk[i] = *(const u32x4*)(Kb + (size_t)(key0 + r) * ldk + cc * 8);
    }
#pragma unroll
    for (int i = 0; i < NVL; ++i) {
      const int c = tid + 256 * i, r = c / VCH, cc = c % VCH;
      rv[i] = *(const u32x4*)(Vt + (size_t)r * Sk + key0 + cc * 8);
    }
  };
  auto sstore = [&](int buf) {
    u16* Kw = smem + buf * STAGE;
    u16* Vw = Kw + KT * KLD;
#pragma unroll
    for (int i = 0; i < NKL; ++i) {
      const int c = tid + 256 * i, r = c / KCH, cc = c % KCH;
      *(u32x4*)(Kw + r * KLD + cc * 8) = rk[i];
    }
#pragma unroll
    for (int i = 0; i < NVL; ++i) {
      const int c = tid + 256 * i, r = c / VCH, cc = c % VCH;
      *(u32x4*)(Vw + r * VLD + cc * 8) = rv[i];
    }
  };
  const int NT = Sk / KT;
  gload(0);
  __syncthreads();
  sstore(0);
  gload(NT > 1 ? KT : 0);
  __syncthreads();
  for (int kt0 = 0; kt0 < NT; ++kt0) {
    const u16* Ks = smem + (kt0 & 1) * STAGE;
    const u16* Vs = Ks + KT * KLD;
    if (kt0 + 1 < NT) {
      sstore((kt0 + 1) & 1);
      gload((kt0 + 2 < NT ? kt0 + 2 : NT - 1) * KT);
    }

    f32x4 st[2][NS];
#pragma unroll
    for (int s = 0; s < 2; ++s)
#pragma unroll
      for (int kt = 0; kt < NS; ++kt) st[s][kt] = (f32x4){0.f, 0.f, 0.f, 0.f};
    {
      constexpr int NF = DIFF ? NKK * NS * 2 : NKK * NS;
      auto kaddr = [&](int f) -> const u16* {
        if (DIFF) { const int s2 = f & 1, kt = (f >> 1) % NS, kk = (f >> 1) / NS; return Ks + (kt * 16 + li) * KLD + s2 * 64 + kk * 32 + g * 8; }
        else { const int kt = f % NS, kk = f / NS; return Ks + (kt * 16 + li) * KLD + kk * 32 + g * 8; }
      };
      bf16x8 kf[3];
      kf[0] = *(const bf16x8*)kaddr(0);
      kf[1] = *(const bf16x8*)kaddr(1);
#pragma unroll
      for (int f = 0; f < NF; ++f) {
        if (f + 2 < NF) kf[(f + 2) % 3] = *(const bf16x8*)kaddr(f + 2);
        __builtin_amdgcn_sched_barrier(0);
        if (DIFF) {
          const int s2 = f & 1, kt = (f >> 1) % NS, kk = (f >> 1) / NS;
          st[s2][kt] = mfma16(kf[f % 3], qf[s2][kk], st[s2][kt]);
        } else {
          const int kt = f % NS, kk = f / NS;
          st[0][kt] = mfma16(kf[f % 3], qf[0][kk], st[0][kt]);
          st[1][kt] = mfma16(kf[f % 3], qf[1][kk], st[1][kt]);
        }
        __builtin_amdgcn_sched_barrier(0);
      }
    }
    bf16x8 pf[2][NU];
#pragma unroll
    for (int s = 0; s < 2; ++s) {
      float mx = st[s][0][0];
#pragma unroll
      for (int kt = 0; kt < NS; ++kt)
#pragma unroll
        for (int jj = 0; jj < 4; ++jj) mx = fmaxf(mx, st[s][kt][jj]);
      mx = fmaxf(mx, xshfl(mx, 16));
      mx = fmaxf(mx, xshfl(mx, 32));
      const bool need = mx > mrow[s] + 8.f;
      float mnew = mrow[s];
      if (__builtin_amdgcn_ballot_w64(need) != 0ull) {
        mnew = need ? mx : mrow[s];
        const float alpha = __builtin_amdgcn_exp2f(mrow[s] - mnew);
        mrow[s] = mnew;
        lrow[s] *= alpha;
#pragma unroll
        for (int et = 0; et < 8; ++et) oacc[s][et] *= alpha;
      }
      float ps = 0.f;
#pragma unroll
      for (int kt = 0; kt < NS; ++kt)
#pragma unroll
        for (int jj = 0; jj < 4; ++jj) {
          const float p = __builtin_amdgcn_exp2f(st[s][kt][jj] - mnew);
          st[s][kt][jj] = p;
          ps += p;
        }
      lrow[s] += ps;
#pragma unroll
      for (int u = 0; u < NU; ++u) {
        union { bf16x8 v; unsigned d[4]; } pu;
        pu.d[0] = pk2(st[s][2 * u][0], st[s][2 * u][1]);
        pu.d[1] = pk2(st[s][2 * u][2], st[s][2 * u][3]);
        pu.d[2] = pk2(st[s][2 * u + 1][0], st[s][2 * u + 1][1]);
        pu.d[3] = pk2(st[s][2 * u + 1][2], st[s][2 * u + 1][3]);
        pf[s][u] = pu.v;
      }
    }
    {
      constexpr int NF = NU * 8;
      union VU { bf16x8 v; u32x2 d[2]; };
      VU vf[3];
      auto vload = [&](VU& o, int f) {
        const int u = f >> 3, et = f & 7;
        o.d[0] = *(const u32x2*)(Vs + (et * 16 + li) * VLD + (2 * u) * 16 + g * 4);
        o.d[1] = *(const u32x2*)(Vs + (et * 16 + li) * VLD + (2 * u + 1) * 16 + g * 4);
      };
      vload(vf[0], 0);
      vload(vf[1], 1);
#pragma unroll
      for (int f = 0; f < NF; ++f) {
        if (f + 2 < NF) vload(vf[(f + 2) % 3], f + 2);
        __builtin_amdgcn_sched_barrier(0);
        const int u = f >> 3, et = f & 7;
        oacc[0][et] = mfma16(vf[f % 3].v, pf[0][u], oacc[0][et]);
        oacc[1][et] = mfma16(vf[f % 3].v, pf[1][u], oacc[1][et]);
        __builtin_amdgcn_sched_barrier(0);
      }
    }
    __syncthreads();
  }
#pragma unroll
  for (int s = 0; s < 2; ++s) {
    lrow[s] += xshfl(lrow[s], 16);
    lrow[s] += xshfl(lrow[s], 32);
  }
  const u16* G = (const u16*)(P.ws + WS_G);
  u16* O = (u16*)(P.ws + WS_O);
  if (DIFF) {
    const float i0 = 1.f / lrow[0], i1 = lam / lrow[1];
    float ss = 0.f;
#pragma unroll
    for (int et = 0; et < 8; ++et) {
      oacc[0][et] = oacc[0][et] * i0 - oacc[1][et] * i1;
#pragma unroll
      for (int jj = 0; jj < 4; ++jj) ss += oacc[0][et][jj] * oacc[0][et][jj];
    }
    ss += xshfl(ss, 16);
    ss += xshfl(ss, 32);
    const float rr = rsqrtf(ss * (1.f / 128.f) + EPS) * (1.f - lam_init);
    const size_t tok = (size_t)(qrow0 + w * 16 + li);
#pragma unroll
    for (int et = 0; et < 8; ++et) {
      const int e = et * 16 + g * 4;
      const float4 gs = *(const float4*)(gsub + e);
      const uint2 gg = *(const uint2*)(G + tok * 1024 + h * 128 + e);
      f32x4 v = oacc[0][et] * rr;
      v[0] *= gs.x * bf2f(gg.x & 0xffffu);
      v[1] *= gs.y * bf2f(gg.x >> 16);
      v[2] *= gs.z * bf2f(gg.y & 0xffffu);
      v[3] *= gs.w * bf2f(gg.y >> 16);
      st_bf4(O + tok * 1024 + h * 128 + e, v);
    }
  } else {
#pragma unroll
    for (int s = 0; s < 2; ++s) {
      const float inv = 1.f / lrow[s];
      const size_t tok = (size_t)(qrow0 + w * 32 + s * 16 + li);
#pragma unroll
      for (int et = 0; et < 8; ++et) {
        const int e = et * 16 + g * 4;
        const uint2 gg = *(const uint2*)(G + tok * 1024 + h * 128 + e);
        f32x4 v = oacc[s][et] * inv;
        v[0] *= bf2f(gg.x & 0xffffu);
        v[1] *= bf2f(gg.x >> 16);
        v[2] *= bf2f(gg.y & 0xffffu);
        v[3] *= bf2f(gg.y >> 16);
        st_bf4(O + tok * 1024 + h * 128 + e, v);
      }
    }
  }
}

DEVI void attn_diff_phase(const Params& P, int j, u16* smem) {
  const float* lamv = (const float*)(P.ws + WS_MISC);
  const float lam = lamv[j * 2], lam_init = lamv[j * 2 + 1];
  const float* gsub = P.in[I_GSUB] + j * 128;
  const u16* Q = (const u16*)(P.ws + WS_Q);
  for (int it = blockIdx.x; it < 1024; it += gridDim.x) {
    if (it < 512) {
      const int iv = xcd_remap(it, 512);
      const int bl = iv >> 7, h = (iv >> 4) & 7, qt = iv & 15;
      const u16* Kb = (const u16*)(P.ws + WS_KDLAT) + (size_t)j * KDLAT_J + (size_t)bl * 1280 * 1024 + h * 128;
      const u16* Vt = (const u16*)(P.ws + WS_VTLATD) + (size_t)j * VTLATD_J + (size_t)(bl * 8 + h) * 128 * 1280;
      attn_item<true>(P, Q, 1024, 4096 + bl * 1024 + qt * 64, Kb, 1024, Vt, 1280, h, lam, lam_init, gsub, smem);
    } else {
      const int i2 = xcd_remap(it - 512, 512), b = i2 >> 5, h = (i2 >> 2) & 7, qt = i2 & 3;
      const u16* Kb = (const u16*)(P.ws + WS_CTXK) + (size_t)b * 256 * 1024 + h * 128;
      const u16* Vt = (const u16*)(P.ws + WS_VTCTX) + (size_t)(b * 8 + h) * 128 * 256;
      attn_item<true>(P, Q, 1024, b * 256 + qt * 64, Kb, 1024, Vt, 256, h, lam, lam_init, gsub, smem);
    }
  }
}

DEVI void attn_mla_phase(const Params& P, int j, u16* smem) {
  const u16* Q = (const u16*)(P.ws + WS_Q);
  for (int it = blockIdx.x; it < 512; it += gridDim.x) {
    if (it < 256) {
      const int iv = xcd_remap(it, 256);
      const int bl = iv >> 6, h = (iv >> 3) & 7, qt = iv & 7;
      const u16* Kb = (const u16*)(P.ws + WS_KMLAT) + (size_t)j * KMLAT_J + (size_t)(bl * 8 + h) * 1280 * 192;
      const u16* Vt = (const u16*)(P.ws + WS_VTLATM) + (size_t)(bl * 8 + h) * 128 * 1280;
      attn_item<false>(P, Q, 1536, 4096 + bl * 1024 + qt * 128, Kb, 192, Vt, 1280, h, 0.f, 0.f, nullptr, smem);
    } else {
      const int i2 = xcd_remap(it - 256, 256), b = i2 >> 4, h = (i2 >> 1) & 7, qt = i2 & 1;
      const u16* Kb = (const u16*)(P.ws + WS_CTXK) + (size_t)(b * 8 + h) * 256 * 192;
      const u16* Vt = (const u16*)(P.ws + WS_VTCTX) + (size_t)(b * 8 + h) * 128 * 256;
      attn_item<false>(P, Q, 1536, b * 256 + qt * 128, Kb, 192, Vt, 256, h, 0.f, 0.f, nullptr, smem);
    }
  }
}

DEVI float wave_sum(float v) {
  v += xshfl(v, 1); v += xshfl(v, 2); v += xshfl(v, 4); v += xshfl(v, 8); v += xshfl(v, 16); v += xshfl(v, 32);
  return v;
}

DEVI void ew_phase(const Params& P, int layer) {
  const int lane = tidx() & 63, w = tidx() >> 6;
  const float* ada = (const float*)(P.ws + WS_ADA);
  const u16* T = (const u16*)(P.ws + WS_T);
  u16* H = (u16*)(P.ws + WS_H);
  const int nl = layer + 1;
  for (int r0 = blockIdx.x * 4 + w; r0 < 4096; r0 += gridDim.x * 4) {
    float4 x[2][4], t[2][4];
#pragma unroll
    for (int q = 0; q < 2; ++q) {
      const int row = r0 + q * 4096;
      const float* xsrc = (layer <= 0) ? (q == 0 ? P.in[I_XP] + (size_t)row * 1024 : P.in[I_XS] + (size_t)(row - 4096) * 1024)
                                       : P.out + OUT_Y + (size_t)row * 1024;
#pragma unroll
      for (int i = 0; i < 4; ++i) x[q][i] = *(const float4*)(xsrc + lane * 4 + i * 256);
      if (layer >= 0) {
#pragma unroll
        for (int i = 0; i < 4; ++i) {
          const u32x2 tv = *(const u32x2*)(T + (size_t)row * 1024 + lane * 4 + i * 256);
          t[q][i] = make_float4(bf2f(tv[0] & 0xffffu), bf2f(tv[0] >> 16), bf2f(tv[1] & 0xffffu), bf2f(tv[1] >> 16));
        }
      }
    }
#pragma unroll
    for (int q = 0; q < 2; ++q) {
      const int row = r0 + q * 4096;
      const int cond = q == 0 ? 0 : 1 + (r0 >> 10);
      if (layer >= 0) {
        float ss = 0.f;
#pragma unroll
        for (int i = 0; i < 4; ++i)
          ss += t[q][i].x * t[q][i].x + t[q][i].y * t[q][i].y + t[q][i].z * t[q][i].z + t[q][i].w * t[q][i].w;
        ss = wave_sum(ss);
        const float rt = rsqrtf(ss * (1.f / 1024.f) + EPS);
        const float* gate = ada + (size_t)(layer * 5 + cond) * 3072 + 2048;
        const float* gp = P.in[I_GPOST] + layer * 1024;
#pragma unroll
        for (int i = 0; i < 4; ++i) {
          const int c = lane * 4 + i * 256;
          const float4 ga = *(const float4*)(gate + c);
          const float4 gq = *(const float4*)(gp + c);
          x[q][i].x += ga.x * (t[q][i].x * rt * gq.x);
          x[q][i].y += ga.y * (t[q][i].y * rt * gq.y);
          x[q][i].z += ga.z * (t[q][i].z * rt * gq.z);
          x[q][i].w += ga.w * (t[q][i].w * rt * gq.w);
          *(float4*)(P.out + OUT_Y + (size_t)row * 1024 + c) = x[q][i];
        }
      }
      if (nl < 4) {
        float ss = 0.f;
#pragma unroll
        for (int i = 0; i < 4; ++i)
          ss += x[q][i].x * x[q][i].x + x[q][i].y * x[q][i].y + x[q][i].z * x[q][i].z + x[q][i].w * x[q][i].w;
        ss = wave_sum(ss);
        const float rx = rsqrtf(ss * (1.f / 1024.f) + EPS);
        const float* sh = ada + (size_t)(nl * 5 + cond) * 3072;
        const float* sc = sh + 1024;
        const float* gpre = P.in[I_GPRE] + nl * 1024;
#pragma unroll
        for (int i = 0; i < 4; ++i) {
          const int c = lane * 4 + i * 256;
          const float4 s1 = *(const float4*)(sh + c);
          const float4 s2 = *(const float4*)(sc + c);
          const float4 gq = *(const float4*)(gpre + c);
          f32x4 hv;
          hv[0] = x[q][i].x * rx * gq.x * (1.f + s2.x) + s1.x;
          hv[1] = x[q][i].y * rx * gq.y * (1.f + s2.y) + s1.y;
          hv[2] = x[q][i].z * rx * gq.z * (1.f + s2.z) + s1.z;
          hv[3] = x[q][i].w * rx * gq.w * (1.f + s2.w) + s1.w;
          st_bf4(H + (size_t)row * 1024 + c, hv);
        }
      }
    }
  }
}

DEVI void tr_tile(const float* __restrict__ src, int lds, int k0, int n0, int nvalid, u16* __restrict__ dst, int ldd,
                  const float* kscale, float* tile) {
  const int tid = tidx();
  float4 v[4];
#pragma unroll
  for (int i = 0; i < 4; ++i) {
    const int idx = tid + 256 * i, kk = idx >> 4, c4 = (idx & 15) * 4;
    v[i] = (n0 + c4 < nvalid) ? *(const float4*)(src + (size_t)(k0 + kk) * lds + n0 + c4) : make_float4(0.f, 0.f, 0.f, 0.f);
    if (kscale) { const float ks = kscale[k0 + kk]; v[i].x *= ks; v[i].y *= ks; v[i].z *= ks; v[i].w *= ks; }
  }
  __syncthreads();
#pragma unroll
  for (int i = 0; i < 4; ++i) {
    const int idx = tid + 256 * i, kk = idx >> 4, c4 = (idx & 15) * 4;
    float* tp = tile + kk * 65 + c4;
    tp[0] = v[i].x; tp[1] = v[i].y; tp[2] = v[i].z; tp[3] = v[i].w;
  }
  __syncthreads();
#pragma unroll
  for (int i = 0; i < 2; ++i) {
    const int c = tid + 256 * i, nn = c >> 3, kc = (c & 7) * 8;
    const float* tp = tile + kc * 65 + nn;
    u32x4 u;
    u[0] = pk2(tp[0], tp[65]); u[1] = pk2(tp[2 * 65], tp[3 * 65]); u[2] = pk2(tp[4 * 65], tp[5 * 65]); u[3] = pk2(tp[6 * 65], tp[7 * 65]);
    *(u32x4*)(dst + (size_t)(n0 + nn) * ldd + k0 + kc) = u;
  }
}

constexpr int N_ADA = 384;
constexpr int N_TWOUT = 1024, N_TDAIN = 2048, N_TMLAIN = 896, N_TQB = 288, N_TKVB = 256, N_TCV = 512;
constexpr int N_ROPE = 128, N_LAM = 1, N_CDK = 1024, N_CCKV = 256, N_CKPE = 64;
constexpr int P0_ITEMS = N_ADA + N_TWOUT + N_TDAIN + N_TMLAIN + N_TQB + N_TKVB + N_TCV + N_ROPE + N_LAM + N_CDK + N_CCKV + N_CKPE;

constexpr int PI_A = N_ADA, PI_D = PI_A + N_TWOUT, PI_M = PI_D + N_TDAIN, PI_Q = PI_M + N_TMLAIN, PI_K = PI_Q + N_TQB, PI_C = PI_K + N_TKVB;
DEVI int prep_map(int set, int n) {
  int lo[4], hi[4];
  if (set == 0)      { lo[0] = 0;          hi[0] = PI_A;        lo[1] = PI_A;       hi[1] = PI_A + 256;  lo[2] = PI_D;        hi[2] = PI_D + 1024; lo[3] = PI_C;       hi[3] = P0_ITEMS; }
  else if (set == 1) { lo[0] = PI_M;       hi[0] = PI_M + 448;  lo[1] = PI_Q;       hi[1] = PI_Q + 144;  lo[2] = PI_K;        hi[2] = PI_K + 128;  lo[3] = PI_A + 256; hi[3] = PI_A + 512; }
  else if (set == 2) { lo[0] = PI_D + 1024; hi[0] = PI_D + 2048; lo[1] = PI_A + 512; hi[1] = PI_A + 768;  lo[2] = 0;           hi[2] = 0;           lo[3] = 0;          hi[3] = 0; }
  else               { lo[0] = PI_M + 448; hi[0] = PI_M + 896;  lo[1] = PI_Q + 144; hi[1] = PI_Q + 288;  lo[2] = PI_K + 128;  hi[2] = PI_K + 256;  lo[3] = PI_A + 768; hi[3] = PI_A + 1024; }
#pragma unroll
  for (int r = 0; r < 4; ++r) {
    const int c = hi[r] - lo[r];
    if (n < c) return lo[r] + n;
    n -= c;
  }
  return -1;
}

DEVI void prep_phase(const Params& P, u16* smem, int set, int bid, int nb) {
  float* fs = (float*)smem;
  const int tid = tidx();
  for (int n = bid; ; n += nb) {
    const int item = prep_map(set, n);
    if (item < 0) break;
    int it = item;
    if (it < N_ADA) {
      const int layer = it / 96, r96 = it % 96, cgp = r96 >> 3, ks = r96 & 7;
      float* sc = fs;
      float* red = fs + 640;
      __syncthreads();
      for (int idx = tid; idx < 640; idx += 256) {
        const int cnd = idx >> 7, k = ks * 128 + (idx & 127);
        const float v = cnd == 0 ? P.in[I_CCTX][k] : P.in[I_C][(cnd - 1) * 1024 + k];
        sc[idx] = silu(v);
      }
      __syncthreads();
      const int c4 = tid & 63, wv_ = tid >> 6;
      const float* wp = P.in[I_WADA] + (size_t)layer * 1024 * 3072 + (size_t)(ks * 128 + wv_ * 32) * 3072 + cgp * 256 + c4 * 4;
      float a[5][4];
#pragma unroll
      for (int c = 0; c < 5; ++c)
#pragma unroll
        for (int q = 0; q < 4; ++q) a[c][q] = 0.f;
#pragma unroll 8
      for (int i = 0; i < 32; ++i) {
        const float4 wv = *(const float4*)(wp + (size_t)i * 3072);
#pragma unroll
        for (int c = 0; c < 5; ++c) {
          const float sv = sc[c * 128 + wv_ * 32 + i];
          a[c][0] += sv * wv.x; a[c][1] += sv * wv.y; a[c][2] += sv * wv.z; a[c][3] += sv * wv.w;
        }
      }
#pragma unroll
      for (int c = 0; c < 5; ++c)
#pragma unroll
        for (int q = 0; q < 4; ++q) red[(wv_ * 5 + c) * 256 + c4 * 4 + q] = a[c][q];
      __syncthreads();
      float* part = (float*)(P.ws + WS_ADAP) + (size_t)((layer * 12 + cgp) * 8) * 1280;
#pragma unroll
      for (int c = 0; c < 5; ++c) {
        const float v = ((red[(0 * 5 + c) * 256 + tid] + red[(1 * 5 + c) * 256 + tid]) + red[(2 * 5 + c) * 256 + tid]) + red[(3 * 5 + c) * 256 + tid];
        part[(size_t)ks * 1280 + c * 256 + tid] = v;
      }
      continue;
    }
    it -= N_ADA;
    if (it < N_TWOUT) {
      const int l = it >> 8, kt = (it >> 4) & 15, nt = it & 15;
      tr_tile(P.in[I_WOUT] + (size_t)l * 1024 * 1024, 1024, kt * 64, nt * 64, 1024,
              (u16*)(P.ws + WS_WOUT) + (size_t)l * 1024 * 1024, 1024, nullptr, fs);
      continue;
    }
    it -= N_TWOUT;
    if (it < N_TDAIN) {
      const int l = it >> 10, kt = (it >> 6) & 15, nt = it & 63;
      tr_tile(P.in[I_DAWIN] + (size_t)l * 1024 * 4096, 4096, kt * 64, nt * 64, 4096,
              (u16*)(P.ws + WS_WDAIN) + (size_t)l * 4096 * 1024, 1024, nullptr, fs);
      continue;
    }
    it -= N_TDAIN;
    if (it < N_TMLAIN) {
      const int l = it / 448, r = it % 448, kt = r / 28, nt = r % 28;
      tr_tile(P.in[I_MWIN] + (size_t)l * 1024 * 1728, 1728, kt * 64, nt * 64, 1728,
              (u16*)(P.ws + WS_WMLAIN) + (size_t)l * 1792 * 1024, 1024, nullptr, fs);
      continue;
    }
    it -= N_TMLAIN;
    if (it < N_TQB) {
      const int l = it / 144, r = it % 144, kt = r / 24, nt = r % 24;
      tr_tile(P.in[I_WQB] + (size_t)l * 384 * 1536, 1536, kt * 64, nt * 64, 1536,
              (u16*)(P.ws + WS_WQB) + (size_t)l * 1536 * 384, 384, P.in[I_GQA] + l * 384, fs);
      continue;
    }
    it -= N_TQB;
    if (it < N_TKVB) {
      const int l = it >> 7, kt = (it >> 5) & 3, nt = it & 31;
      tr_tile(P.in[I_WKVB] + (size_t)l * 256 * 2048, 2048, kt * 64, nt * 64, 2048,
              (u16*)(P.ws + WS_WKVB) + (size_t)l * 2048 * 256, 256, nullptr, fs);
      tr_tile(P.in[I_WKVB] + (size_t)l * 256 * 2048, 2048, kt * 64, nt * 64, 2048,
              (u16*)(P.ws + WS_WKVBG) + (size_t)l * 2048 * 256, 256, P.in[I_GKVA] + l * 256, fs);
      continue;
    }
    it -= N_TKVB;
    if (it < N_TCV) {
      const int grp = it >> 3, sub = it & 7, bl = grp >> 4, jj = (grp >> 3) & 1, h = grp & 7, pt = sub >> 1, et = sub & 1;
      const float* src = P.in[I_CDV] + ((size_t)(bl * 2 + jj) * 256) * 1024 + h * 128;
      u16* dst = (u16*)(P.ws + WS_VTLATD) + (size_t)jj * VTLATD_J + (size_t)(bl * 8 + h) * 128 * 1280 + 1024;
      tr_tile(src, 1024, pt * 64, et * 64, 128, dst, 1280, nullptr, fs);
      continue;
    }
    it -= N_TCV;
    if (it < N_ROPE) {
      const int idx = it * 256 + tid, t = idx >> 5, p = idx & 31, f = p & 15;
      const float inv = exp2f(-(float)f * (13.287712379549449f / 16.f));
      const float pos = (p < 16) ? (float)(t >> 6) : (float)(t & 63);
      float sn, cs;
      sincosf(pos * inv, &sn, &cs);
      float* rc = (float*)(P.ws + WS_ROPE);
      rc[idx] = cs;
      rc[1024 * 32 + idx] = sn;
      continue;
    }
    it -= N_ROPE;
    if (it < N_LAM) {
      if (tid < 2) {
        const int jd = tid;
        float s1 = 0.f, s2 = 0.f;
        for (int d = 0; d < 64; ++d) {
          s1 += P.in[I_LQ1][jd * 64 + d] * P.in[I_LK1][jd * 64 + d];
          s2 += P.in[I_LQ2][jd * 64 + d] * P.in[I_LK2][jd * 64 + d];
        }
        const float li = 0.8f - 0.6f * expf(-0.3f * (float)(2 * jd));
        float* lamv = (float*)(P.ws + WS_MISC);
        lamv[jd * 2] = expf(s1) - expf(s2) + li;
        lamv[jd * 2 + 1] = li;
      }
      continue;
    }
    it -= N_LAM;
    if (it < N_CDK) {
      const size_t e0 = ((size_t)it * 256 + tid) * 8;
      const int col = e0 & 1023, p = (e0 >> 10) & 255, jj = (e0 >> 18) & 1, bl = (int)(e0 >> 19);
      const float4 a = *(const float4*)(P.in[I_CDK] + e0);
      const float4 b = *(const float4*)(P.in[I_CDK] + e0 + 4);
      uint4 u; u.x = pk2(a.x, a.y); u.y = pk2(a.z, a.w); u.z = pk2(b.x, b.y); u.w = pk2(b.z, b.w);
      *(uint4*)((u16*)(P.ws + WS_KDLAT) + (size_t)jj * KDLAT_J + ((size_t)(bl * 1280 + 1024 + p)) * 1024 + col) = u;
      continue;
    }
    it -= N_CDK;
    if (it < N_CCKV) {
      const size_t e0 = ((size_t)it * 256 + tid) * 8;
      const int col = e0 & 255, p = (e0 >> 8) & 255, jj = (e0 >> 16) & 1, bl = (int)(e0 >> 17);
      const float4 a = *(const float4*)(P.in[I_CCKV] + e0);
      const float4 b = *(const float4*)(P.in[I_CCKV] + e0 + 4);
      uint4 u; u.x = pk2(a.x, a.y); u.y = pk2(a.z, a.w); u.z = pk2(b.x, b.y); u.w = pk2(b.z, b.w);
      *(uint4*)((u16*)(P.ws + WS_CKVA) + (size_t)jj * CKVA_J + ((size_t)(4096 + bl * 1280 + 1024 + p)) * 256 + col) = u;
      continue;
    }
    it -= N_CCKV;
    {
      const size_t e0 = ((size_t)it * 256 + tid) * 8;
      const int d = e0 & 63, p = (e0 >> 6) & 255, jj = (e0 >> 14) & 1, bl = (int)(e0 >> 15);
      const float4 a = *(const float4*)(P.in[I_CKPE] + e0);
      const float4 b = *(const float4*)(P.in[I_CKPE] + e0 + 4);
      uint4 u; u.x = pk2(a.x, a.y); u.y = pk2(a.z, a.w); u.z = pk2(b.x, b.y); u.w = pk2(b.z, b.w);
      u16* dst = (u16*)(P.ws + WS_KMLAT) + (size_t)jj * KMLAT_J + ((size_t)(bl * 8) * 1280 + 1024 + p) * 192 + 128 + d;
#pragma unroll
      for (int h = 0; h < 8; ++h) *(uint4*)(dst + (size_t)h * 1280 * 192) = u;
    }
  }
}

DEVI void mla_b_phase(const Params& P, int j, u16* smem) {
  constexpr int NQ = 32 * 12, NKV = 36 * 16, NNORM = 64;
  for (int it = blockIdx.x; it < NKV + NQ + NNORM; it += gridDim.x) {
    if (it < NKV) tile_kvb(P, j, it, smem);
    else if (it < NKV + NQ) tile_qb(P, j, it - NKV, smem);
    else {
      const int lane = tidx() & 63, w = tidx() >> 6;
      const float* ssq = (const float*)(P.ws + WS_SSQKV);
      const float4 gk = *(const float4*)(P.in[I_GKVA] + j * 256 + lane * 4);
      for (int r = w; r < 64; r += 4) {
        const int row = (it - NKV - NQ) * 64 + r;
        const float4 s4 = *(const float4*)(ssq + (size_t)row * 4);
        const float rr = rsqrtf((s4.x + s4.y + s4.z + s4.w) * (1.f / 256.f) + EPS);
        float* p = P.out + OUT_CKV + ((size_t)(((row >> 8) * 2 + j) * 256 + (row & 255))) * 256 + lane * 4;
        float4 v = *(const float4*)((const float*)(P.ws + WS_KVRAW) + (size_t)row * 256 + lane * 4);
        v.x *= rr * gk.x; v.y *= rr * gk.y; v.z *= rr * gk.z; v.w *= rr * gk.w;
        *(float4*)p = v;
      }
    }
  }
}


#define XB_TMO      128
#define XB_XCNT(j)  (256  + 64 * (j))
#define XB_XSUB(j)  (1280 + 64 * (j))
#define XB_XGEN(j)  (2304 + 64 * (j))
#define XB_TOP      3328
#define XB_TOPGEN   3392
#define XCD_BAR_WORDS 3456
#define XB_SPIN_CAP (1u << 22)
#define LAS __attribute__((address_space(3)))
DEVI unsigned xb_ld(unsigned* p) { return __hip_atomic_load(p, __ATOMIC_RELAXED, __HIP_MEMORY_SCOPE_AGENT); }
DEVI unsigned xb_add(unsigned* p, unsigned v) { return __hip_atomic_fetch_add(p, v, __ATOMIC_RELAXED, __HIP_MEMORY_SCOPE_AGENT); }
DEVI unsigned xb_xcc_id() { return (unsigned)__builtin_amdgcn_s_getreg((3 << 11) | 20) & 0xFu; }
#define XB_SPIN(cond, bar) do { unsigned _sp = 0; while (cond) { __builtin_amdgcn_s_sleep(1); \
    if ((++_sp & 255u) == 0u) { if (xb_ld(&(bar)[XB_TMO])) break; if (_sp > XB_SPIN_CAP) { atomicAdd(&(bar)[XB_TMO], 1u); break; } } } } while (0)
struct XcdBarrier { unsigned* bar; unsigned x; volatile LAS unsigned* st; };
DEVI XcdBarrier xcd_barrier_post(unsigned* bar, volatile LAS unsigned* st) {
  XcdBarrier b; b.bar = bar; b.x = xb_xcc_id(); b.st = st;
  if (threadIdx.x == 0) (void)xb_add(&bar[XB_XCNT(b.x)], 1u);
  return b;
}
DEVI void xcd_barrier_complete(unsigned* bar, unsigned x, unsigned& nloc, unsigned& nx) {
  const unsigned G = gridDim.x * gridDim.y * gridDim.z;
  unsigned sum, cnt, mine, sp = 0u;
  for (;;) {
    sum = 0u; cnt = 0u; mine = 0u;
#pragma unroll
    for (unsigned j = 0; j < 16; ++j) { const unsigned c = xb_ld(&bar[XB_XCNT(j)]); sum += c; cnt += (c > 0u) ? 1u : 0u; mine = (j == x) ? c : mine; }
    if (sum == G) break;
    __builtin_amdgcn_s_sleep(1);
    if ((++sp & 255u) == 0u) { if (xb_ld(&bar[XB_TMO])) break; if (sp > XB_SPIN_CAP) { atomicAdd(&bar[XB_TMO], 1u); break; } }
  }
  nloc = mine > 0u ? mine : 1u; nx = cnt > 0u ? cnt : 1u;
}
DEVI void xcd_barrier(const XcdBarrier& b) {
  asm volatile("s_waitcnt vmcnt(0)" ::: "memory");
  __syncthreads();
  if (threadIdx.x == 0) {
    unsigned* bar = b.bar;
    __builtin_amdgcn_s_waitcnt(0);
    unsigned nloc = b.st[0], nx = b.st[1];
    if (nloc == 0u) { xcd_barrier_complete(bar, b.x, nloc, nx); b.st[0] = nloc; b.st[1] = nx; }
    const unsigned old = xb_add(&bar[XB_XSUB(b.x)], 1u);
    const unsigned gen = old / nloc;
    if (old + 1u == (gen + 1u) * nloc) {
      __builtin_amdgcn_fence(__ATOMIC_RELEASE, "agent");
      asm volatile("s_waitcnt vmcnt(0)" ::: "memory");
      const unsigned og = xb_add(&bar[XB_TOP], 1u);
      const unsigned tg = og / nx;
      if (og + 1u == (tg + 1u) * nx) xb_add(&bar[XB_TOPGEN], 1u);
      else XB_SPIN(xb_ld(&bar[XB_TOPGEN]) == tg, bar);
      __builtin_amdgcn_fence(__ATOMIC_ACQUIRE, "agent");
      xb_add(&bar[XB_XGEN(b.x)], 1u);
      asm volatile("s_waitcnt vmcnt(0)" ::: "memory");
    } else {
      XB_SPIN(xb_ld(&bar[XB_XGEN(b.x)]) == gen, bar);
      __builtin_amdgcn_fence(__ATOMIC_ACQUIRE, "agent");
      asm volatile("s_waitcnt vmcnt(0)" ::: "memory");
    }
  }
  __syncthreads();
}

DEVI void ada_reduce_phase(const Params& P) {
  const float* part = (const float*)(P.ws + WS_ADAP);
  float* ada = (float*)(P.ws + WS_ADA);
  for (int i = blockIdx.x * 256 + tidx(); i < 4 * 5 * 768; i += gridDim.x * 256) {
    const int n4 = i % 768, lc = i / 768, c = lc % 5, layer = lc / 5, n = n4 * 4, cgp = n >> 8, col = n & 255;
    float4 sum = *(const float4*)(P.in[I_BADA] + layer * 3072 + n);
    const float* pp = part + (size_t)((layer * 12 + cgp) * 8) * 1280 + c * 256 + col;
#pragma unroll
    for (int q = 0; q < 8; ++q) {
      const float4 v = *(const float4*)(pp + (size_t)q * 1280);
      sum.x += v.x; sum.y += v.y; sum.z += v.z; sum.w += v.w;
    }
    *(float4*)(ada + (size_t)(layer * 5 + c) * 3072 + n) = sum;
  }
}

#ifndef EN
#define EN 0xFF
#endif
DEVI void run_phase(const Params& P, int ph, u16* smem) {
  if (ph == 0) { if (EN & 1) prep_phase(P, smem, 0, blockIdx.x, gridDim.x); return; }
  if (ph == 1) { ada_reduce_phase(P); return; }
  if (ph == 2) { if (EN & 2) ew_phase(P, -1); return; }
  ph -= 1;
  int layer, sub;
  if (ph < 6) { layer = 0; sub = ph - 2; }
  else if (ph < 11) { layer = 1; sub = ph - 6; }
  else if (ph < 15) { layer = 2; sub = ph - 11; }
  else { layer = 3; sub = ph - 15; }
  const int j = layer >> 1;
  if ((layer & 1) == 0) {
    if (sub == 0) { if (EN & 4) for (int t = blockIdx.x; t < 32 * 32; t += gridDim.x) tile_diff_in(P, j, t, smem); }
    else if (sub == 1) { if (EN & 8) attn_diff_phase(P, j, smem); }
    else if (sub == 2) {
      if (EN & 16) for (int t = blockIdx.x; t < 32 * 8; t += gridDim.x) tile_out(P, layer, t, smem);
      const int pset = layer == 0 ? 1 : 3;
      if (gridDim.x >= 512) { if (blockIdx.x >= 256) prep_phase(P, smem, pset, blockIdx.x - 256, gridDim.x - 256); }
      else prep_phase(P, smem, pset, blockIdx.x, gridDim.x);
    }
    else { if (EN & 2) ew_phase(P, layer); }
  } else {
    if (sub == 0) { if (EN & 32) for (int t = blockIdx.x; t < 32 * 14; t += gridDim.x) tile_mla_in(P, j, t, smem); }
    else if (sub == 1) { if (EN & 64) mla_b_phase(P, j, smem); }
    else if (sub == 2) { if (EN & 128) attn_mla_phase(P, j, smem); }
    else if (sub == 3) {
      if (EN & 16) for (int t = blockIdx.x; t < 32 * 8; t += gridDim.x) tile_out(P, layer, t, smem);
      if (layer == 1) {
        if (gridDim.x >= 512) { if (blockIdx.x >= 256) prep_phase(P, smem, 2, blockIdx.x - 256, gridDim.x - 256); }
        else prep_phase(P, smem, 2, blockIdx.x, gridDim.x);
      }
    }
    else { if (EN & 2) ew_phase(P, layer); }
  }
}

constexpr int N_PHASES = 21;

__global__ void __launch_bounds__(256, 2) fwd_megakernel(Params P) {
  __shared__ __attribute__((aligned(16))) u16 smem[SMEM_BYTES / 2];
  __shared__ uint4 xb_words;
  if (threadIdx.x == 0) xb_words = make_uint4(0u, 0u, 0u, 0u);
  __syncthreads();
  XcdBarrier xb = xcd_barrier_post((unsigned*)(P.ws + WS_BAR), (volatile LAS unsigned*)&xb_words);
  for (int ph = P.ph_lo; ph < P.ph_hi; ++ph) {
    Params Pl = P;
    {
      size_t zoff = 0;
      asm volatile("" : "+s"(zoff));
      Pl.ws = P.ws + zoff;
      Pl.out = P.out + zoff;
    }
    run_phase(Pl, ph, smem);
#ifdef REP_MASK
    {
      int kind;
      if (ph == 0) kind = 1; else if (ph == 1) kind = 2;
      else { int layer, sub; if (ph < 6) { layer = 0; sub = ph - 2; } else if (ph < 11) { layer = 1; sub = ph - 6; } else if (ph < 15) { layer = 2; sub = ph - 11; } else { layer = 3; sub = ph - 15; }
        if ((layer & 1) == 0) kind = sub == 0 ? 4 : sub == 1 ? 8 : sub == 2 ? 16 : 2;
        else kind = sub == 0 ? 32 : sub == 1 ? 64 : sub == 2 ? 128 : sub == 3 ? 16 : 2; }
      if (kind & REP_MASK) { xcd_barrier(xb); run_phase(Pl, ph, smem); }
    }
#endif
    if (ph + 1 < P.ph_hi) {
      if (P.ph_hi > 1000) cg::this_grid().sync();
      xcd_barrier(xb);
    }
#ifdef EXTRA_SYNCS
    for (int q = 0; q < EXTRA_SYNCS; ++q) xcd_barrier(xb);
#endif
  }
}

extern "C" void kernel_launch(void* const* d_in, const int* in_sizes, int n_in, void* d_out, int out_size, void* d_ws,
                              size_t ws_size, hipStream_t stream) {
  static int grid_blocks = 0;
  if (!grid_blocks) {
    int dev = 0, cus = 0, per_cu = 0;
    (void)hipGetDevice(&dev);
    (void)hipDeviceGetAttribute(&cus, hipDeviceAttributeMultiprocessorCount, dev);
    (void)hipOccupancyMaxActiveBlocksPerMultiprocessor(&per_cu, fwd_megakernel, 256, 0);
    if (per_cu < 1) per_cu = 1;
    if (per_cu > 2) per_cu = 2;
    grid_blocks = cus * per_cu;
  }
  if (hipMemsetAsync((unsigned char*)d_ws + WS_BAR, 0, 16384, stream) != hipSuccess) { fprintf(stderr, "memset failed\n"); return; }
  Params p{};
  for (int i = 0; i < 24; ++i) p.in[i] = (const float*)d_in[i];
  p.out = (float*)d_out;
  p.ws = (unsigned char*)d_ws;
#if MULTI_LAUNCH
  for (int ph = 0; ph < N_PHASES; ++ph) {
    p.ph_lo = ph; p.ph_hi = ph + 1;
    hipLaunchKernelGGL(fwd_megakernel, dim3(grid_blocks), dim3(256), 0, stream, p);
  }
#else
  p.ph_lo = 0; p.ph_hi = N_PHASES;
  void* args[] = {&p};
  hipError_t e = hipLaunchCooperativeKernel((void*)fwd_megakernel, dim3(grid_blocks), dim3(256), args, 0, stream);
  if (e != hipSuccess) fprintf(stderr, "cooperative launch failed: %s (grid %d)\n", hipGetErrorString(e), grid_blocks);
#endif
}
```

```cpp
#include <hip/hip_runtime.h>
#include <hip/hip_cooperative_groups.h>
#include <cstdio>
namespace cg = cooperative_groups;

#ifndef MULTI_LAUNCH
#define MULTI_LAUNCH 0
#endif

typedef unsigned short u16;
typedef __attribute__((ext_vector_type(8))) short bf16x8;
typedef __attribute__((ext_vector_type(4))) float f32x4;
typedef __attribute__((ext_vector_type(4))) unsigned u32x4;
typedef __attribute__((ext_vector_type(2))) unsigned u32x2;

#define DEVI __device__ __forceinline__

struct Params {
  const float* in[24];
  float* out;
  unsigned char* ws;
  int ph_lo, ph_hi;
};

constexpr size_t MBy = 1u << 20;
constexpr size_t WS_WOUT = 0;
constexpr size_t WS_WDAIN = 8 * MBy;
constexpr size_t WS_WMLAIN = 24 * MBy;
constexpr size_t WS_WQB = 31 * MBy;
constexpr size_t WS_WKVB = 34 * MBy;
constexpr size_t WS_WKVBG = 36 * MBy;
constexpr size_t WS_ADA = 38 * MBy;
constexpr size_t WS_ROPE = 39 * MBy;
constexpr size_t WS_MISC = 40 * MBy;
constexpr size_t WS_H = 41 * MBy;
constexpr size_t WS_O = WS_H;
constexpr size_t WS_Q = 57 * MBy;
constexpr size_t WS_T = WS_Q;
constexpr size_t WS_CTXK = 81 * MBy;
constexpr size_t WS_KDLAT = 93 * MBy;
constexpr size_t WS_VTCTX = 113 * MBy;
constexpr size_t WS_VTLATD = 121 * MBy;
constexpr size_t WS_VTLATM = 141 * MBy;
constexpr size_t WS_G = 151 * MBy;
constexpr size_t WS_QA = 167 * MBy;
constexpr size_t WS_CKVA = 173 * MBy;
constexpr size_t WS_SSQQ = 183 * MBy;
constexpr size_t WS_SSQKV = 184 * MBy;
constexpr size_t WS_KMLAT = 185 * MBy;
constexpr size_t WS_KVRAW = 215 * MBy;
constexpr size_t WS_BAR = WS_MISC + 65536;
constexpr size_t WS_ADAP = 219 * MBy;
constexpr size_t KDLAT_J = (size_t)4 * 1280 * 1024;
constexpr size_t VTLATD_J = (size_t)4 * 8 * 128 * 1280;
constexpr size_t CKVA_J = (size_t)9216 * 256;
constexpr size_t KMLAT_J = (size_t)4 * 8 * 1280 * 192;

constexpr size_t OUT_Y = 0;
constexpr size_t OUT_SK = 8388608;
constexpr size_t OUT_SV = 16777216;
constexpr size_t OUT_CKV = 25165824;
constexpr size_t OUT_KPE = 27262976;

constexpr float EPS = 1e-6f;
constexpr float LOG2E = 1.4426950408889634f;

enum { I_XP = 0, I_XS, I_CDK, I_CDV, I_CCKV, I_CKPE, I_C, I_CCTX, I_WADA, I_BADA, I_GPRE, I_GPOST, I_WOUT,
       I_DAWIN, I_LQ1, I_LK1, I_LQ2, I_LK2, I_GSUB, I_MWIN, I_GQA, I_WQB, I_GKVA, I_WKVB };

DEVI int tidx() { int t = threadIdx.x; asm volatile("" : "+v"(t)); return t; }
DEVI u16 f2bf(float f) {
  unsigned u = __float_as_uint(f);
  u += 0x7fffu + ((u >> 16) & 1u);
  return (u16)(u >> 16);
}
typedef __attribute__((ext_vector_type(2))) float f32x2_t;
typedef __attribute__((ext_vector_type(2))) __bf16 bf16x2_t;
DEVI unsigned pk2(float a, float b) {
  f32x2_t v = {a, b};
  bf16x2_t r = __builtin_convertvector(v, bf16x2_t);
  return __builtin_bit_cast(unsigned, r);
}
DEVI float bf2f(unsigned v) { return __uint_as_float(v << 16); }
DEVI void st_bf4(u16* p, f32x4 v) {
  uint2 u; u.x = pk2(v[0], v[1]); u.y = pk2(v[2], v[3]);
  *(uint2*)p = u;
}
DEVI void st_pair(u16* p, int g, f32x4 a, f32x4 b) {
  const bool odd = g & 1;
  f32x4 send, recv;
#pragma unroll
  for (int i = 0; i < 4; ++i) send[i] = odd ? a[i] : b[i];
#pragma unroll
  for (int i = 0; i < 4; ++i) recv[i] = __shfl_xor(send[i], 16, 64);
  f32x4 lo, hi;
#pragma unroll
  for (int i = 0; i < 4; ++i) { lo[i] = odd ? recv[i] : a[i]; hi[i] = odd ? b[i] : recv[i]; }
  u32x4 u;
  u[0] = pk2(lo[0], lo[1]); u[1] = pk2(lo[2], lo[3]); u[2] = pk2(hi[0], hi[1]); u[3] = pk2(hi[2], hi[3]);
  *(u32x4*)(p + (odd ? 16 : 0) + (g >> 1) * 8) = u;
}
DEVI void st_f4(float* p, f32x4 v) { *(float4*)p = make_float4(v[0], v[1], v[2], v[3]); }
DEVI f32x4 mfma16(bf16x8 a, bf16x8 b, f32x4 c) { return __builtin_amdgcn_mfma_f32_16x16x32_bf16(a, b, c, 0, 0, 0); }
DEVI float silu(float x) { return x * __builtin_amdgcn_rcpf(1.f + __builtin_amdgcn_exp2f(-1.4426950408889634f * x)); }
DEVI float xshfl(float v, int m) { return __shfl_xor(v, m, 64); }

DEVI void rope4(f32x4& x1, f32x4& x2, const float* cs, const float* sn) {
  float4 c = *(const float4*)cs; float4 s = *(const float4*)sn;
  f32x4 a = x1, b = x2;
  x1[0] = a[0] * c.x - b[0] * s.x; x2[0] = a[0] * s.x + b[0] * c.x;
  x1[1] = a[1] * c.y - b[1] * s.y; x2[1] = a[1] * s.y + b[1] * c.y;
  x1[2] = a[2] * c.z - b[2] * s.z; x2[2] = a[2] * s.z + b[2] * c.z;
  x1[3] = a[3] * c.w - b[3] * s.w; x2[3] = a[3] * s.w + b[3] * c.w;
}

constexpr int LDT = 64;
constexpr int TILE_ELEMS = 128 * LDT;
constexpr int SMEM_BYTES = 2 * (64 * 144 + 128 * 72) * 2;

template <bool SWAP>
DEVI void gemm_core(const u16* __restrict__ A, int lda, const u16* __restrict__ B, int ldb, int K,
                    int m0, int n0, u16* smem, f32x4 (&acc)[8][4]) {
  const int tid = tidx(), lane = tid & 63, w = tid >> 6;
  const int wm = w >> 1, wn = w & 1;
  const int g = lane >> 4, li = lane & 15;
  u16* As = smem;
  u16* Bs = smem + 256 * 64;
  const int lr = tid >> 3, lc = (tid & 7) * 8;
  const u16* ap = A + (size_t)(m0 + lr) * lda + lc;
  const u16* bp = B + (size_t)(n0 + lr) * ldb + lc;
  const int wsw = (((tid & 7) ^ (lr & 7)) * 8);
  u16* sa = As + lr * 64 + wsw;
  u16* sb = Bs + lr * 64 + wsw;
  const int rs0 = ((g ^ (li & 7)) * 8), rs1 = (((4 + g) ^ (li & 7)) * 8);
  const u16* Ard = As + (wm * 128 + li) * 64;
  const u16* Brd = Bs + (wn * 64 + li) * 64;
  u32x4 ra[8], rb[4];
#define GLOAD(KT_) { const int k0_ = (KT_) << 6; \
    _Pragma("unroll") for (int i = 0; i < 8; ++i) ra[i] = *(const u32x4*)(ap + (size_t)i * 32 * lda + k0_); \
    _Pragma("unroll") for (int i = 0; i < 4; ++i) rb[i] = *(const u32x4*)(bp + (size_t)i * 32 * ldb + k0_); }
#define SSTORE() { _Pragma("unroll") for (int i = 0; i < 8; ++i) *(u32x4*)(sa + 32 * i * 64) = ra[i]; \
    _Pragma("unroll") for (int i = 0; i < 4; ++i) *(u32x4*)(sb + 32 * i * 64) = rb[i]; }
#define FRAGS(RS) { _Pragma("unroll") for (int t = 0; t < 8; ++t) fa[t] = *(const bf16x8*)(Ard + t * 16 * 64 + (RS)); \
    _Pragma("unroll") for (int t = 0; t < 4; ++t) fb[t] = *(const bf16x8*)(Brd + t * 16 * 64 + (RS)); }
#define MMA() _Pragma("unroll") for (int mt = 0; mt < 8; ++mt) _Pragma("unroll") for (int nt = 0; nt < 4; ++nt) \
      acc[mt][nt] = SWAP ? mfma16(fb[nt], fa[mt], acc[mt][nt]) : mfma16(fa[mt], fb[nt], acc[mt][nt]);
  const int KT = K >> 6;
  bf16x8 fa[8], fb[4];
  GLOAD(0);
  for (int kt = 0; kt < KT; ++kt) {
    __syncthreads();
    SSTORE();
    __syncthreads();
    GLOAD((kt + 1 < KT ? kt + 1 : KT - 1));
    FRAGS(rs0);
    __builtin_amdgcn_sched_barrier(0);
    MMA();
    __builtin_amdgcn_sched_barrier(0);
    FRAGS(rs1);
    __builtin_amdgcn_sched_barrier(0);
    MMA();
  }
#undef GLOAD
#undef SSTORE
#undef FRAGS
#undef MMA
}

DEVI void zero_acc(f32x4 (&acc)[8][4]) {
#pragma unroll
  for (int i = 0; i < 8; ++i)
#pragma unroll
    for (int k = 0; k < 4; ++k) acc[i][k] = (f32x4){0.f, 0.f, 0.f, 0.f};
}


DEVI int xcd_remap(int l, int total) {
  int q = l >> 3;
  if ((q | 63) < (total >> 3))
    q = (q & ~63) | ((q & 31) << 1) | ((q >> 5) & 1);
  return (l & 7) * (total >> 3) + q;
}
DEVI void patch_tile(int v, int NT, int PN, int& mt, int& nt) {
  const int psz = 4 * PN, p = v / psz, i = v - p * psz, npn = NT / PN;
  const int pm = p / npn, pn = p - pm * npn;
  const int im = i / PN, in = i - im * PN;
  mt = pm * 4 + im;
  nt = pn * PN + in;
}

DEVI void tile_diff_in(const Params& P, int j, int tile, u16* smem) {
  int tm_, tn_; patch_tile(xcd_remap(tile, 1024), 32, 8, tm_, tn_);
  const int m0 = tm_ * 256, n0 = tn_ * 128;
  const int region = n0 >> 10;
  const u16* A = (const u16*)(P.ws + WS_H);
  const u16* B = (const u16*)(P.ws + WS_WDAIN) + (size_t)j * 4096 * 1024;
  f32x4 acc[8][4];
  zero_acc(acc);
  if (region == 2) gemm_core<false>(A, 1024, B, 1024, 1024, m0, n0, smem, acc);
  else gemm_core<true>(A, 1024, B, 1024, 1024, m0, n0, smem, acc);

  const int lane = tidx() & 63, w = tidx() >> 6, wm = w >> 1, wn = w & 1, g = lane >> 4, li = lane & 15;
  const int mb = m0 + wm * 128, nb = n0 + wn * 64;
  const bool isLat = mb >= 4096;
  const int b = mb >> 8, sb = mb & 255, bl = (mb - 4096) >> 10, tb = (mb - 4096) & 1023;
  const float* ropeC = (const float*)(P.ws + WS_ROPE);
  const float* ropeS = ropeC + 1024 * 32;
  if (region == 2) {
    const int cbase = nb - 2048;
    u16* vtc = (u16*)(P.ws + WS_VTCTX);
    u16* vtl = (u16*)(P.ws + WS_VTLATD) + (size_t)j * VTLATD_J;
#pragma unroll
    for (int mt = 0; mt < 8; ++mt) {
      const int r0 = mt * 16 + g * 4;
#pragma unroll
      for (int nt = 0; nt < 4; ++nt) {
        const int col = cbase + nt * 16 + li, h = col >> 7, e = col & 127;
        if (!isLat) {
          const int s = sb + r0;
          float* sv = P.out + OUT_SV + ((size_t)((b * 2 + j) * 256 + s)) * 1024 + col;
#pragma unroll
          for (int jj = 0; jj < 4; ++jj) sv[(size_t)jj * 1024] = acc[mt][nt][jj];
          st_bf4(vtc + ((size_t)((b * 8 + h) * 128 + e)) * 256 + s, acc[mt][nt]);
        } else {
          const int t = tb + r0;
          st_bf4(vtl + ((size_t)((bl * 8 + h) * 128 + e)) * 1280 + t, acc[mt][nt]);
        }
      }
    }
  } else {
    const float qs = 0.125f * LOG2E;
#pragma unroll
    for (int mt = 0; mt < 8; ++mt) {
      const int rl = mt * 16 + li, row = mb + rl;
      if (region <= 1 && isLat) {
        const int t = tb + rl;
#pragma unroll
        for (int nt = 0; nt < 2; ++nt)
          rope4(acc[mt][nt], acc[mt][nt + 2], ropeC + t * 32 + nt * 16 + g * 4, ropeS + t * 32 + nt * 16 + g * 4);
      }
      if (region == 1 && !isLat) {
#pragma unroll
        for (int nt = 0; nt < 4; ++nt)
          st_f4(P.out + OUT_SK + ((size_t)((b * 2 + j) * 256 + sb + rl)) * 1024 + (nb - 1024) + nt * 16 + g * 4, acc[mt][nt]);
      }
      u16* dst;
      if (region == 0) dst = (u16*)(P.ws + WS_Q) + (size_t)row * 1024 + nb;
      else if (region == 1) dst = isLat ? (u16*)(P.ws + WS_KDLAT) + (size_t)j * KDLAT_J + ((size_t)(bl * 1280 + tb + rl)) * 1024 + (nb - 1024)
                                        : (u16*)(P.ws + WS_CTXK) + (size_t)row * 1024 + (nb - 1024);
      else dst = (u16*)(P.ws + WS_G) + (size_t)row * 1024 + (nb - 3072);
#pragma unroll
      for (int np = 0; np < 2; ++np) {
        f32x4 va = acc[mt][2 * np], vb = acc[mt][2 * np + 1];
        if (region == 0) { va *= qs; vb *= qs; }
        else if (region == 3) {
#pragma unroll
          for (int jj = 0; jj < 4; ++jj) { va[jj] = silu(va[jj]); vb[jj] = silu(vb[jj]); }
        }
        st_pair(dst + np * 32, g, va, vb);
      }
    }
  }
}

DEVI void tile_mla_in(const Params& P, int j, int tile, u16* smem) {
  int tm_, tn_; patch_tile(xcd_remap(tile, 448), 14, 7, tm_, tn_);
  const int m0 = tm_ * 256, n0 = tn_ * 128;
  const u16* A = (const u16*)(P.ws + WS_H);
  const u16* B = (const u16*)(P.ws + WS_WMLAIN) + (size_t)j * 1792 * 1024;
  f32x4 acc[8][4];
  zero_acc(acc);
  gemm_core<true>(A, 1024, B, 1024, 1024, m0, n0, smem, acc);

  const int lane = tidx() & 63, w = tidx() >> 6, wm = w >> 1, wn = w & 1, g = lane >> 4, li = lane & 15;
  const int mb = m0 + wm * 128, nb = n0 + wn * 64;
  const bool isLat = mb >= 4096;
  const int b = mb >> 8, sb = mb & 255, bl = (mb - 4096) >> 10, tb = (mb - 4096) & 1023;
  const float* ropeC = (const float*)(P.ws + WS_ROPE);
  const float* ropeS = ropeC + 1024 * 32;
  if (nb >= 1728) return;
#pragma unroll
  for (int mt = 0; mt < 8; ++mt) {
    const int rl = mt * 16 + li, row = mb + rl;
    if (nb < 640) {
      float ss = 0.f;
#pragma unroll
      for (int nt = 0; nt < 4; ++nt)
#pragma unroll
        for (int jj = 0; jj < 4; ++jj) ss += acc[mt][nt][jj] * acc[mt][nt][jj];
      ss += xshfl(ss, 16);
      ss += xshfl(ss, 32);
      if (nb < 384) {
        if (g == 0) ((float*)(P.ws + WS_SSQQ))[row * 8 + (nb >> 6)] = ss;
#pragma unroll
        for (int np = 0; np < 2; ++np)
          st_pair((u16*)(P.ws + WS_QA) + (size_t)row * 384 + nb + np * 32, g, acc[mt][2 * np], acc[mt][2 * np + 1]);
      } else {
        if (g == 0) ((float*)(P.ws + WS_SSQKV))[row * 4 + ((nb - 384) >> 6)] = ss;
        const int arow = isLat ? (4096 + bl * 1280 + tb + rl) : row;
#pragma unroll
        for (int nt = 0; nt < 4; ++nt) {
          const int c2 = nb - 384 + nt * 16 + g * 4;
          if (!isLat) st_f4((float*)(P.ws + WS_KVRAW) + (size_t)row * 256 + c2, acc[mt][nt]);
        }
#pragma unroll
        for (int np = 0; np < 2; ++np)
          st_pair((u16*)(P.ws + WS_CKVA) + (size_t)j * CKVA_J + (size_t)arow * 256 + (nb - 384) + np * 32, g, acc[mt][2 * np], acc[mt][2 * np + 1]);
      }
    } else if (nb == 640) {
      if (isLat) {
        const int t = tb + rl;
#pragma unroll
        for (int nt = 0; nt < 2; ++nt)
          rope4(acc[mt][nt], acc[mt][nt + 2], ropeC + t * 32 + nt * 16 + g * 4, ropeS + t * 32 + nt * 16 + g * 4);
      }
#pragma unroll
      for (int nt = 0; nt < 4; ++nt) {
        const int d = nt * 16 + g * 4;
        if (!isLat) {
          st_f4(P.out + OUT_KPE + ((size_t)((b * 2 + j) * 256 + sb + rl)) * 64 + d, acc[mt][nt]);
          u16* kd = (u16*)(P.ws + WS_CTXK) + ((size_t)(b * 8) * 256 + sb + rl) * 192 + 128 + d;
#pragma unroll
          for (int h = 0; h < 8; ++h) st_bf4(kd + (size_t)h * 256 * 192, acc[mt][nt]);
        } else {
          u16* kd = (u16*)(P.ws + WS_KMLAT) + (size_t)j * KMLAT_J + ((size_t)(bl * 8) * 1280 + tb + rl) * 192 + 128 + d;
#pragma unroll
          for (int h = 0; h < 8; ++h) st_bf4(kd + (size_t)h * 1280 * 192, acc[mt][nt]);
        }
      }
    } else {
#pragma unroll
      for (int np = 0; np < 2; ++np) {
        f32x4 va = acc[mt][2 * np], vb = acc[mt][2 * np + 1];
#pragma unroll
        for (int jj = 0; jj < 4; ++jj) { va[jj] = silu(va[jj]); vb[jj] = silu(vb[jj]); }
        st_pair((u16*)(P.ws + WS_G) + (size_t)row * 1024 + (nb - 704) + np * 32, g, va, vb);
      }
    }
  }
}

DEVI void tile_qb(const Params& P, int j, int tile, u16* smem) {
  int tm_, tn_; patch_tile(xcd_remap(tile, 384), 12, 6, tm_, tn_);
  const int m0 = tm_ * 256, n0 = tn_ * 128;
  const u16* A = (const u16*)(P.ws + WS_QA);
  const u16* B = (const u16*)(P.ws + WS_WQB) + (size_t)j * 1536 * 384;
  f32x4 acc[8][4];
  zero_acc(acc);
  gemm_core<true>(A, 384, B, 384, 384, m0, n0, smem, acc);
  const int lane = tidx() & 63, w = tidx() >> 6, wm = w >> 1, wn = w & 1, g = lane >> 4, li = lane & 15;
  const int mb = m0 + wm * 128, nb = n0 + wn * 64;
  const bool isLat = mb >= 4096;
  const int tb = (mb - 4096) & 1023;
  const float* ropeC = (const float*)(P.ws + WS_ROPE);
  const float* ropeS = ropeC + 1024 * 32;
  const float* ssq = (const float*)(P.ws + WS_SSQQ);
  const bool isRope = (nb % 192) == 128;
  const float qs = 0.07216878364870322f * LOG2E;
#pragma unroll
  for (int mt = 0; mt < 8; ++mt) {
    const int rl = mt * 16 + li, row = mb + rl;
    float ss = 0.f;
#pragma unroll
    for (int i = 0; i < 6; ++i) ss += ssq[row * 8 + i];
    const float r = rsqrtf(ss * (1.f / 384.f) + EPS) * qs;
    if (isRope && isLat) {
      const int t = tb + rl;
#pragma unroll
      for (int nt = 0; nt < 2; ++nt)
        rope4(acc[mt][nt], acc[mt][nt + 2], ropeC + t * 32 + nt * 16 + g * 4, ropeS + t * 32 + nt * 16 + g * 4);
    }
#pragma unroll
    for (int np = 0; np < 2; ++np)
      st_pair((u16*)(P.ws + WS_Q) + (size_t)row * 1536 + nb + np * 32, g, acc[mt][2 * np] * r, acc[mt][2 * np + 1] * r);
  }
}

DEVI void tile_kvb(const Params& P, int j, int tile, u16* smem) {
  int tm_, tn_; patch_tile(xcd_remap(tile, 576), 16, 8, tm_, tn_);
  const int m0 = tm_ * 256, n0 = tn_ * 128;
  const bool tileLat = m0 >= 4096;
  const bool fresh = !tileLat || ((m0 - 4096) % 1280) < 1024;
  const u16* A = (const u16*)(P.ws + WS_CKVA) + (size_t)j * CKVA_J;
  const u16* B = (const u16*)(P.ws + (fresh ? WS_WKVBG : WS_WKVB)) + (size_t)j * 2048 * 256;
  const bool isV = (n0 >> 7) & 1;
  const int h = n0 >> 8;
  f32x4 acc[8][4];
  zero_acc(acc);
  if (isV) gemm_core<false>(A, 256, B, 256, 256, m0, n0, smem, acc);
  else gemm_core<true>(A, 256, B, 256, 256, m0, n0, smem, acc);
  const int lane = tidx() & 63, w = tidx() >> 6, wm = w >> 1, wn = w & 1, g = lane >> 4, li = lane & 15;
  const int mb = m0 + wm * 128;
  int b, keyb, Sk, tokb;
  u16 *Kd, *Vd;
  if (!tileLat) {
    b = mb >> 8; keyb = mb & 255; Sk = 256; tokb = mb;
    Kd = (u16*)(P.ws + WS_CTXK); Vd = (u16*)(P.ws + WS_VTCTX);
  } else {
    const int r2 = mb - 4096;
    b = r2 / 1280; keyb = r2 % 1280; Sk = 1280; tokb = 4096 + b * 1024 + keyb;
    Kd = (u16*)(P.ws + WS_KMLAT) + (size_t)j * KMLAT_J; Vd = (u16*)(P.ws + WS_VTLATM);
  }
  const float* ssq = (const float*)(P.ws + WS_SSQKV);
  if (!isV) {
#pragma unroll
    for (int mt = 0; mt < 8; ++mt) {
      const int rl = mt * 16 + li;
      float r = 1.f;
      if (fresh) {
        const float4 s4 = *(const float4*)(ssq + (size_t)(tokb + rl) * 4);
        r = rsqrtf((s4.x + s4.y + s4.z + s4.w) * (1.f / 256.f) + EPS);
      }
#pragma unroll
      for (int np = 0; np < 2; ++np)
        st_pair(Kd + ((size_t)((b * 8 + h) * Sk + keyb + rl)) * 192 + wn * 64 + np * 32, g, acc[mt][2 * np] * r, acc[mt][2 * np + 1] * r);
    }
  } else {
#pragma unroll
    for (int mt = 0; mt < 8; ++mt) {
      const int r0 = mt * 16 + g * 4;
      f32x4 rr = {1.f, 1.f, 1.f, 1.f};
      if (fresh) {
#pragma unroll
        for (int jj = 0; jj < 4; ++jj) {
          const float4 s4 = *(const float4*)(ssq + (size_t)(tokb + r0 + jj) * 4);
          rr[jj] = rsqrtf((s4.x + s4.y + s4.z + s4.w) * (1.f / 256.f) + EPS);
        }
      }
#pragma unroll
      for (int nt = 0; nt < 4; ++nt) {
        const int e = wn * 64 + nt * 16 + li;
        st_bf4(Vd + ((size_t)((b * 8 + h) * 128 + e)) * Sk + keyb + r0, acc[mt][nt] * rr);
      }
    }
  }
}

DEVI void tile_out(const Params& P, int layer, int tile, u16* smem) {
  int tm_, tn_; patch_tile(xcd_remap(tile, 256), 8, 8, tm_, tn_);
  const int m0 = tm_ * 256, n0 = tn_ * 128;
  const u16* A = (const u16*)(P.ws + WS_O);
  const u16* B = (const u16*)(P.ws + WS_WOUT) + (size_t)layer * 1024 * 1024;
  f32x4 acc[8][4];
  zero_acc(acc);
  gemm_core<true>(A, 1024, B, 1024, 1024, m0, n0, smem, acc);
  const int lane = tidx() & 63, w = tidx() >> 6, wm = w >> 1, wn = w & 1, g = lane >> 4, li = lane & 15;
  const int mb = m0 + wm * 128, nb = n0 + wn * 64;
  u16* T = (u16*)(P.ws + WS_T);
#pragma unroll
  for (int mt = 0; mt < 8; ++mt)
#pragma unroll
    for (int np = 0; np < 2; ++np)
      st_pair(T + (size_t)(mb + mt * 16 + li) * 1024 + nb + np * 32, g, acc[mt][2 * np], acc[mt][2 * np + 1]);
}

template <bool DIFF>
DEVI void attn_item(const Params& P, const u16* __restrict__ Qb, int ldq, int qrow0,
                    const u16* __restrict__ Kb, int ldk, const u16* __restrict__ Vt, int Sk,
                    int h, float lam, float lam_init, const float* gsub, u16* smem) {
  constexpr int KW = DIFF ? 128 : 192;
  constexpr int KLD = KW + 16;
  constexpr int NKK = DIFF ? 2 : 6;
  constexpr int KT = DIFF ? 64 : 32;
  constexpr int NS = KT / 16;
  constexpr int NU = KT / 32;
  constexpr int KCH = KW / 8;
  constexpr int NKL = (KT * KCH) / 256;
  constexpr int VCH = KT / 8;
  constexpr int NVL = (128 * VCH) / 256;
  constexpr int VLD = KT + 8;
  constexpr int STAGE = KT * KLD + 128 * VLD;
  const int tid = tidx(), lane = tid & 63, w = tid >> 6, g = lane >> 4, li = lane & 15;

  bf16x8 qf[2][NKK];
#pragma unroll
  for (int s = 0; s < 2; ++s) {
    const int qrow = DIFF ? (qrow0 + w * 16 + li) : (qrow0 + w * 32 + s * 16 + li);
    const int qcol = DIFF ? (h * 128 + s * 64) : (h * 192);
#pragma unroll
    for (int kk = 0; kk < NKK; ++kk)
      qf[s][kk] = *(const bf16x8*)(Qb + (size_t)qrow * ldq + qcol + kk * 32 + g * 8);
  }
  f32x4 oacc[2][8];
#pragma unroll
  for (int s = 0; s < 2; ++s)
#pragma unroll
    for (int et = 0; et < 8; ++et) oacc[s][et] = (f32x4){0.f, 0.f, 0.f, 0.f};
  float mrow[2] = {0.f, 0.f}, lrow[2] = {0.f, 0.f};

  u32x4 rk[NKL], rv[NVL];
  auto gload = [&](int key0) {
#pragma unroll
    for (int i = 0; i < NKL; ++i) {
      const int c = tid + 256 * i, r = c / KCH, cc = c % KCH;
      rk[i] = *(const u32x4*)(Kb + (size_t)(key0 + r) * ldk + cc * 8);
    }
#pragma unroll
    for (int i = 0; i < NVL; ++i) {
      const int c = tid + 256 * i, r = c / VCH, cc = c % VCH;
      rv[i] = *(const u32x4*)(Vt + (size_t)r * Sk + key0 + cc * 8);
    }
  };
  auto sstore = [&](int buf) {
    u16* Kw = smem + buf * STAGE;
    u16* Vw = Kw + KT * KLD;
#pragma unroll
    for (int i = 0; i < NKL; ++i) {
      const int c = tid + 256 * i, r = c / KCH, cc = c % KCH;
      *(u32x4*)(Kw + r * KLD + cc * 8) = rk[i];
    }
#pragma unroll
    for (int i = 0; i < NVL; ++i) {
      const int c = tid + 256 * i, r = c / VCH, cc = c % VCH;
      *(u32x4*)(Vw + r * VLD + cc * 8) = rv[i];
    }
  };
  const int NT = Sk / KT;
  gload(0);
  __syncthreads();
  sstore(0);
  gload(NT > 1 ? KT : 0);
  __syncthreads();
  for (int kt0 = 0; kt0 < NT; ++kt0) {
    const u16* Ks = smem + (kt0 & 1) * STAGE;
    const u16* Vs = Ks + KT * KLD;
    if (kt0 + 1 < NT) {
      sstore((kt0 + 1) & 1);
      gload((kt0 + 2 < NT ? kt0 + 2 : NT - 1) * KT);
    }

    f32x4 st[2][NS];
#pragma unroll
    for (int s = 0; s < 2; ++s)
#pragma unroll
      for (int kt = 0; kt < NS; ++kt) { const float ni = -mrow[s]; st[s][kt] = (f32x4){ni, ni, ni, ni}; }
    {
      constexpr int NF = DIFF ? NKK * NS * 2 : NKK * NS;
      auto kaddr = [&](int f) -> const u16* {
        if (DIFF) { const int s2 = f & 1, kt = (f >> 1) % NS, kk = (f >> 1) / NS; return Ks + (kt * 16 + li) * KLD + s2 * 64 + kk * 32 + g * 8; }
        else { const int kt = f % NS, kk = f / NS; return Ks + (kt * 16 + li) * KLD + kk * 32 + g * 8; }
      };
      bf16x8 kf[3];
      kf[0] = *(const bf16x8*)kaddr(0);
      kf[1] = *(const bf16x8*)kaddr(1);
#pragma unroll
      for (int f = 0; f < NF; ++f) {
        if (f + 2 < NF) kf[(f + 2) % 3] = *(const bf16x8*)kaddr(f + 2);
        __builtin_amdgcn_sched_barrier(0);
        if (DIFF) {
          const int s2 = f & 1, kt = (f >> 1) % NS, kk = (f >> 1) / NS;
          st[s2][kt] = mfma16(kf[f % 3], qf[s2][kk], st[s2][kt]);
        } else {
          const int kt = f % NS, kk = f / NS;
          st[0][kt] = mfma16(kf[f % 3], qf[0][kk], st[0][kt]);
          st[1][kt] = mfma16(kf[f % 3], qf[1][kk], st[1][kt]);
        }
        __builtin_amdgcn_sched_barrier(0);
      }
    }
    bf16x8 pf[2][NU];
#pragma unroll
    for (int s = 0; s < 2; ++s) {
      float mx = st[s][0][0];
#pragma unroll
      for (int kt = 0; kt < NS; ++kt)
#pragma unroll
        for (int jj = 0; jj < 4; ++jj) mx = fmaxf(mx, st[s][kt][jj]);
      mx = fmaxf(mx, xshfl(mx, 16));
      mx = fmaxf(mx, xshfl(mx, 32));
      const bool first = (kt0 == 0);
      const bool need = first || (mx > 8.f);
      if (__builtin_amdgcn_ballot_w64(need) != 0ull) {
        const float d = need ? mx : 0.f;
        mrow[s] += d;
        if (!first) {
          const float alpha = __builtin_amdgcn_exp2f(-d);
          lrow[s] *= alpha;
#pragma unroll
          for (int et = 0; et < 8; ++et) oacc[s][et] *= alpha;
        }
#pragma unroll
        for (int kt = 0; kt < NS; ++kt) st[s][kt] -= d;
      }
      float ps = 0.f;
#pragma unroll
      for (int kt = 0; kt < NS; ++kt)
#pragma unroll
        for (int jj = 0; jj < 4; ++jj) {
          const float p = __builtin_amdgcn_exp2f(st[s][kt][jj]);
          st[s][kt][jj] = p;
          ps += p;
        }
      lrow[s] += ps;
#pragma unroll
      for (int u = 0; u < NU; ++u) {
        union { bf16x8 v; unsigned d[4]; } pu;
        pu.d[0] = pk2(st[s][2 * u][0], st[s][2 * u][1]);
        pu.d[1] = pk2(st[s][2 * u][2], st[s][2 * u][3]);
        pu.d[2] = pk2(st[s][2 * u + 1][0], st[s][2 * u + 1][1]);
        pu.d[3] = pk2(st[s][2 * u + 1][2], st[s][2 * u + 1][3]);
        pf[s][u] = pu.v;
      }
    }
    {
      constexpr int NF = NU * 8;
      union VU { bf16x8 v; u32x2 d[2]; };
      VU vf[3];
      auto vload = [&](VU& o, int f) {
        const int u = f >> 3, et = f & 7;
        o.d[0] = *(const u32x2*)(Vs + (et * 16 + li) * VLD + (2 * u) * 16 + g * 4);
        o.d[1] = *(const u32x2*)(Vs + (et * 16 + li) * VLD + (2 * u + 1) * 16 + g * 4);
      };
      vload(vf[0], 0);
      vload(vf[1], 1);
#pragma unroll
      for (int f = 0; f < NF; ++f) {
        if (f + 2 < NF) vload(vf[(f + 2) % 3], f + 2);
        __builtin_amdgcn_sched_barrier(0);
        const int u = f >> 3, et = f & 7;
        oacc[0][et] = mfma16(vf[f % 3].v, pf[0][u], oacc[0][et]);
        oacc[1][et] = mfma16(vf[f % 3].v, pf[1][u], oacc[1][et]);
        __builtin_amdgcn_sched_barrier(0);
      }
    }
    __syncthreads();
  }
#pragma unroll
  for (int s = 0; s < 2; ++s) {
    lrow[s] += xshfl(lrow[s], 16);
    lrow[s] += xshfl(lrow[s], 32);
  }
  const u16* G = (const u16*)(P.ws + WS_G);
  u16* O = (u16*)(P.ws + WS_O);
  if (DIFF) {
    const float i0 = 1.f / lrow[0], i1 = lam / lrow[1];
    float ss = 0.f;
#pragma unroll
    for (int et = 0; et < 8; ++et) {
      oacc[0][et] = oacc[0][et] * i0 - oacc[1][et] * i1;
#pragma unroll
      for (int jj = 0; jj < 4; ++jj) ss += oacc[0][et][jj] * oacc[0][et][jj];
    }
    ss += xshfl(ss, 16);
    ss += xshfl(ss, 32);
    const float rr = rsqrtf(ss * (1.f / 128.f) + EPS) * (1.f - lam_init);
    const size_t tok = (size_t)(qrow0 + w * 16 + li);
#pragma unroll
    for (int et = 0; et < 8; ++et) {
      const int e = et * 16 + g * 4;
      const float4 gs = *(const float4*)(gsub + e);
      const uint2 gg = *(const uint2*)(G + tok * 1024 + h * 128 + e);
      f32x4 v = oacc[0][et] * rr;
      v[0] *= gs.x * bf2f(gg.x & 0xffffu);
      v[1] *= gs.y * bf2f(gg.x >> 16);
      v[2] *= gs.z * bf2f(gg.y & 0xffffu);
      v[3] *= gs.w * bf2f(gg.y >> 16);
      st_bf4(O + tok * 1024 + h * 128 + e, v);
    }
  } else {
#pragma unroll
    for (int s = 0; s < 2; ++s) {
      const float inv = 1.f / lrow[s];
      const size_t tok = (size_t)(qrow0 + w * 32 + s * 16 + li);
#pragma unroll
      for (int et = 0; et < 8; ++et) {
        const int e = et * 16 + g * 4;
        const uint2 gg = *(const uint2*)(G + tok * 1024 + h * 128 + e);
        f32x4 v = oacc[s][et] * inv;
        v[0] *= bf2f(gg.x & 0xffffu);
        v[1] *= bf2f(gg.x >> 16);
        v[2] *= bf2f(gg.y & 0xffffu);
        v[3] *= bf2f(gg.y >> 16);
        st_bf4(O + tok * 1024 + h * 128 + e, v);
      }
    }
  }
}

DEVI void attn_diff_phase(const Params& P, int j, u16* smem) {
  const float* lamv = (const float*)(P.ws + WS_MISC);
  const float lam = lamv[j * 2], lam_init = lamv[j * 2 + 1];
  const float* gsub = P.in[I_GSUB] + j * 128;
  const u16* Q = (const u16*)(P.ws + WS_Q);
  for (int it = blockIdx.x; it < 1024; it += gridDim.x) {
    if (it < 512) {
      const int iv = xcd_remap(it, 512);
      const int bl = iv >> 7, h = (iv >> 4) & 7, qt = iv & 15;
      const u16* Kb = (const u16*)(P.ws + WS_KDLAT) + (size_t)j * KDLAT_J + (size_t)bl * 1280 * 1024 + h * 128;
      const u16* Vt = (const u16*)(P.ws + WS_VTLATD) + (size_t)j * VTLATD_J + (size_t)(bl * 8 + h) * 128 * 1280;
      attn_item<true>(P, Q, 1024, 4096 + bl * 1024 + qt * 64, Kb, 1024, Vt, 1280, h, lam, lam_init, gsub, smem);
    } else {
      const int i2 = xcd_remap(it - 512, 512), b = i2 >> 5, h = (i2 >> 2) & 7, qt = i2 & 3;
      const u16* Kb = (const u16*)(P.ws + WS_CTXK) + (size_t)b * 256 * 1024 + h * 128;
      const u16* Vt = (const u16*)(P.ws + WS_VTCTX) + (size_t)(b * 8 + h) * 128 * 256;
      attn_item<true>(P, Q, 1024, b * 256 + qt * 64, Kb, 1024, Vt, 256, h, lam, lam_init, gsub, smem);
    }
  }
}

DEVI void attn_mla_phase(const Params& P, int j, u16* smem) {
  const u16* Q = (const u16*)(P.ws + WS_Q);
  for (int it = blockIdx.x; it < 512; it += gridDim.x) {
    if (it < 256) {
      const int iv = xcd_remap(it, 256);
      const int bl = iv >> 6, h = (iv >> 3) & 7, qt = iv & 7;
      const u16* Kb = (const u16*)(P.ws + WS_KMLAT) + (size_t)j * KMLAT_J + (size_t)(bl * 8 + h) * 1280 * 192;
      const u16* Vt = (const u16*)(P.ws + WS_VTLATM) + (size_t)(bl * 8 + h) * 128 * 1280;
      attn_item<false>(P, Q, 1536, 4096 + bl * 1024 + qt * 128, Kb, 192, Vt, 1280, h, 0.f, 0.f, nullptr, smem);
    } else {
      const int i2 = xcd_remap(it - 256, 256), b = i2 >> 4, h = (i2 >> 1) & 7, qt = i2 & 1;
      const u16* Kb = (const u16*)(P.ws + WS_CTXK) + (size_t)(b * 8 + h) * 256 * 192;
      const u16* Vt = (const u16*)(P.ws + WS_VTCTX) + (size_t)(b * 8 + h) * 128 * 256;
      attn_item<false>(P, Q, 1536, b * 256 + qt * 128, Kb, 192, Vt, 256, h, 0.f, 0.f, nullptr, smem);
    }
  }
}

DEVI float wave_sum(float v) {
  v += xshfl(v, 1); v += xshfl(v, 2); v += xshfl(v, 4); v += xshfl(v, 8); v += xshfl(v, 16); v += xshfl(v, 32);
  return v;
}

DEVI void ew_phase(const Params& P, int layer) {
  const int lane = tidx() & 63, w = tidx() >> 6;
  const float* ada = (const float*)(P.ws + WS_ADA);
  const u16* T = (const u16*)(P.ws + WS_T);
  u16* H = (u16*)(P.ws + WS_H);
  const int nl = layer + 1;
  for (int r0 = blockIdx.x * 4 + w; r0 < 4096; r0 += gridDim.x * 4) {
    float4 x[2][4], t[2][4];
#pragma unroll
    for (int q = 0; q < 2; ++q) {
      const int row = r0 + q * 4096;
      const float* xsrc = (layer <= 0) ? (q == 0 ? P.in[I_XP] + (size_t)row * 1024 : P.in[I_XS] + (size_t)(row - 4096) * 1024)
                                       : P.out + OUT_Y + (size_t)row * 1024;
#pragma unroll
      for (int i = 0; i < 4; ++i) x[q][i] = *(const float4*)(xsrc + lane * 4 + i * 256);
      if (layer >= 0) {
#pragma unroll
        for (int i = 0; i < 4; ++i) {
          const u32x2 tv = *(const u32x2*)(T + (size_t)row * 1024 + lane * 4 + i * 256);
          t[q][i] = make_float4(bf2f(tv[0] & 0xffffu), bf2f(tv[0] >> 16), bf2f(tv[1] & 0xffffu), bf2f(tv[1] >> 16));
        }
      }
    }
#pragma unroll
    for (int q = 0; q < 2; ++q) {
      const int row = r0 + q * 4096;
      const int cond = q == 0 ? 0 : 1 + (r0 >> 10);
      if (layer >= 0) {
        float ss = 0.f;
#pragma unroll
        for (int i = 0; i < 4; ++i)
          ss += t[q][i].x * t[q][i].x + t[q][i].y * t[q][i].y + t[q][i].z * t[q][i].z + t[q][i].w * t[q][i].w;
        ss = wave_sum(ss);
        const float rt = rsqrtf(ss * (1.f / 1024.f) + EPS);
        const float* gate = ada + (size_t)(layer * 5 + cond) * 3072 + 2048;
        const float* gp = P.in[I_GPOST] + layer * 1024;
#pragma unroll
        for (int i = 0; i < 4; ++i) {
          const int c = lane * 4 + i * 256;
          const float4 ga = *(const float4*)(gate + c);
          const float4 gq = *(const float4*)(gp + c);
          x[q][i].x += ga.x * (t[q][i].x * rt * gq.x);
          x[q][i].y += ga.y * (t[q][i].y * rt * gq.y);
          x[q][i].z += ga.z * (t[q][i].z * rt * gq.z);
          x[q][i].w += ga.w * (t[q][i].w * rt * gq.w);
          *(float4*)(P.out + OUT_Y + (size_t)row * 1024 + c) = x[q][i];
        }
      }
      if (nl < 4) {
        float ss = 0.f;
#pragma unroll
        for (int i = 0; i < 4; ++i)
          ss += x[q][i].x * x[q][i].x + x[q][i].y * x[q][i].y + x[q][i].z * x[q][i].z + x[q][i].w * x[q][i].w;
        ss = wave_sum(ss);
        const float rx = rsqrtf(ss * (1.f / 1024.f) + EPS);
        const float* sh = ada + (size_t)(nl * 5 + cond) * 3072;
        const float* sc = sh + 1024;
        const float* gpre = P.in[I_GPRE] + nl * 1024;
#pragma unroll
        for (int i = 0; i < 4; ++i) {
          const int c = lane * 4 + i * 256;
          const float4 s1 = *(const float4*)(sh + c);
          const float4 s2 = *(const float4*)(sc + c);
          const float4 gq = *(const float4*)(gpre + c);
          f32x4 hv;
          hv[0] = x[q][i].x * rx * gq.x * (1.f + s2.x) + s1.x;
          hv[1] = x[q][i].y * rx * gq.y * (1.f + s2.y) + s1.y;
          hv[2] = x[q][i].z * rx * gq.z * (1.f + s2.z) + s1.z;
          hv[3] = x[q][i].w * rx * gq.w * (1.f + s2.w) + s1.w;
          st_bf4(H + (size_t)row * 1024 + c, hv);
        }
      }
    }
  }
}

DEVI void tr_tile(const float* __restrict__ src, int lds, int k0, int n0, int nvalid, u16* __restrict__ dst, int ldd,
                  const float* kscale, float* tile) {
  const int tid = tidx();
  float4 v[4];
#pragma unroll
  for (int i = 0; i < 4; ++i) {
    const int idx = tid + 256 * i, kk = idx >> 4, c4 = (idx & 15) * 4;
    v[i] = (n0 + c4 < nvalid) ? *(const float4*)(src + (size_t)(k0 + kk) * lds + n0 + c4) : make_float4(0.f, 0.f, 0.f, 0.f);
    if (kscale) { const float ks = kscale[k0 + kk]; v[i].x *= ks; v[i].y *= ks; v[i].z *= ks; v[i].w *= ks; }
  }
  __syncthreads();
#pragma unroll
  for (int i = 0; i < 4; ++i) {
    const int idx = tid + 256 * i, kk = idx >> 4, c4 = (idx & 15) * 4;
    float* tp = tile + kk * 65 + c4;
    tp[0] = v[i].x; tp[1] = v[i].y; tp[2] = v[i].z; tp[3] = v[i].w;
  }
  __syncthreads();
#pragma unroll
  for (int i = 0; i < 2; ++i) {
    const int c = tid + 256 * i, nn = c >> 3, kc = (c & 7) * 8;
    const float* tp = tile + kc * 65 + nn;
    u32x4 u;
    u[0] = pk2(tp[0], tp[65]); u[1] = pk2(tp[2 * 65], tp[3 * 65]); u[2] = pk2(tp[4 * 65], tp[5 * 65]); u[3] = pk2(tp[6 * 65], tp[7 * 65]);
    *(u32x4*)(dst + (size_t)(n0 + nn) * ldd + k0 + kc) = u;
  }
}

constexpr int N_ADA = 384;
constexpr int N_TWOUT = 1024, N_TDAIN = 2048, N_TMLAIN = 896, N_TQB = 288, N_TKVB = 256, N_TCV = 512;
constexpr int N_ROPE = 128, N_LAM = 1, N_CDK = 1024, N_CCKV = 256, N_CKPE = 64;
constexpr int P0_ITEMS = N_ADA + N_TWOUT + N_TDAIN + N_TMLAIN + N_TQB + N_TKVB + N_TCV + N_ROPE + N_LAM + N_CDK + N_CCKV + N_CKPE;

constexpr int PI_A = N_ADA, PI_D = PI_A + N_TWOUT, PI_M = PI_D + N_TDAIN, PI_Q = PI_M + N_TMLAIN, PI_K = PI_Q + N_TQB, PI_C = PI_K + N_TKVB;
DEVI int prep_map(int set, int n) {
  int lo[4], hi[4];
  if (set == 0)      { lo[0] = 0;          hi[0] = PI_A;        lo[1] = PI_A;       hi[1] = PI_A + 256;  lo[2] = PI_D;        hi[2] = PI_D + 1024; lo[3] = PI_C;       hi[3] = P0_ITEMS; }
  else if (set == 1) { lo[0] = PI_M;       hi[0] = PI_M + 448;  lo[1] = PI_Q;       hi[1] = PI_Q + 144;  lo[2] = PI_K;        hi[2] = PI_K + 128;  lo[3] = PI_A + 256; hi[3] = PI_A + 512; }
  else if (set == 2) { lo[0] = PI_D + 1024; hi[0] = PI_D + 2048; lo[1] = PI_A + 512; hi[1] = PI_A + 768;  lo[2] = 0;           hi[2] = 0;           lo[3] = 0;          hi[3] = 0; }
  else               { lo[0] = PI_M + 448; hi[0] = PI_M + 896;  lo[1] = PI_Q + 144; hi[1] = PI_Q + 288;  lo[2] = PI_K + 128;  hi[2] = PI_K + 256;  lo[3] = PI_A + 768; hi[3] = PI_A + 1024; }
#pragma unroll
  for (int r = 0; r < 4; ++r) {
    const int c = hi[r] - lo[r];
    if (n < c) return lo[r] + n;
    n -= c;
  }
  return -1;
}

DEVI void prep_phase(const Params& P, u16* smem, int set, int bid, int nb) {
  float* fs = (float*)smem;
  const int tid = tidx();
  for (int n = bid; ; n += nb) {
    const int item = prep_map(set, n);
    if (item < 0) break;
    int it = item;
    if (it < N_ADA) {
      const int layer = it / 96, r96 = it % 96, cgp = r96 >> 3, ks = r96 & 7;
      float* sc = fs;
      float* red = fs + 640;
      __syncthreads();
      for (int idx = tid; idx < 640; idx += 256) {
        const int cnd = idx >> 7, k = ks * 128 + (idx & 127);
        const float v = cnd == 0 ? P.in[I_CCTX][k] : P.in[I_C][(cnd - 1) * 1024 + k];
        sc[idx] = silu(v);
      }
      __syncthreads();
      const int c4 = tid & 63, wv_ = tid >> 6;
      const float* wp = P.in[I_WADA] + (size_t)layer * 1024 * 3072 + (size_t)(ks * 128 + wv_ * 32) * 3072 + cgp * 256 + c4 * 4;
      float a[5][4];
#pragma unroll
      for (int c = 0; c < 5; ++c)
#pragma unroll
        for (int q = 0; q < 4; ++q) a[c][q] = 0.f;
#pragma unroll 8
      for (int i = 0; i < 32; ++i) {
        const float4 wv = *(const float4*)(wp + (size_t)i * 3072);
#pragma unroll
        for (int c = 0; c < 5; ++c) {
          const float sv = sc[c * 128 + wv_ * 32 + i];
          a[c][0] += sv * wv.x; a[c][1] += sv * wv.y; a[c][2] += sv * wv.z; a[c][3] += sv * wv.w;
        }
      }
#pragma unroll
      for (int c = 0; c < 5; ++c)
#pragma unroll
        for (int q = 0; q < 4; ++q) red[(wv_ * 5 + c) * 256 + c4 * 4 + q] = a[c][q];
      __syncthreads();
      float* part = (float*)(P.ws + WS_ADAP) + (size_t)((layer * 12 + cgp) * 8) * 1280;
#pragma unroll
      for (int c = 0; c < 5; ++c) {
        const float v = ((red[(0 * 5 + c) * 256 + tid] + red[(1 * 5 + c) * 256 + tid]) + red[(2 * 5 + c) * 256 + tid]) + red[(3 * 5 + c) * 256 + tid];
        part[(size_t)ks * 1280 + c * 256 + tid] = v;
      }
      continue;
    }
    it -= N_ADA;
    if (it < N_TWOUT) {
      const int l = it >> 8, kt = (it >> 4) & 15, nt = it & 15;
      tr_tile(P.in[I_WOUT] + (size_t)l * 1024 * 1024, 1024, kt * 64, nt * 64, 1024,
              (u16*)(P.ws + WS_WOUT) + (size_t)l * 1024 * 1024, 1024, nullptr, fs);
      continue;
    }
    it -= N_TWOUT;
    if (it < N_TDAIN) {
      const int l = it >> 10, kt = (it >> 6) & 15, nt = it & 63;
      tr_tile(P.in[I_DAWIN] + (size_t)l * 1024 * 4096, 4096, kt * 64, nt * 64, 4096,
              (u16*)(P.ws + WS_WDAIN) + (size_t)l * 4096 * 1024, 1024, nullptr, fs);
      continue;
    }
    it -= N_TDAIN;
    if (it < N_TMLAIN) {
      const int l = it / 448, r = it % 448, kt = r / 28, nt = r % 28;
      tr_tile(P.in[I_MWIN] + (size_t)l * 1024 * 1728, 1728, kt * 64, nt * 64, 1728,
              (u16*)(P.ws + WS_WMLAIN) + (size_t)l * 1792 * 1024, 1024, nullptr, fs);
      continue;
    }
    it -= N_TMLAIN;
    if (it < N_TQB) {
      const int l = it / 144, r = it % 144, kt = r / 24, nt = r % 24;
      tr_tile(P.in[I_WQB] + (size_t)l * 384 * 1536, 1536, kt * 64, nt * 64, 1536,
              (u16*)(P.ws + WS_WQB) + (size_t)l * 1536 * 384, 384, P.in[I_GQA] + l * 384, fs);
      continue;
    }
    it -= N_TQB;
    if (it < N_TKVB) {
      const int l = it >> 7, kt = (it >> 5) & 3, nt = it & 31;
      tr_tile(P.in[I_WKVB] + (size_t)l * 256 * 2048, 2048, kt * 64, nt * 64, 2048,
              (u16*)(P.ws + WS_WKVB) + (size_t)l * 2048 * 256, 256, nullptr, fs);
      tr_tile(P.in[I_WKVB] + (size_t)l * 256 * 2048, 2048, kt * 64, nt * 64, 2048,
              (u16*)(P.ws + WS_WKVBG) + (size_t)l * 2048 * 256, 256, P.in[I_GKVA] + l * 256, fs);
      continue;
    }
    it -= N_TKVB;
    if (it < N_TCV) {
      const int grp = it >> 3, sub = it & 7, bl = grp >> 4, jj = (grp >> 3) & 1, h = grp & 7, pt = sub >> 1, et = sub & 1;
      const float* src = P.in[I_CDV] + ((size_t)(bl * 2 + jj) * 256) * 1024 + h * 128;
      u16* dst = (u16*)(P.ws + WS_VTLATD) + (size_t)jj * VTLATD_J + (size_t)(bl * 8 + h) * 128 * 1280 + 1024;
      tr_tile(src, 1024, pt * 64, et * 64, 128, dst, 1280, nullptr, fs);
      continue;
    }
    it -= N_TCV;
    if (it < N_ROPE) {
      const int idx = it * 256 + tid, t = idx >> 5, p = idx & 31, f = p & 15;
      const float inv = exp2f(-(float)f * (13.287712379549449f / 16.f));
      const float pos = (p < 16) ? (float)(t >> 6) : (float)(t & 63);
      float sn, cs;
      sincosf(pos * inv, &sn, &cs);
      float* rc = (float*)(P.ws + WS_ROPE);
      rc[idx] = cs;
      rc[1024 * 32 + idx] = sn;
      continue;
    }
    it -= N_ROPE;
    if (it < N_LAM) {
      if (tid < 2) {
        const int jd = tid;
        float s1 = 0.f, s2 = 0.f;
        for (int d = 0; d < 64; ++d) {
          s1 += P.in[I_LQ1][jd * 64 + d] * P.in[I_LK1][jd * 64 + d];
          s2 += P.in[I_LQ2][jd * 64 + d] * P.in[I_LK2][jd * 64 + d];
        }
        const float li = 0.8f - 0.6f * expf(-0.3f * (float)(2 * jd));
        float* lamv = (float*)(P.ws + WS_MISC);
        lamv[jd * 2] = expf(s1) - expf(s2) + li;
        lamv[jd * 2 + 1] = li;
      }
      continue;
    }
    it -= N_LAM;
    if (it < N_CDK) {
      const size_t e0 = ((size_t)it * 256 + tid) * 8;
      const int col = e0 & 1023, p = (e0 >> 10) & 255, jj = (e0 >> 18) & 1, bl = (int)(e0 >> 19);
      const float4 a = *(const float4*)(P.in[I_CDK] + e0);
      const float4 b = *(const float4*)(P.in[I_CDK] + e0 + 4);
      uint4 u; u.x = pk2(a.x, a.y); u.y = pk2(a.z, a.w); u.z = pk2(b.x, b.y); u.w = pk2(b.z, b.w);
      *(uint4*)((u16*)(P.ws + WS_KDLAT) + (size_t)jj * KDLAT_J + ((size_t)(bl * 1280 + 1024 + p)) * 1024 + col) = u;
      continue;
    }
    it -= N_CDK;
    if (it < N_CCKV) {
      const size_t e0 = ((size_t)it * 256 + tid) * 8;
      const int col = e0 & 255, p = (e0 >> 8) & 255, jj = (e0 >> 16) & 1, bl = (int)(e0 >> 17);
      const float4 a = *(const float4*)(P.in[I_CCKV] + e0);
      const float4 b = *(const float4*)(P.in[I_CCKV] + e0 + 4);
      uint4 u; u.x = pk2(a.x, a.y); u.y = pk2(a.z, a.w); u.z = pk2(b.x, b.y); u.w = pk2(b.z, b.w);
      *(uint4*)((u16*)(P.ws + WS_CKVA) + (size_t)jj * CKVA_J + ((size_t)(4096 + bl * 1280 + 1024 + p)) * 256 + col) = u;
      continue;
    }
    it -= N_CCKV;
    {
      const size_t e0 = ((size_t)it * 256 + tid) * 8;
      const int d = e0 & 63, p = (e0 >> 6) & 255, jj = (e0 >> 14) & 1, bl = (int)(e0 >> 15);
      const float4 a = *(const float4*)(P.in[I_CKPE] + e0);
      const float4 b = *(const float4*)(P.in[I_CKPE] + e0 + 4);
      uint4 u; u.x = pk2(a.x, a.y); u.y = pk2(a.z, a.w); u.z = pk2(b.x, b.y); u.w = pk2(b.z, b.w);
      u16* dst = (u16*)(P.ws + WS_KMLAT) + (size_t)jj * KMLAT_J + ((size_t)(bl * 8) * 1280 + 1024 + p) * 192 + 128 + d;
#pragma unroll
      for (int h = 0; h < 8; ++h) *(uint4*)(dst + (size_t)h * 1280 * 192) = u;
    }
  }
}

DEVI void mla_b_phase(const Params& P, int j, u16* smem) {
  constexpr int NQ = 32 * 12, NKV = 36 * 16, NNORM = 64;
  for (int it = blockIdx.x; it < NKV + NQ + NNORM; it += gridDim.x) {
    if (it < NKV) tile_kvb(P, j, it, smem);
    else if (it < NKV + NQ) tile_qb(P, j, it - NKV, smem);
    else {
      const int lane = tidx() & 63, w = tidx() >> 6;
      const float* ssq = (const float*)(P.ws + WS_SSQKV);
      const float4 gk = *(const float4*)(P.in[I_GKVA] + j * 256 + lane * 4);
      for (int r = w; r < 64; r += 4) {
        const int row = (it - NKV - NQ) * 64 + r;
        const float4 s4 = *(const float4*)(ssq + (size_t)row * 4);
        const float rr = rsqrtf((s4.x + s4.y + s4.z + s4.w) * (1.f / 256.f) + EPS);
        float* p = P.out + OUT_CKV + ((size_t)(((row >> 8) * 2 + j) * 256 + (row & 255))) * 256 + lane * 4;
        float4 v = *(const float4*)((const float*)(P.ws + WS_KVRAW) + (size_t)row * 256 + lane * 4);
        v.x *= rr * gk.x; v.y *= rr * gk.y; v.z *= rr * gk.z; v.w *= rr * gk.w;
        *(float4*)p = v;
      }
    }
  }
}


#define XB_TMO      128
#define XB_XCNT(j)  (256  + 64 * (j))
#define XB_XSUB(j)  (1280 + 64 * (j))
#define XB_XGEN(j)  (2304 + 64 * (j))
#define XB_TOP      3328
#define XB_TOPGEN   3392
#define XCD_BAR_WORDS 3456
#define XB_SPIN_CAP (1u << 22)
#define LAS __attribute__((address_space(3)))
DEVI unsigned xb_ld(unsigned* p) { return __hip_atomic_load(p, __ATOMIC_RELAXED, __HIP_MEMORY_SCOPE_AGENT); }
DEVI unsigned xb_add(unsigned* p, unsigned v) { return __hip_atomic_fetch_add(p, v, __ATOMIC_RELAXED, __HIP_MEMORY_SCOPE_AGENT); }
DEVI unsigned xb_xcc_id() { return (unsigned)__builtin_amdgcn_s_getreg((3 << 11) | 20) & 0xFu; }
#define XB_SPIN(cond, bar) do { unsigned _sp = 0; while (cond) { __builtin_amdgcn_s_sleep(1); \
    if ((++_sp & 255u) == 0u) { if (xb_ld(&(bar)[XB_TMO])) break; if (_sp > XB_SPIN_CAP) { atomicAdd(&(bar)[XB_TMO], 1u); break; } } } } while (0)
struct XcdBarrier { unsigned* bar; unsigned x; volatile LAS unsigned* st; };
DEVI XcdBarrier xcd_barrier_post(unsigned* bar, volatile LAS unsigned* st) {
  XcdBarrier b; b.bar = bar; b.x = xb_xcc_id(); b.st = st;
  if (threadIdx.x == 0) (void)xb_add(&bar[XB_XCNT(b.x)], 1u);
  return b;
}
DEVI void xcd_barrier_complete(unsigned* bar, unsigned x, unsigned& nloc, unsigned& nx) {
  const unsigned G = gridDim.x * gridDim.y * gridDim.z;
  unsigned sum, cnt, mine, sp = 0u;
  for (;;) {
    sum = 0u; cnt = 0u; mine = 0u;
#pragma unroll
    for (unsigned j = 0; j < 16; ++j) { const unsigned c = xb_ld(&bar[XB_XCNT(j)]); sum += c; cnt += (c > 0u) ? 1u : 0u; mine = (j == x) ? c : mine; }
    if (sum == G) break;
    __builtin_amdgcn_s_sleep(1);
    if ((++sp & 255u) == 0u) { if (xb_ld(&bar[XB_TMO])) break; if (sp > XB_SPIN_CAP) { atomicAdd(&bar[XB_TMO], 1u); break; } }
  }
  nloc = mine > 0u ? mine : 1u; nx = cnt > 0u ? cnt : 1u;
}
DEVI void xcd_barrier(const XcdBarrier& b) {
  asm volatile("s_waitcnt vmcnt(0)" ::: "memory");
  __syncthreads();
  if (threadIdx.x == 0) {
    unsigned* bar = b.bar;
    __builtin_amdgcn_s_waitcnt(0);
    unsigned nloc = b.st[0], nx = b.st[1];
    if (nloc == 0u) { xcd_barrier_complete(bar, b.x, nloc, nx); b.st[0] = nloc; b.st[1] = nx; }
    const unsigned old = xb_add(&bar[XB_XSUB(b.x)], 1u);
    const unsigned gen = old / nloc;
    if (old + 1u == (gen + 1u) * nloc) {
      __builtin_amdgcn_fence(__ATOMIC_RELEASE, "agent");
      asm volatile("s_waitcnt vmcnt(0)" ::: "memory");
      const unsigned og = xb_add(&bar[XB_TOP], 1u);
      const unsigned tg = og / nx;
      if (og + 1u == (tg + 1u) * nx) xb_add(&bar[XB_TOPGEN], 1u);
      else XB_SPIN(xb_ld(&bar[XB_TOPGEN]) == tg, bar);
      __builtin_amdgcn_fence(__ATOMIC_ACQUIRE, "agent");
      xb_add(&bar[XB_XGEN(b.x)], 1u);
      asm volatile("s_waitcnt vmcnt(0)" ::: "memory");
    } else {
      XB_SPIN(xb_ld(&bar[XB_XGEN(b.x)]) == gen, bar);
      __builtin_amdgcn_fence(__ATOMIC_ACQUIRE, "agent");
      asm volatile("s_waitcnt vmcnt(0)" ::: "memory");
    }
  }
  __syncthreads();
}

DEVI void ada_reduce_phase(const Params& P) {
  const float* part = (const float*)(P.ws + WS_ADAP);
  float* ada = (float*)(P.ws + WS_ADA);
  for (int i = blockIdx.x * 256 + tidx(); i < 4 * 5 * 768; i += gridDim.x * 256) {
    const int n4 = i % 768, lc = i / 768, c = lc % 5, layer = lc / 5, n = n4 * 4, cgp = n >> 8, col = n & 255;
    float4 sum = *(const float4*)(P.in[I_BADA] + layer * 3072 + n);
    const float* pp = part + (size_t)((layer * 12 + cgp) * 8) * 1280 + c * 256 + col;
#pragma unroll
    for (int q = 0; q < 8; ++q) {
      const float4 v = *(const float4*)(pp + (size_t)q * 1280);
      sum.x += v.x; sum.y += v.y; sum.z += v.z; sum.w += v.w;
    }
    *(float4*)(ada + (size_t)(layer * 5 + c) * 3072 + n) = sum;
  }
}

#ifndef EN
#define EN 0xFF
#endif
DEVI void run_phase(const Params& P, int ph, u16* smem) {
  if (ph == 0) { if (EN & 1) prep_phase(P, smem, 0, blockIdx.x, gridDim.x); return; }
  if (ph == 1) { ada_reduce_phase(P); return; }
  if (ph == 2) { if (EN & 2) ew_phase(P, -1); return; }
  ph -= 1;
  int layer, sub;
  if (ph < 6) { layer = 0; sub = ph - 2; }
  else if (ph < 11) { layer = 1; sub = ph - 6; }
  else if (ph < 15) { layer = 2; sub = ph - 11; }
  else { layer = 3; sub = ph - 15; }
  const int j = layer >> 1;
  if ((layer & 1) == 0) {
    if (sub == 0) { if (EN & 4) for (int t = blockIdx.x; t < 32 * 32; t += gridDim.x) tile_diff_in(P, j, t, smem); }
    else if (sub == 1) { if (EN & 8) attn_diff_phase(P, j, smem); }
    else if (sub == 2) {
      if (EN & 16) for (int t = blockIdx.x; t < 32 * 8; t += gridDim.x) tile_out(P, layer, t, smem);
      const int pset = layer == 0 ? 1 : 3;
      if (gridDim.x >= 512) { if (blockIdx.x >= 256) prep_phase(P, smem, pset, blockIdx.x - 256, gridDim.x - 256); }
      else prep_phase(P, smem, pset, blockIdx.x, gridDim.x);
    }
    else { if (EN & 2) ew_phase(P, layer); }
  } else {
    if (sub == 0) { if (EN & 32) for (int t = blockIdx.x; t < 32 * 14; t += gridDim.x) tile_mla_in(P, j, t, smem); }
    else if (sub == 1) { if (EN & 64) mla_b_phase(P, j, smem); }
    else if (sub == 2) { if (EN & 128) attn_mla_phase(P, j, smem); }
    else if (sub == 3) {
      if (EN & 16) for (int t = blockIdx.x; t < 32 * 8; t += gridDim.x) tile_out(P, layer, t, smem);
      if (layer == 1) {
        if (gridDim.x >= 512) { if (blockIdx.x >= 256) prep_phase(P, smem, 2, blockIdx.x - 256, gridDim.x - 256); }
        else prep_phase(P, smem, 2, blockIdx.x, gridDim.x);
      }
    }
    else { if (EN & 2) ew_phase(P, layer); }
  }
}

constexpr int N_PHASES = 21;

__global__ void __launch_bounds__(256, 2) fwd_megakernel(Params P) {
  __shared__ __attribute__((aligned(16))) u16 smem[SMEM_BYTES / 2];
  __shared__ uint4 xb_words;
  if (threadIdx.x == 0) xb_words = make_uint4(0u, 0u, 0u, 0u);
  __syncthreads();
  XcdBarrier xb = xcd_barrier_post((unsigned*)(P.ws + WS_BAR), (volatile LAS unsigned*)&xb_words);
  for (int ph = P.ph_lo; ph < P.ph_hi; ++ph) {
    Params Pl = P;
    {
      size_t zoff = 0;
      asm volatile("" : "+s"(zoff));
      Pl.ws = P.ws + zoff;
      Pl.out = P.out + zoff;
    }
    run_phase(Pl, ph, smem);
#ifdef REP_MASK
    {
      int kind;
      if (ph == 0) kind = 1; else if (ph == 1) kind = 2;
      else { int layer, sub; if (ph < 6) { layer = 0; sub = ph - 2; } else if (ph < 11) { layer = 1; sub = ph - 6; } else if (ph < 15) { layer = 2; sub = ph - 11; } else { layer = 3; sub = ph - 15; }
        if ((layer & 1) == 0) kind = sub == 0 ? 4 : sub == 1 ? 8 : sub == 2 ? 16 : 2;
        else kind = sub == 0 ? 32 : sub == 1 ? 64 : sub == 2 ? 128 : sub == 3 ? 16 : 2; }
      if (kind & REP_MASK) { xcd_barrier(xb); run_phase(Pl, ph, smem); }
    }
#endif
    if (ph + 1 < P.ph_hi) {
      if (P.ph_hi > 1000) cg::this_grid().sync();
      xcd_barrier(xb);
    }
#ifdef EXTRA_SYNCS
    for (int q = 0; q < EXTRA_SYNCS; ++q) xcd_barrier(xb);
#endif
  }
}

extern "C" void kernel_launch(void* const* d_in, const int* in_sizes, int n_in, void* d_out, int out_size, void* d_ws,
                              size_t ws_size, hipStream_t stream) {
  static int grid_blocks = 0;
  if (!grid_blocks) {
    int dev = 0, cus = 0, per_cu = 0;
    (void)hipGetDevice(&dev);
    (void)hipDeviceGetAttribute(&cus, hipDeviceAttributeMultiprocessorCount, dev);
    (void)hipOccupancyMaxActiveBlocksPerMultiprocessor(&per_cu, fwd_megakernel, 256, 0);
    if (per_cu < 1) per_cu = 1;
    if (per_cu > 2) per_cu = 2;
    grid_blocks = cus * per_cu;
  }
  if (hipMemsetAsync((unsigned char*)d_ws + WS_BAR, 0, 16384, stream) != hipSuccess) { fprintf(stderr, "memset failed\n"); return; }
  Params p{};
  for (int i = 0; i < 24; ++i) p.in[i] = (const float*)d_in[i];
  p.out = (float*)d_out;
  p.ws = (unsigned char*)d_ws;
#if MULTI_LAUNCH
  for (int ph = 0; ph < N_PHASES; ++ph) {
    p.ph_lo = ph; p.ph_hi = ph + 1;
    hipLaunchKernelGGL(fwd_megakernel, dim3(grid_blocks), dim3(256), 0, stream, p);
  }
#else
  p.ph_lo = 0; p.ph_hi = N_PHASES;
  void* args[] = {&p};
  hipError_t e = hipLaunchCooperativeKernel((void*)fwd_megakernel, dim3(grid_blocks), dim3(256), args, 0, stream);
  if (e != hipSuccess) fprintf(stderr, "cooperative launch failed: %s (grid %d)\n", hipGetErrorString(e), grid_blocks);
#endif
}
```

```cpp
#include <hip/hip_runtime.h>
#include <hip/hip_cooperative_groups.h>
#include <cstdio>
namespace cg = cooperative_groups;

#ifndef MULTI_LAUNCH
#define MULTI_LAUNCH 0
#endif

typedef unsigned short u16;
typedef __attribute__((ext_vector_type(8))) short bf16x8;
typedef __attribute__((ext_vector_type(4))) float f32x4;
typedef __attribute__((ext_vector_type(4))) unsigned u32x4;
typedef __attribute__((ext_vector_type(2))) unsigned u32x2;

#define DEVI __device__ __forceinline__

struct Params {
  const float* in[24];
  float* out;
  unsigned char* ws;
  int ph_lo, ph_hi;
};

constexpr size_t MBy = 1u << 20;
constexpr size_t WS_WOUT = 0;
constexpr size_t WS_WDAIN = 8 * MBy;
constexpr size_t WS_WMLAIN = 24 * MBy;
constexpr size_t WS_WQB = 31 * MBy;
constexpr size_t WS_WKVB = 34 * MBy;
constexpr size_t WS_WKVBG = 36 * MBy;
constexpr size_t WS_ADA = 38 * MBy;
constexpr size_t WS_ROPE = 39 * MBy;
constexpr size_t WS_MISC = 40 * MBy;
constexpr size_t WS_H = 41 * MBy;
constexpr size_t WS_O = WS_H;
constexpr size_t WS_Q = 57 * MBy;
constexpr size_t WS_T = WS_Q;
constexpr size_t WS_CTXK = 81 * MBy;
constexpr size_t WS_KDLAT = 93 * MBy;
constexpr size_t WS_VTCTX = 113 * MBy;
constexpr size_t WS_VTLATD = 121 * MBy;
constexpr size_t WS_VTLATM = 141 * MBy;
constexpr size_t WS_G = 151 * MBy;
constexpr size_t WS_QA = 167 * MBy;
constexpr size_t WS_CKVA = 173 * MBy;
constexpr size_t WS_SSQQ = 183 * MBy;
constexpr size_t WS_SSQKV = 184 * MBy;
constexpr size_t WS_KMLAT = 185 * MBy;
constexpr size_t WS_KVRAW = 215 * MBy;
constexpr size_t WS_BAR = WS_MISC + 65536;
constexpr size_t WS_ADAP = 219 * MBy;
constexpr size_t KDLAT_J = (size_t)4 * 1280 * 1024;
constexpr size_t VTLATD_J = (size_t)4 * 8 * 128 * 1280;
constexpr size_t CKVA_J = (size_t)9216 * 256;
constexpr size_t KMLAT_J = (size_t)4 * 8 * 1280 * 192;

constexpr size_t OUT_Y = 0;
constexpr size_t OUT_SK = 8388608;
constexpr size_t OUT_SV = 16777216;
constexpr size_t OUT_CKV = 25165824;
constexpr size_t OUT_KPE = 27262976;

constexpr float EPS = 1e-6f;
constexpr float LOG2E = 1.4426950408889634f;

enum { I_XP = 0, I_XS, I_CDK, I_CDV, I_CCKV, I_CKPE, I_C, I_CCTX, I_WADA, I_BADA, I_GPRE, I_GPOST, I_WOUT,
       I_DAWIN, I_LQ1, I_LK1, I_LQ2, I_LK2, I_GSUB, I_MWIN, I_GQA, I_WQB, I_GKVA, I_WKVB };

DEVI int tidx() { int t = threadIdx.x; asm volatile("" : "+v"(t)); return t; }
DEVI u16 f2bf(float f) {
  unsigned u = __float_as_uint(f);
  u += 0x7fffu + ((u >> 16) & 1u);
  return (u16)(u >> 16);
}
typedef __attribute__((ext_vector_type(2))) float f32x2_t;
typedef __attribute__((ext_vector_type(2))) __bf16 bf16x2_t;
DEVI unsigned pk2(float a, float b) {
  f32x2_t v = {a, b};
  bf16x2_t r = __builtin_convertvector(v, bf16x2_t);
  return __builtin_bit_cast(unsigned, r);
}
DEVI float bf2f(unsigned v) { return __uint_as_float(v << 16); }
DEVI void st_bf4(u16* p, f32x4 v) {
  uint2 u; u.x = pk2(v[0], v[1]); u.y = pk2(v[2], v[3]);
  *(uint2*)p = u;
}
DEVI void st_pair(u16* p, int g, f32x4 a, f32x4 b) {
  const bool odd = g & 1;
  f32x4 send, recv;
#pragma unroll
  for (int i = 0; i < 4; ++i) send[i] = odd ? a[i] : b[i];
#pragma unroll
  for (int i = 0; i < 4; ++i) recv[i] = __shfl_xor(send[i], 16, 64);
  f32x4 lo, hi;
#pragma unroll
  for (int i = 0; i < 4; ++i) { lo[i] = odd ? recv[i] : a[i]; hi[i] = odd ? b[i] : recv[i]; }
  u32x4 u;
  u[0] = pk2(lo[0], lo[1]); u[1] = pk2(lo[2], lo[3]); u[2] = pk2(hi[0], hi[1]); u[3] = pk2(hi[2], hi[3]);
  *(u32x4*)(p + (odd ? 16 : 0) + (g >> 1) * 8) = u;
}
DEVI void st_f4(float* p, f32x4 v) { *(float4*)p = make_float4(v[0], v[1], v[2], v[3]); }
DEVI f32x4 mfma16(bf16x8 a, bf16x8 b, f32x4 c) { return __builtin_amdgcn_mfma_f32_16x16x32_bf16(a, b, c, 0, 0, 0); }
DEVI float silu(float x) { return x * __builtin_amdgcn_rcpf(1.f + __builtin_amdgcn_exp2f(-1.4426950408889634f * x)); }
DEVI float xshfl(float v, int m) { return __shfl_xor(v, m, 64); }

DEVI void rope4(f32x4& x1, f32x4& x2, const float* cs, const float* sn) {
  float4 c = *(const float4*)cs; float4 s = *(const float4*)sn;
  f32x4 a = x1, b = x2;
  x1[0] = a[0] * c.x - b[0] * s.x; x2[0] = a[0] * s.x + b[0] * c.x;
  x1[1] = a[1] * c.y - b[1] * s.y; x2[1] = a[1] * s.y + b[1] * c.y;
  x1[2] = a[2] * c.z - b[2] * s.z; x2[2] = a[2] * s.z + b[2] * c.z;
  x1[3] = a[3] * c.w - b[3] * s.w; x2[3] = a[3] * s.w + b[3] * c.w;
}

constexpr int LDT = 64;
constexpr int TILE_ELEMS = 128 * LDT;
constexpr int SMEM_BYTES = 2 * (64 * 144 + 128 * 72) * 2;

template <bool SWAP>
DEVI void gemm_core(const u16* __restrict__ A, int lda, const u16* __restrict__ B, int ldb, int K,
                    int m0, int n0, u16* smem, f32x4 (&acc)[8][4]) {
  const int tid = tidx(), lane = tid & 63, w = tid >> 6;
  const int wm = w >> 1, wn = w & 1;
  const int g = lane >> 4, li = lane & 15;
  u16* As = smem;
  u16* Bs = smem + 256 * 64;
  const int lr = tid >> 3, lc = (tid & 7) * 8;
  const u16* ap = A + (size_t)(m0 + lr) * lda + lc;
  const u16* bp = B + (size_t)(n0 + lr) * ldb + lc;
  const int wsw = (((tid & 7) ^ (lr & 7)) * 8);
  u16* sa = As + lr * 64 + wsw;
  u16* sb = Bs + lr * 64 + wsw;
  const int rs0 = ((g ^ (li & 7)) * 8), rs1 = (((4 + g) ^ (li & 7)) * 8);
  const u16* Ard = As + (wm * 128 + li) * 64;
  const u16* Brd = Bs + (wn * 64 + li) * 64;
  u32x4 ra[8], rb[4];
#define GLOAD(KT_) { const int k0_ = (KT_) << 6; \
    _Pragma("unroll") for (int i = 0; i < 8; ++i) ra[i] = *(const u32x4*)(ap + (size_t)i * 32 * lda + k0_); \
    _Pragma("unroll") for (int i = 0; i < 4; ++i) rb[i] = *(const u32x4*)(bp + (size_t)i * 32 * ldb + k0_); }
#define SSTORE() { _Pragma("unroll") for (int i = 0; i < 8; ++i) *(u32x4*)(sa + 32 * i * 64) = ra[i]; \
    _Pragma("unroll") for (int i = 0; i < 4; ++i) *(u32x4*)(sb + 32 * i * 64) = rb[i]; }
#define FRAGS(RS) { _Pragma("unroll") for (int t = 0; t < 8; ++t) fa[t] = *(const bf16x8*)(Ard + t * 16 * 64 + (RS)); \
    _Pragma("unroll") for (int t = 0; t < 4; ++t) fb[t] = *(const bf16x8*)(Brd + t * 16 * 64 + (RS)); }
#define MMA() _Pragma("unroll") for (int mt = 0; mt < 8; ++mt) _Pragma("unroll") for (int nt = 0; nt < 4; ++nt) \
      acc[mt][nt] = SWAP ? mfma16(fb[nt], fa[mt], acc[mt][nt]) : mfma16(fa[mt], fb[nt], acc[mt][nt]);
  const int KT = K >> 6;
  bf16x8 fa[8], fb[4];
  GLOAD(0);
  for (int kt = 0; kt < KT; ++kt) {
    __syncthreads();
    SSTORE();
    __syncthreads();
    GLOAD((kt + 1 < KT ? kt + 1 : KT - 1));
    FRAGS(rs0);
    __builtin_amdgcn_sched_barrier(0);
    MMA();
    __builtin_amdgcn_sched_barrier(0);
    FRAGS(rs1);
    __builtin_amdgcn_sched_barrier(0);
    MMA();
  }
#undef GLOAD
#undef SSTORE
#undef FRAGS
#undef MMA
}

DEVI void zero_acc(f32x4 (&acc)[8][4]) {
#pragma unroll
  for (int i = 0; i < 8; ++i)
#pragma unroll
    for (int k = 0; k < 4; ++k) acc[i][k] = (f32x4){0.f, 0.f, 0.f, 0.f};
}


DEVI int xcd_remap(int l, int total) {
  int q = l >> 3;
  if ((q | 63) < (total >> 3))
    q = (q & ~63) | ((((q & 63) / 8) >> 1) * 16) | (((q & 63) % 8) << 1) | (((q & 63) / 8) & 1);
  return (l & 7) * (total >> 3) + q;
}
DEVI void patch_tile(int v, int NT, int PN, int& mt, int& nt) {
  const int psz = 4 * PN, p = v / psz, i = v - p * psz, npn = NT / PN;
  const int pm = p / npn, pn = p - pm * npn;
  const int im = i / PN, in = i - im * PN;
  mt = pm * 4 + im;
  nt = pn * PN + in;
}

DEVI void tile_diff_in(const Params& P, int j, int tile, u16* smem) {
  int tm_, tn_; patch_tile(xcd_remap(tile, 1024), 32, 8, tm_, tn_);
  const int m0 = tm_ * 256, n0 = tn_ * 128;
  const int region = n0 >> 10;
  const u16* A = (const u16*)(P.ws + WS_H);
  const u16* B = (const u16*)(P.ws + WS_WDAIN) + (size_t)j * 4096 * 1024;
  f32x4 acc[8][4];
  zero_acc(acc);
  if (region == 2) gemm_core<false>(A, 1024, B, 1024, 1024, m0, n0, smem, acc);
  else gemm_core<true>(A, 1024, B, 1024, 1024, m0, n0, smem, acc);

  const int lane = tidx() & 63, w = tidx() >> 6, wm = w >> 1, wn = w & 1, g = lane >> 4, li = lane & 15;
  const int mb = m0 + wm * 128, nb = n0 + wn * 64;
  const bool isLat = mb >= 4096;
  const int b = mb >> 8, sb = mb & 255, bl = (mb - 4096) >> 10, tb = (mb - 4096) & 1023;
  const float* ropeC = (const float*)(P.ws + WS_ROPE);
  const float* ropeS = ropeC + 1024 * 32;
  if (region == 2) {
    const int cbase = nb - 2048;
    u16* vtc = (u16*)(P.ws + WS_VTCTX);
    u16* vtl = (u16*)(P.ws + WS_VTLATD) + (size_t)j * VTLATD_J;
#pragma unroll
    for (int mt = 0; mt < 8; ++mt) {
      const int r0 = mt * 16 + g * 4;
#pragma unroll
      for (int nt = 0; nt < 4; ++nt) {
        const int col = cbase + nt * 16 + li, h = col >> 7, e = col & 127;
        if (!isLat) {
          const int s = sb + r0;
          float* sv = P.out + OUT_SV + ((size_t)((b * 2 + j) * 256 + s)) * 1024 + col;
#pragma unroll
          for (int jj = 0; jj < 4; ++jj) sv[(size_t)jj * 1024] = acc[mt][nt][jj];
          st_bf4(vtc + ((size_t)((b * 8 + h) * 128 + e)) * 256 + s, acc[mt][nt]);
        } else {
          const int t = tb + r0;
          st_bf4(vtl + ((size_t)((bl * 8 + h) * 128 + e)) * 1280 + t, acc[mt][nt]);
        }
      }
    }
  } else {
    const float qs = 0.125f * LOG2E;
#pragma unroll
    for (int mt = 0; mt < 8; ++mt) {
      const int rl = mt * 16 + li, row = mb + rl;
      if (region <= 1 && isLat) {
        const int t = tb + rl;
#pragma unroll
        for (int nt = 0; nt < 2; ++nt)
          rope4(acc[mt][nt], acc[mt][nt + 2], ropeC + t * 32 + nt * 16 + g * 4, ropeS + t * 32 + nt * 16 + g * 4);
      }
      if (region == 1 && !isLat) {
#pragma unroll
        for (int nt = 0; nt < 4; ++nt)
          st_f4(P.out + OUT_SK + ((size_t)((b * 2 + j) * 256 + sb + rl)) * 1024 + (nb - 1024) + nt * 16 + g * 4, acc[mt][nt]);
      }
      u16* dst;
      if (region == 0) dst = (u16*)(P.ws + WS_Q) + (size_t)row * 1024 + nb;
      else if (region == 1) dst = isLat ? (u16*)(P.ws + WS_KDLAT) + (size_t)j * KDLAT_J + ((size_t)(bl * 1280 + tb + rl)) * 1024 + (nb - 1024)
                                        : (u16*)(P.ws + WS_CTXK) + (size_t)row * 1024 + (nb - 1024);
      else dst = (u16*)(P.ws + WS_G) + (size_t)row * 1024 + (nb - 3072);
#pragma unroll
      for (int np = 0; np < 2; ++np) {
        f32x4 va = acc[mt][2 * np], vb = acc[mt][2 * np + 1];
        if (region == 0) { va *= qs; vb *= qs; }
        else if (region == 3) {
#pragma unroll
          for (int jj = 0; jj < 4; ++jj) { va[jj] = silu(va[jj]); vb[jj] = silu(vb[jj]); }
        }
        st_pair(dst + np * 32, g, va, vb);
      }
    }
  }
}

DEVI void tile_mla_in(const Params& P, int j, int tile, u16* smem) {
  int tm_, tn_; patch_tile(xcd_remap(tile, 448), 14, 7, tm_, tn_);
  const int m0 = tm_ * 256, n0 = tn_ * 128;
  const u16* A = (const u16*)(P.ws + WS_H);
  const u16* B = (const u16*)(P.ws + WS_WMLAIN) + (size_t)j * 1792 * 1024;
  f32x4 acc[8][4];
  zero_acc(acc);
  gemm_core<true>(A, 1024, B, 1024, 1024, m0, n0, smem, acc);

  const int lane = tidx() & 63, w = tidx() >> 6, wm = w >> 1, wn = w & 1, g = lane >> 4, li = lane & 15;
  const int mb = m0 + wm * 128, nb = n0 + wn * 64;
  const bool isLat = mb >= 4096;
  const int b = mb >> 8, sb = mb & 255, bl = (mb - 4096) >> 10, tb = (mb - 4096) & 1023;
  const float* ropeC = (const float*)(P.ws + WS_ROPE);
  const float* ropeS = ropeC + 1024 * 32;
  if (nb >= 1728) return;
#pragma unroll
  for (int mt = 0; mt < 8; ++mt) {
    const int rl = mt * 16 + li, row = mb + rl;
    if (nb < 640) {
      float ss = 0.f;
#pragma unroll
      for (int nt = 0; nt < 4; ++nt)
#pragma unroll
        for (int jj = 0; jj < 4; ++jj) ss += acc[mt][nt][jj] * acc[mt][nt][jj];
      ss += xshfl(ss, 16);
      ss += xshfl(ss, 32);
      if (nb < 384) {
        if (g == 0) ((float*)(P.ws + WS_SSQQ))[row * 8 + (nb >> 6)] = ss;
#pragma unroll
        for (int np = 0; np < 2; ++np)
          st_pair((u16*)(P.ws + WS_QA) + (size_t)row * 384 + nb + np * 32, g, acc[mt][2 * np], acc[mt][2 * np + 1]);
      } else {
        if (g == 0) ((float*)(P.ws + WS_SSQKV))[row * 4 + ((nb - 384) >> 6)] = ss;
        const int arow = isLat ? (4096 + bl * 1280 + tb + rl) : row;
#pragma unroll
        for (int nt = 0; nt < 4; ++nt) {
          const int c2 = nb - 384 + nt * 16 + g * 4;
          if (!isLat) st_f4((float*)(P.ws + WS_KVRAW) + (size_t)row * 256 + c2, acc[mt][nt]);
        }
#pragma unroll
        for (int np = 0; np < 2; ++np)
          st_pair((u16*)(P.ws + WS_CKVA) + (size_t)j * CKVA_J + (size_t)arow * 256 + (nb - 384) + np * 32, g, acc[mt][2 * np], acc[mt][2 * np + 1]);
      }
    } else if (nb == 640) {
      if (isLat) {
        const int t = tb + rl;
#pragma unroll
        for (int nt = 0; nt < 2; ++nt)
          rope4(acc[mt][nt], acc[mt][nt + 2], ropeC + t * 32 + nt * 16 + g * 4, ropeS + t * 32 + nt * 16 + g * 4);
      }
#pragma unroll
      for (int nt = 0; nt < 4; ++nt) {
        const int d = nt * 16 + g * 4;
        if (!isLat) {
          st_f4(P.out + OUT_KPE + ((size_t)((b * 2 + j) * 256 + sb + rl)) * 64 + d, acc[mt][nt]);
          u16* kd = (u16*)(P.ws + WS_CTXK) + ((size_t)(b * 8) * 256 + sb + rl) * 192 + 128 + d;
#pragma unroll
          for (int h = 0; h < 8; ++h) st_bf4(kd + (size_t)h * 256 * 192, acc[mt][nt]);
        } else {
          u16* kd = (u16*)(P.ws + WS_KMLAT) + (size_t)j * KMLAT_J + ((size_t)(bl * 8) * 1280 + tb + rl) * 192 + 128 + d;
#pragma unroll
          for (int h = 0; h < 8; ++h) st_bf4(kd + (size_t)h * 1280 * 192, acc[mt][nt]);
        }
      }
    } else {
#pragma unroll
      for (int np = 0; np < 2; ++np) {
        f32x4 va = acc[mt][2 * np], vb = acc[mt][2 * np + 1];
#pragma unroll
        for (int jj = 0; jj < 4; ++jj) { va[jj] = silu(va[jj]); vb[jj] = silu(vb[jj]); }
        st_pair((u16*)(P.ws + WS_G) + (size_t)row * 1024 + (nb - 704) + np * 32, g, va, vb);
      }
    }
  }
}

DEVI void tile_qb(const Params& P, int j, int tile, u16* smem) {
  int tm_, tn_; patch_tile(xcd_remap(tile, 384), 12, 6, tm_, tn_);
  const int m0 = tm_ * 256, n0 = tn_ * 128;
  const u16* A = (const u16*)(P.ws + WS_QA);
  const u16* B = (const u16*)(P.ws + WS_WQB) + (size_t)j * 1536 * 384;
  f32x4 acc[8][4];
  zero_acc(acc);
  gemm_core<true>(A, 384, B, 384, 384, m0, n0, smem, acc);
  const int lane = tidx() & 63, w = tidx() >> 6, wm = w >> 1, wn = w & 1, g = lane >> 4, li = lane & 15;
  const int mb = m0 + wm * 128, nb = n0 + wn * 64;
  const bool isLat = mb >= 4096;
  const int tb = (mb - 4096) & 1023;
  const float* ropeC = (const float*)(P.ws + WS_ROPE);
  const float* ropeS = ropeC + 1024 * 32;
  const float* ssq = (const float*)(P.ws + WS_SSQQ);
  const bool isRope = (nb % 192) == 128;
  const float qs = 0.07216878364870322f * LOG2E;
#pragma unroll
  for (int mt = 0; mt < 8; ++mt) {
    const int rl = mt * 16 + li, row = mb + rl;
    float ss = 0.f;
#pragma unroll
    for (int i = 0; i < 6; ++i) ss += ssq[row * 8 + i];
    const float r = rsqrtf(ss * (1.f / 384.f) + EPS) * qs;
    if (isRope && isLat) {
      const int t = tb + rl;
#pragma unroll
      for (int nt = 0; nt < 2; ++nt)
        rope4(acc[mt][nt], acc[mt][nt + 2], ropeC + t * 32 + nt * 16 + g * 4, ropeS + t * 32 + nt * 16 + g * 4);
    }
#pragma unroll
    for (int np = 0; np < 2; ++np)
      st_pair((u16*)(P.ws + WS_Q) + (size_t)row * 1536 + nb + np * 32, g, acc[mt][2 * np] * r, acc[mt][2 * np + 1] * r);
  }
}

DEVI void tile_kvb(const Params& P, int j, int tile, u16* smem) {
  int tm_, tn_; patch_tile(xcd_remap(tile, 576), 16, 8, tm_, tn_);
  const int m0 = tm_ * 256, n0 = tn_ * 128;
  const bool tileLat = m0 >= 4096;
  const bool fresh = !tileLat || ((m0 - 4096) % 1280) < 1024;
  const u16* A = (const u16*)(P.ws + WS_CKVA) + (size_t)j * CKVA_J;
  const u16* B = (const u16*)(P.ws + (fresh ? WS_WKVBG : WS_WKVB)) + (size_t)j * 2048 * 256;
  const bool isV = (n0 >> 7) & 1;
  const int h = n0 >> 8;
  f32x4 acc[8][4];
  zero_acc(acc);
  if (isV) gemm_core<false>(A, 256, B, 256, 256, m0, n0, smem, acc);
  else gemm_core<true>(A, 256, B, 256, 256, m0, n0, smem, acc);
  const int lane = tidx() & 63, w = tidx() >> 6, wm = w >> 1, wn = w & 1, g = lane >> 4, li = lane & 15;
  const int mb = m0 + wm * 128;
  int b, keyb, Sk, tokb;
  u16 *Kd, *Vd;
  if (!tileLat) {
    b = mb >> 8; keyb = mb & 255; Sk = 256; tokb = mb;
    Kd = (u16*)(P.ws + WS_CTXK); Vd = (u16*)(P.ws + WS_VTCTX);
  } else {
    const int r2 = mb - 4096;
    b = r2 / 1280; keyb = r2 % 1280; Sk = 1280; tokb = 4096 + b * 1024 + keyb;
    Kd = (u16*)(P.ws + WS_KMLAT) + (size_t)j * KMLAT_J; Vd = (u16*)(P.ws + WS_VTLATM);
  }
  const float* ssq = (const float*)(P.ws + WS_SSQKV);
  if (!isV) {
#pragma unroll
    for (int mt = 0; mt < 8; ++mt) {
      const int rl = mt * 16 + li;
      float r = 1.f;
      if (fresh) {
        const float4 s4 = *(const float4*)(ssq + (size_t)(tokb + rl) * 4);
        r = rsqrtf((s4.x + s4.y + s4.z + s4.w) * (1.f / 256.f) + EPS);
      }
#pragma unroll
      for (int np = 0; np < 2; ++np)
        st_pair(Kd + ((size_t)((b * 8 + h) * Sk + keyb + rl)) * 192 + wn * 64 + np * 32, g, acc[mt][2 * np] * r, acc[mt][2 * np + 1] * r);
    }
  } else {
#pragma unroll
    for (int mt = 0; mt < 8; ++mt) {
      const int r0 = mt * 16 + g * 4;
      f32x4 rr = {1.f, 1.f, 1.f, 1.f};
      if (fresh) {
#pragma unroll
        for (int jj = 0; jj < 4; ++jj) {
          const float4 s4 = *(const float4*)(ssq + (size_t)(tokb + r0 + jj) * 4);
          rr[jj] = rsqrtf((s4.x + s4.y + s4.z + s4.w) * (1.f / 256.f) + EPS);
        }
      }
#pragma unroll
      for (int nt = 0; nt < 4; ++nt) {
        const int e = wn * 64 + nt * 16 + li;
        st_bf4(Vd + ((size_t)((b * 8 + h) * 128 + e)) * Sk + keyb + r0, acc[mt][nt] * rr);
      }
    }
  }
}

DEVI void tile_out(const Params& P, int layer, int tile, u16* smem) {
  int tm_, tn_; patch_tile(xcd_remap(tile, 256), 8, 8, tm_, tn_);
  const int m0 = tm_ * 256, n0 = tn_ * 128;
  const u16* A = (const u16*)(P.ws + WS_O);
  const u16* B = (const u16*)(P.ws + WS_WOUT) + (size_t)layer * 1024 * 1024;
  f32x4 acc[8][4];
  zero_acc(acc);
  gemm_core<true>(A, 1024, B, 1024, 1024, m0, n0, smem, acc);
  const int lane = tidx() & 63, w = tidx() >> 6, wm = w >> 1, wn = w & 1, g = lane >> 4, li = lane & 15;
  const int mb = m0 + wm * 128, nb = n0 + wn * 64;
  u16* T = (u16*)(P.ws + WS_T);
#pragma unroll
  for (int mt = 0; mt < 8; ++mt)
#pragma unroll
    for (int np = 0; np < 2; ++np)
      st_pair(T + (size_t)(mb + mt * 16 + li) * 1024 + nb + np * 32, g, acc[mt][2 * np], acc[mt][2 * np + 1]);
}

template <bool DIFF>
DEVI void attn_item(const Params& P, const u16* __restrict__ Qb, int ldq, int qrow0,
                    const u16* __restrict__ Kb, int ldk, const u16* __restrict__ Vt, int Sk,
                    int h, float lam, float lam_init, const float* gsub, u16* smem) {
  constexpr int KW = DIFF ? 128 : 192;
  constexpr int KLD = KW + 16;
  constexpr int NKK = DIFF ? 2 : 6;
  constexpr int KT = DIFF ? 64 : 32;
  constexpr int NS = KT / 16;
  constexpr int NU = KT / 32;
  constexpr int KCH = KW / 8;
  constexpr int NKL = (KT * KCH) / 256;
  constexpr int VCH = KT / 8;
  constexpr int NVL = (128 * VCH) / 256;
  constexpr int VLD = KT + 8;
  constexpr int STAGE = KT * KLD + 128 * VLD;
  const int tid = tidx(), lane = tid & 63, w = tid >> 6, g = lane >> 4, li = lane & 15;

  bf16x8 qf[2][NKK];
#pragma unroll
  for (int s = 0; s < 2; ++s) {
    const int qrow = DIFF ? (qrow0 + w * 16 + li) : (qrow0 + w * 32 + s * 16 + li);
    const int qcol = DIFF ? (h * 128 + s * 64) : (h * 192);
#pragma unroll
    for (int kk = 0; kk < NKK; ++kk)
      qf[s][kk] = *(const bf16x8*)(Qb + (size_t)qrow * ldq + qcol + kk * 32 + g * 8);
  }
  f32x4 oacc[2][8];
#pragma unroll
  for (int s = 0; s < 2; ++s)
#pragma unroll
    for (int et = 0; et < 8; ++et) oacc[s][et] = (f32x4){0.f, 0.f, 0.f, 0.f};
  float mrow[2] = {0.f, 0.f}, lrow[2] = {0.f, 0.f};

  u32x4 rk[NKL], rv[NVL];
  auto gload = [&](int key0) {
#pragma unroll
    for (int i = 0; i < NKL; ++i) {
      const int c = tid + 256 * i, r = c / KCH, cc = c % KCH;
      rk[i] = *(const u32x4*)(Kb + (size_t)(key0 + r) * ldk + cc * 8);
    }
#pragma unroll
    for (int i = 0; i < NVL; ++i) {
      const int c = tid + 256 * i, r = c / VCH, cc = c % VCH;
      rv[i] = *(const u32x4*)(Vt + (size_t)r * Sk + key0 + cc * 8);
    }
  };
  auto sstore = [&](int buf) {
    u16* Kw = smem + buf * STAGE;
    u16* Vw = Kw + KT * KLD;
#pragma unroll
    for (int i = 0; i < NKL; ++i) {
      const int c = tid + 256 * i, r = c / KCH, cc = c % KCH;
      *(u32x4*)(Kw + r * KLD + cc * 8) = rk[i];
    }
#pragma unroll
    for (int i = 0; i < NVL; ++i) {
      const int c = tid + 256 * i, r = c / VCH, cc = c % VCH;
      *(u32x4*)(Vw + r * VLD + cc * 8) = rv[i];
    }
  };
  const int NT = Sk / KT;
  gload(0);
  __syncthreads();
  sstore(0);
  gload(NT > 1 ? KT : 0);
  __syncthreads();
  for (int kt0 = 0; kt0 < NT; ++kt0) {
    const u16* Ks = smem + (kt0 & 1) * STAGE;
    const u16* Vs = Ks + KT * KLD;
    if (kt0 + 1 < NT) {
      sstore((kt0 + 1) & 1);
      gload((kt0 + 2 < NT ? kt0 + 2 : NT - 1) * KT);
    }

    f32x4 st[2][NS];
#pragma unroll
    for (int s = 0; s < 2; ++s)
#pragma unroll
      for (int kt = 0; kt < NS; ++kt) { const float ni = -mrow[s]; st[s][kt] = (f32x4){ni, ni, ni, ni}; }
    {
      constexpr int NF = DIFF ? NKK * NS * 2 : NKK * NS;
      auto kaddr = [&](int f) -> const u16* {
        if (DIFF) { const int s2 = f & 1, kt = (f >> 1) % NS, kk = (f >> 1) / NS; return Ks + (kt * 16 + li) * KLD + s2 * 64 + kk * 32 + g * 8; }
        else { const int kt = f % NS, kk = f / NS; return Ks + (kt * 16 + li) * KLD + kk * 32 + g * 8; }
      };
      bf16x8 kf[3];
      kf[0] = *(const bf16x8*)kaddr(0);
      kf[1] = *(const bf16x8*)kaddr(1);
#pragma unroll
      for (int f = 0; f < NF; ++f) {
        if (f + 2 < NF) kf[(f + 2) % 3] = *(const bf16x8*)kaddr(f + 2);
        __builtin_amdgcn_sched_barrier(0);
        if (DIFF) {
          const int s2 = f & 1, kt = (f >> 1) % NS, kk = (f >> 1) / NS;
          st[s2][kt] = mfma16(kf[f % 3], qf[s2][kk], st[s2][kt]);
        } else {
          const int kt = f % NS, kk = f / NS;
          st[0][kt] = mfma16(kf[f % 3], qf[0][kk], st[0][kt]);
          st[1][kt] = mfma16(kf[f % 3], qf[1][kk], st[1][kt]);
        }
        __builtin_amdgcn_sched_barrier(0);
      }
    }
    bf16x8 pf[2][NU];
#pragma unroll
    for (int s = 0; s < 2; ++s) {
      float mx = st[s][0][0];
#pragma unroll
      for (int kt = 0; kt < NS; ++kt)
#pragma unroll
        for (int jj = 0; jj < 4; ++jj) mx = fmaxf(mx, st[s][kt][jj]);
      mx = fmaxf(mx, xshfl(mx, 16));
      mx = fmaxf(mx, xshfl(mx, 32));
      const bool first = (kt0 == 0);
      const bool need = first || (mx > 8.f);
      if (__builtin_amdgcn_ballot_w64(need) != 0ull) {
        const float d = need ? mx : 0.f;
        mrow[s] += d;
        if (!first) {
          const float alpha = __builtin_amdgcn_exp2f(-d);
          lrow[s] *= alpha;
#pragma unroll
          for (int et = 0; et < 8; ++et) oacc[s][et] *= alpha;
        }
#pragma unroll
        for (int kt = 0; kt < NS; ++kt) st[s][kt] -= d;
      }
      float ps = 0.f;
#pragma unroll
      for (int kt = 0; kt < NS; ++kt)
#pragma unroll
        for (int jj = 0; jj < 4; ++jj) {
          const float p = __builtin_amdgcn_exp2f(st[s][kt][jj]);
          st[s][kt][jj] = p;
          ps += p;
        }
      lrow[s] += ps;
#pragma unroll
      for (int u = 0; u < NU; ++u) {
        union { bf16x8 v; unsigned d[4]; } pu;
        pu.d[0] = pk2(st[s][2 * u][0], st[s][2 * u][1]);
        pu.d[1] = pk2(st[s][2 * u][2], st[s][2 * u][3]);
        pu.d[2] = pk2(st[s][2 * u + 1][0], st[s][2 * u + 1][1]);
        pu.d[3] = pk2(st[s][2 * u + 1][2], st[s][2 * u + 1][3]);
        pf[s][u] = pu.v;
      }
    }
    {
      constexpr int NF = NU * 8;
      union VU { bf16x8 v; u32x2 d[2]; };
      VU vf[3];
      auto vload = [&](VU& o, int f) {
        const int u = f >> 3, et = f & 7;
        o.d[0] = *(const u32x2*)(Vs + (et * 16 + li) * VLD + (2 * u) * 16 + g * 4);
        o.d[1] = *(const u32x2*)(Vs + (et * 16 + li) * VLD + (2 * u + 1) * 16 + g * 4);
      };
      vload(vf[0], 0);
      vload(vf[1], 1);
#pragma unroll
      for (int f = 0; f < NF; ++f) {
        if (f + 2 < NF) vload(vf[(f + 2) % 3], f + 2);
        __builtin_amdgcn_sched_barrier(0);
        const int u = f >> 3, et = f & 7;
        oacc[0][et] = mfma16(vf[f % 3].v, pf[0][u], oacc[0][et]);
        oacc[1][et] = mfma16(vf[f % 3].v, pf[1][u], oacc[1][et]);
        __builtin_amdgcn_sched_barrier(0);
      }
    }
    __syncthreads();
  }
#pragma unroll
  for (int s = 0; s < 2; ++s) {
    lrow[s] += xshfl(lrow[s], 16);
    lrow[s] += xshfl(lrow[s], 32);
  }
  const u16* G = (const u16*)(P.ws + WS_G);
  u16* O = (u16*)(P.ws + WS_O);
  if (DIFF) {
    const float i0 = 1.f / lrow[0], i1 = lam / lrow[1];
    float ss = 0.f;
#pragma unroll
    for (int et = 0; et < 8; ++et) {
      oacc[0][et] = oacc[0][et] * i0 - oacc[1][et] * i1;
#pragma unroll
      for (int jj = 0; jj < 4; ++jj) ss += oacc[0][et][jj] * oacc[0][et][jj];
    }
    ss += xshfl(ss, 16);
    ss += xshfl(ss, 32);
    const float rr = rsqrtf(ss * (1.f / 128.f) + EPS) * (1.f - lam_init);
    const size_t tok = (size_t)(qrow0 + w * 16 + li);
#pragma unroll
    for (int et = 0; et < 8; ++et) {
      const int e = et * 16 + g * 4;
      const float4 gs = *(const float4*)(gsub + e);
      const uint2 gg = *(const uint2*)(G + tok * 1024 + h * 128 + e);
      f32x4 v = oacc[0][et] * rr;
      v[0] *= gs.x * bf2f(gg.x & 0xffffu);
      v[1] *= gs.y * bf2f(gg.x >> 16);
      v[2] *= gs.z * bf2f(gg.y & 0xffffu);
      v[3] *= gs.w * bf2f(gg.y >> 16);
      st_bf4(O + tok * 1024 + h * 128 + e, v);
    }
  } else {
#pragma unroll
    for (int s = 0; s < 2; ++s) {
      const float inv = 1.f / lrow[s];
      const size_t tok = (size_t)(qrow0 + w * 32 + s * 16 + li);
#pragma unroll
      for (int et = 0; et < 8; ++et) {
        const int e = et * 16 + g * 4;
        const uint2 gg = *(const uint2*)(G + tok * 1024 + h * 128 + e);
        f32x4 v = oacc[s][et] * inv;
        v[0] *= bf2f(gg.x & 0xffffu);
        v[1] *= bf2f(gg.x >> 16);
        v[2] *= bf2f(gg.y & 0xffffu);
        v[3] *= bf2f(gg.y >> 16);
        st_bf4(O + tok * 1024 + h * 128 + e, v);
      }
    }
  }
}

DEVI void attn_diff_phase(const Params& P, int j, u16* smem) {
  const float* lamv = (const float*)(P.ws + WS_MISC);
  const float lam = lamv[j * 2], lam_init = lamv[j * 2 + 1];
  const float* gsub = P.in[I_GSUB] + j * 128;
  const u16* Q = (const u16*)(P.ws + WS_Q);
  for (int it = blockIdx.x; it < 1024; it += gridDim.x) {
    if (it < 512) {
      const int iv = xcd_remap(it, 512);
      const int bl = iv >> 7, h = (iv >> 4) & 7, qt = iv & 15;
      const u16* Kb = (const u16*)(P.ws + WS_KDLAT) + (size_t)j * KDLAT_J + (size_t)bl * 1280 * 1024 + h * 128;
      const u16* Vt = (const u16*)(P.ws + WS_VTLATD) + (size_t)j * VTLATD_J + (size_t)(bl * 8 + h) * 128 * 1280;
      attn_item<true>(P, Q, 1024, 4096 + bl * 1024 + qt * 64, Kb, 1024, Vt, 1280, h, lam, lam_init, gsub, smem);
    } else {
      const int i2 = xcd_remap(it - 512, 512), b = i2 >> 5, h = (i2 >> 2) & 7, qt = i2 & 3;
      const u16* Kb = (const u16*)(P.ws + WS_CTXK) + (size_t)b * 256 * 1024 + h * 128;
      const u16* Vt = (const u16*)(P.ws + WS_VTCTX) + (size_t)(b * 8 + h) * 128 * 256;
      attn_item<true>(P, Q, 1024, b * 256 + qt * 64, Kb, 1024, Vt, 256, h, lam, lam_init, gsub, smem);
    }
  }
}

DEVI void attn_mla_phase(const Params& P, int j, u16* smem) {
  const u16* Q = (const u16*)(P.ws + WS_Q);
  for (int it = blockIdx.x; it < 512; it += gridDim.x) {
    if (it < 256) {
      const int iv = xcd_remap(it, 256);
      const int bl = iv >> 6, h = (iv >> 3) & 7, qt = iv & 7;
      const u16* Kb = (const u16*)(P.ws + WS_KMLAT) + (size_t)j * KMLAT_J + (size_t)(bl * 8 + h) * 1280 * 192;
      const u16* Vt = (const u16*)(P.ws + WS_VTLATM) + (size_t)(bl * 8 + h) * 128 * 1280;
      attn_item<false>(P, Q, 1536, 4096 + bl * 1024 + qt * 128, Kb, 192, Vt, 1280, h, 0.f, 0.f, nullptr, smem);
    } else {
      const int i2 = xcd_remap(it - 256, 256), b = i2 >> 4, h = (i2 >> 1) & 7, qt = i2 & 1;
      const u16* Kb = (const u16*)(P.ws + WS_CTXK) + (size_t)(b * 8 + h) * 256 * 192;
      const u16* Vt = (const u16*)(P.ws + WS_VTCTX) + (size_t)(b * 8 + h) * 128 * 256;
      attn_item<false>(P, Q, 1536, b * 256 + qt * 128, Kb, 192, Vt, 256, h, 0.f, 0.f, nullptr, smem);
    }
  }
}

DEVI float wave_sum(float v) {
  v += xshfl(v, 1); v += xshfl(v, 2); v += xshfl(v, 4); v += xshfl(v, 8); v += xshfl(v, 16); v += xshfl(v, 32);
  return v;
}

DEVI void ew_phase(const Params& P, int layer) {
  const int lane = tidx() & 63, w = tidx() >> 6;
  const float* ada = (const float*)(P.ws + WS_ADA);
  const u16* T = (const u16*)(P.ws + WS_T);
  u16* H = (u16*)(P.ws + WS_H);
  const int nl = layer + 1;
  for (int r0 = blockIdx.x * 4 + w; r0 < 4096; r0 += gridDim.x * 4) {
    float4 x[2][4], t[2][4];
#pragma unroll
    for (int q = 0; q < 2; ++q) {
      const int row = r0 + q * 4096;
      const float* xsrc = (layer <= 0) ? (q == 0 ? P.in[I_XP] + (size_t)row * 1024 : P.in[I_XS] + (size_t)(row - 4096) * 1024)
                                       : P.out + OUT_Y + (size_t)row * 1024;
#pragma unroll
      for (int i = 0; i < 4; ++i) x[q][i] = *(const float4*)(xsrc + lane * 4 + i * 256);
      if (layer >= 0) {
#pragma unroll
        for (int i = 0; i < 4; ++i) {
          const u32x2 tv = *(const u32x2*)(T + (size_t)row * 1024 + lane * 4 + i * 256);
          t[q][i] = make_float4(bf2f(tv[0] & 0xffffu), bf2f(tv[0] >> 16), bf2f(tv[1] & 0xffffu), bf2f(tv[1] >> 16));
        }
      }
    }
#pragma unroll
    for (int q = 0; q < 2; ++q) {
      const int row = r0 + q * 4096;
      const int cond = q == 0 ? 0 : 1 + (r0 >> 10);
      if (layer >= 0) {
        float ss = 0.f;
#pragma unroll
        for (int i = 0; i < 4; ++i)
          ss += t[q][i].x * t[q][i].x + t[q][i].y * t[q][i].y + t[q][i].z * t[q][i].z + t[q][i].w * t[q][i].w;
        ss = wave_sum(ss);
        const float rt = rsqrtf(ss * (1.f / 1024.f) + EPS);
        const float* gate = ada + (size_t)(layer * 5 + cond) * 3072 + 2048;
        const float* gp = P.in[I_GPOST] + layer * 1024;
#pragma unroll
        for (int i = 0; i < 4; ++i) {
          const int c = lane * 4 + i * 256;
          const float4 ga = *(const float4*)(gate + c);
          const float4 gq = *(const float4*)(gp + c);
          x[q][i].x += ga.x * (t[q][i].x * rt * gq.x);
          x[q][i].y += ga.y * (t[q][i].y * rt * gq.y);
          x[q][i].z += ga.z * (t[q][i].z * rt * gq.z);
          x[q][i].w += ga.w * (t[q][i].w * rt * gq.w);
          *(float4*)(P.out + OUT_Y + (size_t)row * 1024 + c) = x[q][i];
        }
      }
      if (nl < 4) {
        float ss = 0.f;
#pragma unroll
        for (int i = 0; i < 4; ++i)
          ss += x[q][i].x * x[q][i].x + x[q][i].y * x[q][i].y + x[q][i].z * x[q][i].z + x[q][i].w * x[q][i].w;
        ss = wave_sum(ss);
        const float rx = rsqrtf(ss * (1.f / 1024.f) + EPS);
        const float* sh = ada + (size_t)(nl * 5 + cond) * 3072;
        const float* sc = sh + 1024;
        const float* gpre = P.in[I_GPRE] + nl * 1024;
#pragma unroll
        for (int i = 0; i < 4; ++i) {
          const int c = lane * 4 + i * 256;
          const float4 s1 = *(const float4*)(sh + c);
          const float4 s2 = *(const float4*)(sc + c);
          const float4 gq = *(const float4*)(gpre + c);
          f32x4 hv;
          hv[0] = x[q][i].x * rx * gq.x * (1.f + s2.x) + s1.x;
          hv[1] = x[q][i].y * rx * gq.y * (1.f + s2.y) + s1.y;
          hv[2] = x[q][i].z * rx * gq.z * (1.f + s2.z) + s1.z;
          hv[3] = x[q][i].w * rx * gq.w * (1.f + s2.w) + s1.w;
          st_bf4(H + (size_t)row * 1024 + c, hv);
        }
      }
    }
  }
}

DEVI void tr_tile(const float* __restrict__ src, int lds, int k0, int n0, int nvalid, u16* __restrict__ dst, int ldd,
                  const float* kscale, float* tile) {
  const int tid = tidx();
  float4 v[4];
#pragma unroll
  for (int i = 0; i < 4; ++i) {
    const int idx = tid + 256 * i, kk = idx >> 4, c4 = (idx & 15) * 4;
    v[i] = (n0 + c4 < nvalid) ? *(const float4*)(src + (size_t)(k0 + kk) * lds + n0 + c4) : make_float4(0.f, 0.f, 0.f, 0.f);
    if (kscale) { const float ks = kscale[k0 + kk]; v[i].x *= ks; v[i].y *= ks; v[i].z *= ks; v[i].w *= ks; }
  }
  __syncthreads();
#pragma unroll
  for (int i = 0; i < 4; ++i) {
    const int idx = tid + 256 * i, kk = idx >> 4, c4 = (idx & 15) * 4;
    float* tp = tile + kk * 65 + c4;
    tp[0] = v[i].x; tp[1] = v[i].y; tp[2] = v[i].z; tp[3] = v[i].w;
  }
  __syncthreads();
#pragma unroll
  for (int i = 0; i < 2; ++i) {
    const int c = tid + 256 * i, nn = c >> 3, kc = (c & 7) * 8;
    const float* tp = tile + kc * 65 + nn;
    u32x4 u;
    u[0] = pk2(tp[0], tp[65]); u[1] = pk2(tp[2 * 65], tp[3 * 65]); u[2] = pk2(tp[4 * 65], tp[5 * 65]); u[3] = pk2(tp[6 * 65], tp[7 * 65]);
    *(u32x4*)(dst + (size_t)(n0 + nn) * ldd + k0 + kc) = u;
  }
}

constexpr int N_ADA = 384;
constexpr int N_TWOUT = 1024, N_TDAIN = 2048, N_TMLAIN = 896, N_TQB = 288, N_TKVB = 256, N_TCV = 512;
constexpr int N_ROPE = 128, N_LAM = 1, N_CDK = 1024, N_CCKV = 256, N_CKPE = 64;
constexpr int P0_ITEMS = N_ADA + N_TWOUT + N_TDAIN + N_TMLAIN + N_TQB + N_TKVB + N_TCV + N_ROPE + N_LAM + N_CDK + N_CCKV + N_CKPE;

constexpr int PI_A = N_ADA, PI_D = PI_A + N_TWOUT, PI_M = PI_D + N_TDAIN, PI_Q = PI_M + N_TMLAIN, PI_K = PI_Q + N_TQB, PI_C = PI_K + N_TKVB;
DEVI int prep_map(int set, int n) {
  int lo[4], hi[4];
  if (set == 0)      { lo[0] = 0;          hi[0] = PI_A;        lo[1] = PI_A;       hi[1] = PI_A + 256;  lo[2] = PI_D;        hi[2] = PI_D + 1024; lo[3] = PI_C;       hi[3] = P0_ITEMS; }
  else if (set == 1) { lo[0] = PI_M;       hi[0] = PI_M + 448;  lo[1] = PI_Q;       hi[1] = PI_Q + 144;  lo[2] = PI_K;        hi[2] = PI_K + 128;  lo[3] = PI_A + 256; hi[3] = PI_A + 512; }
  else if (set == 2) { lo[0] = PI_D + 1024; hi[0] = PI_D + 2048; lo[1] = PI_A + 512; hi[1] = PI_A + 768;  lo[2] = 0;           hi[2] = 0;           lo[3] = 0;          hi[3] = 0; }
  else               { lo[0] = PI_M + 448; hi[0] = PI_M + 896;  lo[1] = PI_Q + 144; hi[1] = PI_Q + 288;  lo[2] = PI_K + 128;  hi[2] = PI_K + 256;  lo[3] = PI_A + 768; hi[3] = PI_A + 1024; }
#pragma unroll
  for (int r = 0; r < 4; ++r) {
    const int c = hi[r] - lo[r];
    if (n < c) return lo[r] + n;
    n -= c;
  }
  return -1;
}

DEVI void prep_phase(const Params& P, u16* smem, int set, int bid, int nb) {
  float* fs = (float*)smem;
  const int tid = tidx();
  for (int n = bid; ; n += nb) {
    const int item = prep_map(set, n);
    if (item < 0) break;
    int it = item;
    if (it < N_ADA) {
      const int layer = it / 96, r96 = it % 96, cgp = r96 >> 3, ks = r96 & 7;
      float* sc = fs;
      float* red = fs + 640;
      __syncthreads();
      for (int idx = tid; idx < 640; idx += 256) {
        const int cnd = idx >> 7, k = ks * 128 + (idx & 127);
        const float v = cnd == 0 ? P.in[I_CCTX][k] : P.in[I_C][(cnd - 1) * 1024 + k];
        sc[idx] = silu(v);
      }
      __syncthreads();
      const int c4 = tid & 63, wv_ = tid >> 6;
      const float* wp = P.in[I_WADA] + (size_t)layer * 1024 * 3072 + (size_t)(ks * 128 + wv_ * 32) * 3072 + cgp * 256 + c4 * 4;
      float a[5][4];
#pragma unroll
      for (int c = 0; c < 5; ++c)
#pragma unroll
        for (int q = 0; q < 4; ++q) a[c][q] = 0.f;
#pragma unroll 8
      for (int i = 0; i < 32; ++i) {
        const float4 wv = *(const float4*)(wp + (size_t)i * 3072);
#pragma unroll
        for (int c = 0; c < 5; ++c) {
          const float sv = sc[c * 128 + wv_ * 32 + i];
          a[c][0] += sv * wv.x; a[c][1] += sv * wv.y; a[c][2] += sv * wv.z; a[c][3] += sv * wv.w;
        }
      }
#pragma unroll
      for (int c = 0; c < 5; ++c)
#pragma unroll
        for (int q = 0; q < 4; ++q) red[(wv_ * 5 + c) * 256 + c4 * 4 + q] = a[c][q];
      __syncthreads();
      float* part = (float*)(P.ws + WS_ADAP) + (size_t)((layer * 12 + cgp) * 8) * 1280;
#pragma unroll
      for (int c = 0; c < 5; ++c) {
        const float v = ((red[(0 * 5 + c) * 256 + tid] + red[(1 * 5 + c) * 256 + tid]) + red[(2 * 5 + c) * 256 + tid]) + red[(3 * 5 + c) * 256 + tid];
        part[(size_t)ks * 1280 + c * 256 + tid] = v;
      }
      continue;
    }
    it -= N_ADA;
    if (it < N_TWOUT) {
      const int l = it >> 8, kt = (it >> 4) & 15, nt = it & 15;
      tr_tile(P.in[I_WOUT] + (size_t)l * 1024 * 1024, 1024, kt * 64, nt * 64, 1024,
              (u16*)(P.ws + WS_WOUT) + (size_t)l * 1024 * 1024, 1024, nullptr, fs);
      continue;
    }
    it -= N_TWOUT;
    if (it < N_TDAIN) {
      const int l = it >> 10, kt = (it >> 6) & 15, nt = it & 63;
      tr_tile(P.in[I_DAWIN] + (size_t)l * 1024 * 4096, 4096, kt * 64, nt * 64, 4096,
              (u16*)(P.ws + WS_WDAIN) + (size_t)l * 4096 * 1024, 1024, nullptr, fs);
      continue;
    }
    it -= N_TDAIN;
    if (it < N_TMLAIN) {
      const int l = it / 448, r = it % 448, kt = r / 28, nt = r % 28;
      tr_tile(P.in[I_MWIN] + (size_t)l * 1024 * 1728, 1728, kt * 64, nt * 64, 1728,
              (u16*)(P.ws + WS_WMLAIN) + (size_t)l * 1792 * 1024, 1024, nullptr, fs);
      continue;
    }
    it -= N_TMLAIN;
    if (it < N_TQB) {
      const int l = it / 144, r = it % 144, kt = r / 24, nt = r % 24;
      tr_tile(P.in[I_WQB] + (size_t)l * 384 * 1536, 1536, kt * 64, nt * 64, 1536,
              (u16*)(P.ws + WS_WQB) + (size_t)l * 1536 * 384, 384, P.in[I_GQA] + l * 384, fs);
      continue;
    }
    it -= N_TQB;
    if (it < N_TKVB) {
      const int l = it >> 7, kt = (it >> 5) & 3, nt = it & 31;
      tr_tile(P.in[I_WKVB] + (size_t)l * 256 * 2048, 2048, kt * 64, nt * 64, 2048,
              (u16*)(P.ws + WS_WKVB) + (size_t)l * 2048 * 256, 256, nullptr, fs);
      tr_tile(P.in[I_WKVB] + (size_t)l * 256 * 2048, 2048, kt * 64, nt * 64, 2048,
              (u16*)(P.ws + WS_WKVBG) + (size_t)l * 2048 * 256, 256, P.in[I_GKVA] + l * 256, fs);
      continue;
    }
    it -= N_TKVB;
    if (it < N_TCV) {
      const int grp = it >> 3, sub = it & 7, bl = grp >> 4, jj = (grp >> 3) & 1, h = grp & 7, pt = sub >> 1, et = sub & 1;
      const float* src = P.in[I_CDV] + ((size_t)(bl * 2 + jj) * 256) * 1024 + h * 128;
      u16* dst = (u16*)(P.ws + WS_VTLATD) + (size_t)jj * VTLATD_J + (size_t)(bl * 8 + h) * 128 * 1280 + 1024;
      tr_tile(src, 1024, pt * 64, et * 64, 128, dst, 1280, nullptr, fs);
      continue;
    }
    it -= N_TCV;
    if (it < N_ROPE) {
      const int idx = it * 256 + tid, t = idx >> 5, p = idx & 31, f = p & 15;
      const float inv = exp2f(-(float)f * (13.287712379549449f / 16.f));
      const float pos = (p < 16) ? (float)(t >> 6) : (float)(t & 63);
      float sn, cs;
      sincosf(pos * inv, &sn, &cs);
      float* rc = (float*)(P.ws + WS_ROPE);
      rc[idx] = cs;
      rc[1024 * 32 + idx] = sn;
      continue;
    }
    it -= N_ROPE;
    if (it < N_LAM) {
      if (tid < 2) {
        const int jd = tid;
        float s1 = 0.f, s2 = 0.f;
        for (int d = 0; d < 64; ++d) {
          s1 += P.in[I_LQ1][jd * 64 + d] * P.in[I_LK1][jd * 64 + d];
          s2 += P.in[I_LQ2][jd * 64 + d] * P.in[I_LK2][jd * 64 + d];
        }
        const float li = 0.8f - 0.6f * expf(-0.3f * (float)(2 * jd));
        float* lamv = (float*)(P.ws + WS_MISC);
        lamv[jd * 2] = expf(s1) - expf(s2) + li;
        lamv[jd * 2 + 1] = li;
      }
      continue;
    }
    it -= N_LAM;
    if (it < N_CDK) {
      const size_t e0 = ((size_t)it * 256 + tid) * 8;
      const int col = e0 & 1023, p = (e0 >> 10) & 255, jj = (e0 >> 18) & 1, bl = (int)(e0 >> 19);
      const float4 a = *(const float4*)(P.in[I_CDK] + e0);
      const float4 b = *(const float4*)(P.in[I_CDK] + e0 + 4);
      uint4 u; u.x = pk2(a.x, a.y); u.y = pk2(a.z, a.w); u.z = pk2(b.x, b.y); u.w = pk2(b.z, b.w);
      *(uint4*)((u16*)(P.ws + WS_KDLAT) + (size_t)jj * KDLAT_J + ((size_t)(bl * 1280 + 1024 + p)) * 1024 + col) = u;
      continue;
    }
    it -= N_CDK;
    if (it < N_CCKV) {
      const size_t e0 = ((size_t)it * 256 + tid) * 8;
      const int col = e0 & 255, p = (e0 >> 8) & 255, jj = (e0 >> 16) & 1, bl = (int)(e0 >> 17);
      const float4 a = *(const float4*)(P.in[I_CCKV] + e0);
      const float4 b = *(const float4*)(P.in[I_CCKV] + e0 + 4);
      uint4 u; u.x = pk2(a.x, a.y); u.y = pk2(a.z, a.w); u.z = pk2(b.x, b.y); u.w = pk2(b.z, b.w);
      *(uint4*)((u16*)(P.ws + WS_CKVA) + (size_t)jj * CKVA_J + ((size_t)(4096 + bl * 1280 + 1024 + p)) * 256 + col) = u;
      continue;
    }
    it -= N_CCKV;
    {
      const size_t e0 = ((size_t)it * 256 + tid) * 8;
      const int d = e0 & 63, p = (e0 >> 6) & 255, jj = (e0 >> 14) & 1, bl = (int)(e0 >> 15);
      const float4 a = *(const float4*)(P.in[I_CKPE] + e0);
      const float4 b = *(const float4*)(P.in[I_CKPE] + e0 + 4);
      uint4 u; u.x = pk2(a.x, a.y); u.y = pk2(a.z, a.w); u.z = pk2(b.x, b.y); u.w = pk2(b.z, b.w);
      u16* dst = (u16*)(P.ws + WS_KMLAT) + (size_t)jj * KMLAT_J + ((size_t)(bl * 8) * 1280 + 1024 + p) * 192 + 128 + d;
#pragma unroll
      for (int h = 0; h < 8; ++h) *(uint4*)(dst + (size_t)h * 1280 * 192) = u;
    }
  }
}

DEVI void mla_b_phase(const Params& P, int j, u16* smem) {
  constexpr int NQ = 32 * 12, NKV = 36 * 16, NNORM = 64;
  for (int it = blockIdx.x; it < NKV + NQ + NNORM; it += gridDim.x) {
    if (it < NKV) tile_kvb(P, j, it, smem);
    else if (it < NKV + NQ) tile_qb(P, j, it - NKV, smem);
    else {
      const int lane = tidx() & 63, w = tidx() >> 6;
      const float* ssq = (const float*)(P.ws + WS_SSQKV);
      const float4 gk = *(const float4*)(P.in[I_GKVA] + j * 256 + lane * 4);
      for (int r = w; r < 64; r += 4) {
        const int row = (it - NKV - NQ) * 64 + r;
        const float4 s4 = *(const float4*)(ssq + (size_t)row * 4);
        const float rr = rsqrtf((s4.x + s4.y + s4.z + s4.w) * (1.f / 256.f) + EPS);
        float* p = P.out + OUT_CKV + ((size_t)(((row >> 8) * 2 + j) * 256 + (row & 255))) * 256 + lane * 4;
        float4 v = *(const float4*)((const float*)(P.ws + WS_KVRAW) + (size_t)row * 256 + lane * 4);
        v.x *= rr * gk.x; v.y *= rr * gk.y; v.z *= rr * gk.z; v.w *= rr * gk.w;
        *(float4*)p = v;
      }
    }
  }
}


#define XB_TMO      128
#define XB_XCNT(j)  (256  + 64 * (j))
#define XB_XSUB(j)  (1280 + 64 * (j))
#define XB_XGEN(j)  (2304 + 64 * (j))
#define XB_TOP      3328
#define XB_TOPGEN   3392
#define XCD_BAR_WORDS 3456
#define XB_SPIN_CAP (1u << 22)
#define LAS __attribute__((address_space(3)))
DEVI unsigned xb_ld(unsigned* p) { return __hip_atomic_load(p, __ATOMIC_RELAXED, __HIP_MEMORY_SCOPE_AGENT); }
DEVI unsigned xb_add(unsigned* p, unsigned v) { return __hip_atomic_fetch_add(p, v, __ATOMIC_RELAXED, __HIP_MEMORY_SCOPE_AGENT); }
DEVI unsigned xb_xcc_id() { return (unsigned)__builtin_amdgcn_s_getreg((3 << 11) | 20) & 0xFu; }
#define XB_SPIN(cond, bar) do { unsigned _sp = 0; while (cond) { __builtin_amdgcn_s_sleep(1); \
    if ((++_sp & 255u) == 0u) { if (xb_ld(&(bar)[XB_TMO])) break; if (_sp > XB_SPIN_CAP) { atomicAdd(&(bar)[XB_TMO], 1u); break; } } } } while (0)
struct XcdBarrier { unsigned* bar; unsigned x; volatile LAS unsigned* st; };
DEVI XcdBarrier xcd_barrier_post(unsigned* bar, volatile LAS unsigned* st) {
  XcdBarrier b; b.bar = bar; b.x = xb_xcc_id(); b.st = st;
  if (threadIdx.x == 0) (void)xb_add(&bar[XB_XCNT(b.x)], 1u);
  return b;
}
DEVI void xcd_barrier_complete(unsigned* bar, unsigned x, unsigned& nloc, unsigned& nx) {
  const unsigned G = gridDim.x * gridDim.y * gridDim.z;
  unsigned sum, cnt, mine, sp = 0u;
  for (;;) {
    sum = 0u; cnt = 0u; mine = 0u;
#pragma unroll
    for (unsigned j = 0; j < 16; ++j) { const unsigned c = xb_ld(&bar[XB_XCNT(j)]); sum += c; cnt += (c > 0u) ? 1u : 0u; mine = (j == x) ? c : mine; }
    if (sum == G) break;
    __builtin_amdgcn_s_sleep(1);
    if ((++sp & 255u) == 0u) { if (xb_ld(&bar[XB_TMO])) break; if (sp > XB_SPIN_CAP) { atomicAdd(&bar[XB_TMO], 1u); break; } }
  }
  nloc = mine > 0u ? mine : 1u; nx = cnt > 0u ? cnt : 1u;
}
DEVI void xcd_barrier(const XcdBarrier& b) {
  asm volatile("s_waitcnt vmcnt(0)" ::: "memory");
  __syncthreads();
  if (threadIdx.x == 0) {
    unsigned* bar = b.bar;
    __builtin_amdgcn_s_waitcnt(0);
    unsigned nloc = b.st[0], nx = b.st[1];
    if (nloc == 0u) { xcd_barrier_complete(bar, b.x, nloc, nx); b.st[0] = nloc; b.st[1] = nx; }
    const unsigned old = xb_add(&bar[XB_XSUB(b.x)], 1u);
    const unsigned gen = old / nloc;
    if (old + 1u == (gen + 1u) * nloc) {
      __builtin_amdgcn_fence(__ATOMIC_RELEASE, "agent");
      asm volatile("s_waitcnt vmcnt(0)" ::: "memory");
      const unsigned og = xb_add(&bar[XB_TOP], 1u);
      const unsigned tg = og / nx;
      if (og + 1u == (tg + 1u) * nx) xb_add(&bar[XB_TOPGEN], 1u);
      else XB_SPIN(xb_ld(&bar[XB_TOPGEN]) == tg, bar);
      __builtin_amdgcn_fence(__ATOMIC_ACQUIRE, "agent");
      xb_add(&bar[XB_XGEN(b.x)], 1u);
      asm volatile("s_waitcnt vmcnt(0)" ::: "memory");
    } else {
      XB_SPIN(xb_ld(&bar[XB_XGEN(b.x)]) == gen, bar);
      __builtin_amdgcn_fence(__ATOMIC_ACQUIRE, "agent");
      asm volatile("s_waitcnt vmcnt(0)" ::: "memory");
    }
  }
  __syncthreads();
}

DEVI void ada_reduce_phase(const Params& P) {
  const float* part = (const float*)(P.ws + WS_ADAP);
  float* ada = (float*)(P.ws + WS_ADA);
  for (int i = blockIdx.x * 256 + tidx(); i < 4 * 5 * 768; i += gridDim.x * 256) {
    const int n4 = i % 768, lc = i / 768, c = lc % 5, layer = lc / 5, n = n4 * 4, cgp = n >> 8, col = n & 255;
    float4 sum = *(const float4*)(P.in[I_BADA] + layer * 3072 + n);
    const float* pp = part + (size_t)((layer * 12 + cgp) * 8) * 1280 + c * 256 + col;
#pragma unroll
    for (int q = 0; q < 8; ++q) {
      const float4 v = *(const float4*)(pp + (size_t)q * 1280);
      sum.x += v.x; sum.y += v.y; sum.z += v.z; sum.w += v.w;
    }
    *(float4*)(ada + (size_t)(layer * 5 + c) * 3072 + n) = sum;
  }
}

#ifndef EN
#define EN 0xFF
#endif
DEVI void run_phase(const Params& P, int ph, u16* smem) {
  if (ph == 0) { if (EN & 1) prep_phase(P, smem, 0, blockIdx.x, gridDim.x); return; }
  if (ph == 1) { ada_reduce_phase(P); return; }
  if (ph == 2) { if (EN & 2) ew_phase(P, -1); return; }
  ph -= 1;
  int layer, sub;
  if (ph < 6) { layer = 0; sub = ph - 2; }
  else if (ph < 11) { layer = 1; sub = ph - 6; }
  else if (ph < 15) { layer = 2; sub = ph - 11; }
  else { layer = 3; sub = ph - 15; }
  const int j = layer >> 1;
  if ((layer & 1) == 0) {
    if (sub == 0) { if (EN & 4) for (int t = blockIdx.x; t < 32 * 32; t += gridDim.x) tile_diff_in(P, j, t, smem); }
    else if (sub == 1) { if (EN & 8) attn_diff_phase(P, j, smem); }
    else if (sub == 2) {
      if (EN & 16) for (int t = blockIdx.x; t < 32 * 8; t += gridDim.x) tile_out(P, layer, t, smem);
      const int pset = layer == 0 ? 1 : 3;
      if (gridDim.x >= 512) { if (blockIdx.x >= 256) prep_phase(P, smem, pset, blockIdx.x - 256, gridDim.x - 256); }
      else prep_phase(P, smem, pset, blockIdx.x, gridDim.x);
    }
    else { if (EN & 2) ew_phase(P, layer); }
  } else {
    if (sub == 0) { if (EN & 32) for (int t = blockIdx.x; t < 32 * 14; t += gridDim.x) tile_mla_in(P, j, t, smem); }
    else if (sub == 1) { if (EN & 64) mla_b_phase(P, j, smem); }
    else if (sub == 2) { if (EN & 128) attn_mla_phase(P, j, smem); }
    else if (sub == 3) {
      if (EN & 16) for (int t = blockIdx.x; t < 32 * 8; t += gridDim.x) tile_out(P, layer, t, smem);
      if (layer == 1) {
        if (gridDim.x >= 512) { if (blockIdx.x >= 256) prep_phase(P, smem, 2, blockIdx.x - 256, gridDim.x - 256); }
        else prep_phase(P, smem, 2, blockIdx.x, gridDim.x);
      }
    }
    else { if (EN & 2) ew_phase(P, layer); }
  }
}

constexpr int N_PHASES = 21;

__global__ void __launch_bounds__(256, 2) fwd_megakernel(Params P) {
  __shared__ __attribute__((aligned(16))) u16 smem[SMEM_BYTES / 2];
  __shared__ uint4 xb_words;
  if (threadIdx.x == 0) xb_words = make_uint4(0u, 0u, 0u, 0u);
  __syncthreads();
  XcdBarrier xb = xcd_barrier_post((unsigned*)(P.ws + WS_BAR), (volatile LAS unsigned*)&xb_words);
  for (int ph = P.ph_lo; ph < P.ph_hi; ++ph) {
    Params Pl = P;
    {
      size_t zoff = 0;
      asm volatile("" : "+s"(zoff));
      Pl.ws = P.ws + zoff;
      Pl.out = P.out + zoff;
    }
    run_phase(Pl, ph, smem);
#ifdef REP_MASK
    {
      int kind;
      if (ph == 0) kind = 1; else if (ph == 1) kind = 2;
      else { int layer, sub; if (ph < 6) { layer = 0; sub = ph - 2; } else if (ph < 11) { layer = 1; sub = ph - 6; } else if (ph < 15) { layer = 2; sub = ph - 11; } else { layer = 3; sub = ph - 15; }
        if ((layer & 1) == 0) kind = sub == 0 ? 4 : sub == 1 ? 8 : sub == 2 ? 16 : 2;
        else kind = sub == 0 ? 32 : sub == 1 ? 64 : sub == 2 ? 128 : sub == 3 ? 16 : 2; }
      if (kind & REP_MASK) { xcd_barrier(xb); run_phase(Pl, ph, smem); }
    }
#endif
    if (ph + 1 < P.ph_hi) {
      if (P.ph_hi > 1000) cg::this_grid().sync();
      xcd_barrier(xb);
    }
#ifdef EXTRA_SYNCS
    for (int q = 0; q < EXTRA_SYNCS; ++q) xcd_barrier(xb);
#endif
  }
}

extern "C" void kernel_launch(void* const* d_in, const int* in_sizes, int n_in, void* d_out, int out_size, void* d_ws,
                              size_t ws_size, hipStream_t stream) {
  static int grid_blocks = 0;
  if (!grid_blocks) {
    int dev = 0, cus = 0, per_cu = 0;
    (void)hipGetDevice(&dev);
    (void)hipDeviceGetAttribute(&cus, hipDeviceAttributeMultiprocessorCount, dev);
    (void)hipOccupancyMaxActiveBlocksPerMultiprocessor(&per_cu, fwd_megakernel, 256, 0);
    if (per_cu < 1) per_cu = 1;
    if (per_cu > 2) per_cu = 2;
    grid_blocks = cus * per_cu;
  }
  if (hipMemsetAsync((unsigned char*)d_ws + WS_BAR, 0, 16384, stream) != hipSuccess) { fprintf(stderr, "memset failed\n"); return; }
  Params p{};
  for (int i = 0; i < 24; ++i) p.in[i] = (const float*)d_in[i];
  p.out = (float*)d_out;
  p.ws = (unsigned char*)d_ws;
#if MULTI_LAUNCH
  for (int ph = 0; ph < N_PHASES; ++ph) {
    p.ph_lo = ph; p.ph_hi = ph + 1;
    hipLaunchKernelGGL(fwd_megakernel, dim3(grid_blocks), dim3(256), 0, stream, p);
  }
#else
  p.ph_lo = 0; p.ph_hi = N_PHASES;
  void* args[] = {&p};
  hipError_t e = hipLaunchCooperativeKernel((void*)fwd_megakernel, dim3(grid_blocks), dim3(256), args, 0, stream);
  if (e != hipSuccess) fprintf(stderr, "cooperative launch failed: %s (grid %d)\n", hipGetErrorString(e), grid_blocks);
#endif
}
```

```cpp
#include <hip/hip_runtime.h>
#include <hip/hip_cooperative_groups.h>
#include <cstdio>
namespace cg = cooperative_groups;

#ifndef MULTI_LAUNCH
#define MULTI_LAUNCH 0
#endif

typedef unsigned short u16;
typedef __attribute__((ext_vector_type(8))) short bf16x8;
typedef __attribute__((ext_vector_type(4))) float f32x4;
typedef __attribute__((ext_vector_type(4))) unsigned u32x4;
typedef __attribute__((ext_vector_type(2))) unsigned u32x2;

#define DEVI __device__ __forceinline__

struct Params {
  const float* in[24];
  float* out;
  unsigned char* ws;
  int ph_lo, ph_hi;
};

constexpr size_t MBy = 1u << 20;
constexpr size_t WS_WOUT = 0;
constexpr size_t WS_WDAIN = 8 * MBy;
constexpr size_t WS_WMLAIN = 24 * MBy;
constexpr size_t WS_WQB = 31 * MBy;
constexpr size_t WS_WKVB = 34 * MBy;
constexpr size_t WS_WKVBG = 36 * MBy;
constexpr size_t WS_ADA = 38 * MBy;
constexpr size_t WS_ROPE = 39 * MBy;
constexpr size_t WS_MISC = 40 * MBy;
constexpr size_t WS_H = 41 * MBy;
constexpr size_t WS_O = WS_H;
constexpr size_t WS_Q = 57 * MBy;
constexpr size_t WS_T = WS_Q;
constexpr size_t WS_CTXK = 81 * MBy;
constexpr size_t WS_KDLAT = 93 * MBy;
constexpr size_t WS_VTCTX = 113 * MBy;
constexpr size_t WS_VTLATD = 121 * MBy;
constexpr size_t WS_VTLATM = 141 * MBy;
constexpr size_t WS_G = 151 * MBy;
constexpr size_t WS_QA = 167 * MBy;
constexpr size_t WS_CKVA = 173 * MBy;
constexpr size_t WS_SSQQ = 183 * MBy;
constexpr size_t WS_SSQKV = 184 * MBy;
constexpr size_t WS_KMLAT = 185 * MBy;
constexpr size_t WS_KVRAW = 215 * MBy;
constexpr size_t WS_BAR = WS_MISC + 65536;
constexpr size_t WS_ADAP = 219 * MBy;
constexpr size_t KDLAT_J = (size_t)4 * 1280 * 1024;
constexpr size_t VTLATD_J = (size_t)4 * 8 * 128 * 1280;
constexpr size_t CKVA_J = (size_t)9216 * 256;
constexpr size_t KMLAT_J = (size_t)4 * 8 * 1280 * 192;

constexpr size_t OUT_Y = 0;
constexpr size_t OUT_SK = 8388608;
constexpr size_t OUT_SV = 16777216;
constexpr size_t OUT_CKV = 25165824;
constexpr size_t OUT_KPE = 27262976;

constexpr float EPS = 1e-6f;
constexpr float LOG2E = 1.4426950408889634f;

enum { I_XP = 0, I_XS, I_CDK, I_CDV, I_CCKV, I_CKPE, I_C, I_CCTX, I_WADA, I_BADA, I_GPRE, I_GPOST, I_WOUT,
       I_DAWIN, I_LQ1, I_LK1, I_LQ2, I_LK2, I_GSUB, I_MWIN, I_GQA, I_WQB, I_GKVA, I_WKVB };

DEVI int tidx() { int t = threadIdx.x; asm volatile("" : "+v"(t)); return t; }
DEVI u16 f2bf(float f) {
  unsigned u = __float_as_uint(f);
  u += 0x7fffu + ((u >> 16) & 1u);
  return (u16)(u >> 16);
}
typedef __attribute__((ext_vector_type(2))) float f32x2_t;
typedef __attribute__((ext_vector_type(2))) __bf16 bf16x2_t;
DEVI unsigned pk2(float a, float b) {
  f32x2_t v = {a, b};
  bf16x2_t r = __builtin_convertvector(v, bf16x2_t);
  return __builtin_bit_cast(unsigned, r);
}
DEVI float bf2f(unsigned v) { return __uint_as_float(v << 16); }
DEVI void st_bf4(u16* p, f32x4 v) {
  uint2 u; u.x = pk2(v[0], v[1]); u.y = pk2(v[2], v[3]);
  *(uint2*)p = u;
}
DEVI void st_pair(u16* p, int g, f32x4 a, f32x4 b) {
  const bool odd = g & 1;
  f32x4 send, recv;
#pragma unroll
  for (int i = 0; i < 4; ++i) send[i] = odd ? a[i] : b[i];
#pragma unroll
  for (int i = 0; i < 4; ++i) recv[i] = __shfl_xor(send[i], 16, 64);
  f32x4 lo, hi;
#pragma unroll
  for (int i = 0; i < 4; ++i) { lo[i] = odd ? recv[i] : a[i]; hi[i] = odd ? b[i] : recv[i]; }
  u32x4 u;
  u[0] = pk2(lo[0], lo[1]); u[1] = pk2(lo[2], lo[3]); u[2] = pk2(hi[0], hi[1]); u[3] = pk2(hi[2], hi[3]);
  *(u32x4*)(p + (odd ? 16 : 0) + (g >> 1) * 8) = u;
}
DEVI void st_f4(float* p, f32x4 v) { *(float4*)p = make_float4(v[0], v[1], v[2], v[3]); }
DEVI f32x4 mfma16(bf16x8 a, bf16x8 b, f32x4 c) { return __builtin_amdgcn_mfma_f32_16x16x32_bf16(a, b, c, 0, 0, 0); }
DEVI float silu(float x) { return x * __builtin_amdgcn_rcpf(1.f + __builtin_amdgcn_exp2f(-1.4426950408889634f * x)); }
DEVI float xshfl(float v, int m) { return __shfl_xor(v, m, 64); }

DEVI void rope4(f32x4& x1, f32x4& x2, const float* cs, const float* sn) {
  float4 c = *(const float4*)cs; float4 s = *(const float4*)sn;
  f32x4 a = x1, b = x2;
  x1[0] = a[0] * c.x - b[0] * s.x; x2[0] = a[0] * s.x + b[0] * c.x;
  x1[1] = a[1] * c.y - b[1] * s.y; x2[1] = a[1] * s.y + b[1] * c.y;
  x1[2] = a[2] * c.z - b[2] * s.z; x2[2] = a[2] * s.z + b[2] * c.z;
  x1[3] = a[3] * c.w - b[3] * s.w; x2[3] = a[3] * s.w + b[3] * c.w;
}

constexpr int LDT = 64;
constexpr int TILE_ELEMS = 128 * LDT;
constexpr int SMEM_BYTES = 2 * (64 * 144 + 128 * 72) * 2;

template <bool SWAP>
DEVI void gemm_core(const u16* __restrict__ A, int lda, const u16* __restrict__ B, int ldb, int K,
                    int m0, int n0, u16* smem, f32x4 (&acc)[8][4]) {
  const int tid = tidx(), lane = tid & 63, w = tid >> 6;
  const int wm = w >> 1, wn = w & 1;
  const int g = lane >> 4, li = lane & 15;
  u16* As = smem;
  u16* Bs = smem + 256 * 64;
  const int lr = tid >> 3, lc = (tid & 7) * 8;
  const u16* ap = A + (size_t)(m0 + lr) * lda + lc;
  const u16* bp = B + (size_t)(n0 + lr) * ldb + lc;
  const int wsw = (((tid & 7) ^ (lr & 7)) * 8);
  u16* sa = As + lr * 64 + wsw;
  u16* sb = Bs + lr * 64 + wsw;
  const int rs0 = ((g ^ (li & 7)) * 8), rs1 = (((4 + g) ^ (li & 7)) * 8);
  const u16* Ard = As + (wm * 128 + li) * 64;
  const u16* Brd = Bs + (wn * 64 + li) * 64;
  u32x4 ra[8], rb[4];
#define GLOAD(KT_) { const int k0_ = (KT_) << 6; \
    _Pragma("unroll") for (int i = 0; i < 8; ++i) ra[i] = *(const u32x4*)(ap + (size_t)i * 32 * lda + k0_); \
    _Pragma("unroll") for (int i = 0; i < 4; ++i) rb[i] = *(const u32x4*)(bp + (size_t)i * 32 * ldb + k0_); }
#define SSTORE() { _Pragma("unroll") for (int i = 0; i < 8; ++i) *(u32x4*)(sa + 32 * i * 64) = ra[i]; \
    _Pragma("unroll") for (int i = 0; i < 4; ++i) *(u32x4*)(sb + 32 * i * 64) = rb[i]; }
#define FRAGS(RS) { _Pragma("unroll") for (int t = 0; t < 8; ++t) fa[t] = *(const bf16x8*)(Ard + t * 16 * 64 + (RS)); \
    _Pragma("unroll") for (int t = 0; t < 4; ++t) fb[t] = *(const bf16x8*)(Brd + t * 16 * 64 + (RS)); }
#define MMA() _Pragma("unroll") for (int mt = 0; mt < 8; ++mt) _Pragma("unroll") for (int nt = 0; nt < 4; ++nt) \
      acc[mt][nt] = SWAP ? mfma16(fb[nt], fa[mt], acc[mt][nt]) : mfma16(fa[mt], fb[nt], acc[mt][nt]);
  const int KT = K >> 6;
  bf16x8 fa[8], fb[4];
  GLOAD(0);
  for (int kt = 0; kt < KT; ++kt) {
    __syncthreads();
    SSTORE();
    __syncthreads();
    GLOAD((kt + 1 < KT ? kt + 1 : KT - 1));
    FRAGS(rs0);
    __builtin_amdgcn_sched_barrier(0);
    MMA();
    __builtin_amdgcn_sched_barrier(0);
    FRAGS(rs1);
    __builtin_amdgcn_sched_barrier(0);
    MMA();
  }
#undef GLOAD
#undef SSTORE
#undef FRAGS
#undef MMA
}

DEVI void zero_acc(f32x4 (&acc)[8][4]) {
#pragma unroll
  for (int i = 0; i < 8; ++i)
#pragma unroll
    for (int k = 0; k < 4; ++k) acc[i][k] = (f32x4){0.f, 0.f, 0.f, 0.f};
}


DEVI int xcd_remap(int l, int total) {
  int q = l >> 3;
  if ((q | 63) < (total >> 3))
    q = (q & ~63) | ((((q & 63) / 8) >> 1) * 16) | (((q & 63) % 8) << 1) | (((q & 63) / 8) & 1);
  return (l & 7) * (total >> 3) + q;
}
DEVI void patch_tile(int v, int NT, int PN, int& mt, int& nt) {
  const int psz = 4 * PN, p = v / psz, i = v - p * psz, npn = NT / PN;
  const int pm = p / npn, pn = p - pm * npn;
  const int im = i / PN, in = i - im * PN;
  mt = pm * 4 + im;
  nt = pn * PN + in;
}

DEVI void tile_diff_in(const Params& P, int j, int tile, u16* smem) {
  int tm_, tn_; patch_tile(xcd_remap(tile, 1024), 32, 8, tm_, tn_);
  const int m0 = tm_ * 256, n0 = tn_ * 128;
  const int region = n0 >> 10;
  const u16* A = (const u16*)(P.ws + WS_H);
  const u16* B = (const u16*)(P.ws + WS_WDAIN) + (size_t)j * 4096 * 1024;
  f32x4 acc[8][4];
  zero_acc(acc);
  if (region == 2) gemm_core<false>(A, 1024, B, 1024, 1024, m0, n0, smem, acc);
  else gemm_core<true>(A, 1024, B, 1024, 1024, m0, n0, smem, acc);

  const int lane = tidx() & 63, w = tidx() >> 6, wm = w >> 1, wn = w & 1, g = lane >> 4, li = lane & 15;
  const int mb = m0 + wm * 128, nb = n0 + wn * 64;
  const bool isLat = mb >= 4096;
  const int b = mb >> 8, sb = mb & 255, bl = (mb - 4096) >> 10, tb = (mb - 4096) & 1023;
  const float* ropeC = (const float*)(P.ws + WS_ROPE);
  const float* ropeS = ropeC + 1024 * 32;
  if (region == 2) {
    const int cbase = nb - 2048;
    u16* vtc = (u16*)(P.ws + WS_VTCTX);
    u16* vtl = (u16*)(P.ws + WS_VTLATD) + (size_t)j * VTLATD_J;
#pragma unroll
    for (int mt = 0; mt < 8; ++mt) {
      const int r0 = mt * 16 + g * 4;
#pragma unroll
      for (int nt = 0; nt < 4; ++nt) {
        const int col = cbase + nt * 16 + li, h = col >> 7, e = col & 127;
        if (!isLat) {
          const int s = sb + r0;
          float* sv = P.out + OUT_SV + ((size_t)((b * 2 + j) * 256 + s)) * 1024 + col;
#pragma unroll
          for (int jj = 0; jj < 4; ++jj) sv[(size_t)jj * 1024] = acc[mt][nt][jj];
          st_bf4(vtc + ((size_t)((b * 8 + h) * 128 + e)) * 256 + s, acc[mt][nt]);
        } else {
          const int t = tb + r0;
          st_bf4(vtl + ((size_t)((bl * 8 + h) * 128 + e)) * 1280 + t, acc[mt][nt]);
        }
      }
    }
  } else {
    const float qs = 0.125f * LOG2E;
#pragma unroll
    for (int mt = 0; mt < 8; ++mt) {
      const int rl = mt * 16 + li, row = mb + rl;
      if (region <= 1 && isLat) {
        const int t = tb + rl;
#pragma unroll
        for (int nt = 0; nt < 2; ++nt)
          rope4(acc[mt][nt], acc[mt][nt + 2], ropeC + t * 32 + nt * 16 + g * 4, ropeS + t * 32 + nt * 16 + g * 4);
      }
      if (region == 1 && !isLat) {
#pragma unroll
        for (int nt = 0; nt < 4; ++nt)
          st_f4(P.out + OUT_SK + ((size_t)((b * 2 + j) * 256 + sb + rl)) * 1024 + (nb - 1024) + nt * 16 + g * 4, acc[mt][nt]);
      }
      u16* dst;
      if (region == 0) dst = (u16*)(P.ws + WS_Q) + (size_t)row * 1024 + nb;
      else if (region == 1) dst = isLat ? (u16*)(P.ws + WS_KDLAT) + (size_t)j * KDLAT_J + ((size_t)(bl * 1280 + tb + rl)) * 1024 + (nb - 1024)
                                        : (u16*)(P.ws + WS_CTXK) + (size_t)row * 1024 + (nb - 1024);
      else dst = (u16*)(P.ws + WS_G) + (size_t)row * 1024 + (nb - 3072);
#pragma unroll
      for (int np = 0; np < 2; ++np) {
        f32x4 va = acc[mt][2 * np], vb = acc[mt][2 * np + 1];
        if (region == 0) { va *= qs; vb *= qs; }
        else if (region == 3) {
#pragma unroll
          for (int jj = 0; jj < 4; ++jj) { va[jj] = silu(va[jj]); vb[jj] = silu(vb[jj]); }
        }
        st_pair(dst + np * 32, g, va, vb);
      }
    }
  }
}

DEVI void tile_mla_in(const Params& P, int j, int tile, u16* smem) {
  int tm_, tn_; patch_tile(xcd_remap(tile, 448), 14, 7, tm_, tn_);
  const int m0 = tm_ * 256, n0 = tn_ * 128;
  const u16* A = (const u16*)(P.ws + WS_H);
  const u16* B = (const u16*)(P.ws + WS_WMLAIN) + (size_t)j * 1792 * 1024;
  f32x4 acc[8][4];
  zero_acc(acc);
  gemm_core<true>(A, 1024, B, 1024, 1024, m0, n0, smem, acc);

  const int lane = tidx() & 63, w = tidx() >> 6, wm = w >> 1, wn = w & 1, g = lane >> 4, li = lane & 15;
  const int mb = m0 + wm * 128, nb = n0 + wn * 64;
  const bool isLat = mb >= 4096;
  const int b = mb >> 8, sb = mb & 255, bl = (mb - 4096) >> 10, tb = (mb - 4096) & 1023;
  const float* ropeC = (const float*)(P.ws + WS_ROPE);
  const float* ropeS = ropeC + 1024 * 32;
  if (nb >= 1728) return;
#pragma unroll
  for (int mt = 0; mt < 8; ++mt) {
    const int rl = mt * 16 + li, row = mb + rl;
    if (nb < 640) {
      float ss = 0.f;
#pragma unroll
      for (int nt = 0; nt < 4; ++nt)
#pragma unroll
        for (int jj = 0; jj < 4; ++jj) ss += acc[mt][nt][jj] * acc[mt][nt][jj];
      ss += xshfl(ss, 16);
      ss += xshfl(ss, 32);
      if (nb < 384) {
        if (g == 0) ((float*)(P.ws + WS_SSQQ))[row * 8 + (nb >> 6)] = ss;
#pragma unroll
        for (int np = 0; np < 2; ++np)
          st_pair((u16*)(P.ws + WS_QA) + (size_t)row * 384 + nb + np * 32, g, acc[mt][2 * np], acc[mt][2 * np + 1]);
      } else {
        if (g == 0) ((float*)(P.ws + WS_SSQKV))[row * 4 + ((nb - 384) >> 6)] = ss;
        const int arow = isLat ? (4096 + bl * 1280 + tb + rl) : row;
#pragma unroll
        for (int nt = 0; nt < 4; ++nt) {
          const int c2 = nb - 384 + nt * 16 + g * 4;
          if (!isLat) st_f4((float*)(P.ws + WS_KVRAW) + (size_t)row * 256 + c2, acc[mt][nt]);
        }
#pragma unroll
        for (int np = 0; np < 2; ++np)
          st_pair((u16*)(P.ws + WS_CKVA) + (size_t)j * CKVA_J + (size_t)arow * 256 + (nb - 384) + np * 32, g, acc[mt][2 * np], acc[mt][2 * np + 1]);
      }
    } else if (nb == 640) {
      if (isLat) {
        const int t = tb + rl;
#pragma unroll
        for (int nt = 0; nt < 2; ++nt)
          rope4(acc[mt][nt], acc[mt][nt + 2], ropeC + t * 32 + nt * 16 + g * 4, ropeS + t * 32 + nt * 16 + g * 4);
      }
#pragma unroll
      for (int nt = 0; nt < 4; ++nt) {
        const int d = nt * 16 + g * 4;
        if (!isLat) {
          st_f4(P.out + OUT_KPE + ((size_t)((b * 2 + j) * 256 + sb + rl)) * 64 + d, acc[mt][nt]);
          u16* kd = (u16*)(P.ws + WS_CTXK) + ((size_t)(b * 8) * 256 + sb + rl) * 192 + 128 + d;
#pragma unroll
          for (int h = 0; h < 8; ++h) st_bf4(kd + (size_t)h * 256 * 192, acc[mt][nt]);
        } else {
          u16* kd = (u16*)(P.ws + WS_KMLAT) + (size_t)j * KMLAT_J + ((size_t)(bl * 8) * 1280 + tb + rl) * 192 + 128 + d;
#pragma unroll
          for (int h = 0; h < 8; ++h) st_bf4(kd + (size_t)h * 1280 * 192, acc[mt][nt]);
        }
      }
    } else {
#pragma unroll
      for (int np = 0; np < 2; ++np) {
        f32x4 va = acc[mt][2 * np], vb = acc[mt][2 * np + 1];
#pragma unroll
        for (int jj = 0; jj < 4; ++jj) { va[jj] = silu(va[jj]); vb[jj] = silu(vb[jj]); }
        st_pair((u16*)(P.ws + WS_G) + (size_t)row * 1024 + (nb - 704) + np * 32, g, va, vb);
      }
    }
  }
}

DEVI void tile_qb(const Params& P, int j, int tile, u16* smem) {
  int tm_, tn_; patch_tile(xcd_remap(tile, 384), 12, 6, tm_, tn_);
  const int m0 = tm_ * 256, n0 = tn_ * 128;
  const u16* A = (const u16*)(P.ws + WS_QA);
  const u16* B = (const u16*)(P.ws + WS_WQB) + (size_t)j * 1536 * 384;
  f32x4 acc[8][4];
  zero_acc(acc);
  gemm_core<true>(A, 384, B, 384, 384, m0, n0, smem, acc);
  const int lane = tidx() & 63, w = tidx() >> 6, wm = w >> 1, wn = w & 1, g = lane >> 4, li = lane & 15;
  const int mb = m0 + wm * 128, nb = n0 + wn * 64;
  const bool isLat = mb >= 4096;
  const int tb = (mb - 4096) & 1023;
  const float* ropeC = (const float*)(P.ws + WS_ROPE);
  const float* ropeS = ropeC + 1024 * 32;
  const float* ssq = (const float*)(P.ws + WS_SSQQ);
  const bool isRope = (nb % 192) == 128;
  const float qs = 0.07216878364870322f * LOG2E;
#pragma unroll
  for (int mt = 0; mt < 8; ++mt) {
    const int rl = mt * 16 + li, row = mb + rl;
    float ss = 0.f;
#pragma unroll
    for (int i = 0; i < 6; ++i) ss += ssq[row * 8 + i];
    const float r = rsqrtf(ss * (1.f / 384.f) + EPS) * qs;
    if (isRope && isLat) {
      const int t = tb + rl;
#pragma unroll
      for (int nt = 0; nt < 2; ++nt)
        rope4(acc[mt][nt], acc[mt][nt + 2], ropeC + t * 32 + nt * 16 + g * 4, ropeS + t * 32 + nt * 16 + g * 4);
    }
#pragma unroll
    for (int np = 0; np < 2; ++np)
      st_pair((u16*)(P.ws + WS_Q) + (size_t)row * 1536 + nb + np * 32, g, acc[mt][2 * np] * r, acc[mt][2 * np + 1] * r);
  }
}

DEVI void tile_kvb(const Params& P, int j, int tile, u16* smem) {
  int tm_, tn_; patch_tile(xcd_remap(tile, 576), 16, 8, tm_, tn_);
  const int m0 = tm_ * 256, n0 = tn_ * 128;
  const bool tileLat = m0 >= 4096;
  const bool fresh = !tileLat || ((m0 - 4096) % 1280) < 1024;
  const u16* A = (const u16*)(P.ws + WS_CKVA) + (size_t)j * CKVA_J;
  const u16* B = (const u16*)(P.ws + (fresh ? WS_WKVBG : WS_WKVB)) + (size_t)j * 2048 * 256;
  const bool isV = (n0 >> 7) & 1;
  const int h = n0 >> 8;
  f32x4 acc[8][4];
  zero_acc(acc);
  if (isV) gemm_core<false>(A, 256, B, 256, 256, m0, n0, smem, acc);
  else gemm_core<true>(A, 256, B, 256, 256, m0, n0, smem, acc);
  const int lane = tidx() & 63, w = tidx() >> 6, wm = w >> 1, wn = w & 1, g = lane >> 4, li = lane & 15;
  const int mb = m0 + wm * 128;
  int b, keyb, Sk, tokb;
  u16 *Kd, *Vd;
  if (!tileLat) {
    b = mb >> 8; keyb = mb & 255; Sk = 256; tokb = mb;
    Kd = (u16*)(P.ws + WS_CTXK); Vd = (u16*)(P.ws + WS_VTCTX);
  } else {
    const int r2 = mb - 4096;
    b = r2 / 1280; keyb = r2 % 1280; Sk = 1280; tokb = 4096 + b * 1024 + keyb;
    Kd = (u16*)(P.ws + WS_KMLAT) + (size_t)j * KMLAT_J; Vd = (u16*)(P.ws + WS_VTLATM);
  }
  const float* ssq = (const float*)(P.ws + WS_SSQKV);
  if (!isV) {
#pragma unroll
    for (int mt = 0; mt < 8; ++mt) {
      const int rl = mt * 16 + li;
      float r = 1.f;
      if (fresh) {
        const float4 s4 = *(const float4*)(ssq + (size_t)(tokb + rl) * 4);
        r = rsqrtf((s4.x + s4.y + s4.z + s4.w) * (1.f / 256.f) + EPS);
      }
#pragma unroll
      for (int np = 0; np < 2; ++np)
        st_pair(Kd + ((size_t)((b * 8 + h) * Sk + keyb + rl)) * 192 + wn * 64 + np * 32, g, acc[mt][2 * np] * r, acc[mt][2 * np + 1] * r);
    }
  } else {
#pragma unroll
    for (int mt = 0; mt < 8; ++mt) {
      const int r0 = mt * 16 + g * 4;
      f32x4 rr = {1.f, 1.f, 1.f, 1.f};
      if (fresh) {
#pragma unroll
        for (int jj = 0; jj < 4; ++jj) {
          const float4 s4 = *(const float4*)(ssq + (size_t)(tokb + r0 + jj) * 4);
          rr[jj] = rsqrtf((s4.x + s4.y + s4.z + s4.w) * (1.f / 256.f) + EPS);
        }
      }
#pragma unroll
      for (int nt = 0; nt < 4; ++nt) {
        const int e = wn * 64 + nt * 16 + li;
        st_bf4(Vd + ((size_t)((b * 8 + h) * 128 + e)) * Sk + keyb + r0, acc[mt][nt] * rr);
      }
    }
  }
}

DEVI void tile_out(const Params& P, int layer, int tile, u16* smem) {
  int tm_, tn_; patch_tile(xcd_remap(tile, 256), 8, 8, tm_, tn_);
  const int m0 = tm_ * 256, n0 = tn_ * 128;
  const u16* A = (const u16*)(P.ws + WS_O);
  const u16* B = (const u16*)(P.ws + WS_WOUT) + (size_t)layer * 1024 * 1024;
  f32x4 acc[8][4];
  zero_acc(acc);
  gemm_core<true>(A, 1024, B, 1024, 1024, m0, n0, smem, acc);
  const int lane = tidx() & 63, w = tidx() >> 6, wm = w >> 1, wn = w & 1, g = lane >> 4, li = lane & 15;
  const int mb = m0 + wm * 128, nb = n0 + wn * 64;
  u16* T = (u16*)(P.ws + WS_T);
#pragma unroll
  for (int mt = 0; mt < 8; ++mt)
#pragma unroll
    for (int np = 0; np < 2; ++np)
      st_pair(T + (size_t)(mb + mt * 16 + li) * 1024 + nb + np * 32, g, acc[mt][2 * np], acc[mt][2 * np + 1]);
}

template <bool DIFF>
DEVI void attn_item(const Params& P, const u16* __restrict__ Qb, int ldq, int qrow0,
                    const u16* __restrict__ Kb, int ldk, const u16* __restrict__ Vt, int Sk,
                    int h, float lam, float lam_init, const float* gsub, u16* smem) {
  constexpr int KW = DIFF ? 128 : 192;
  constexpr int KLD = KW + 16;
  constexpr int NKK = DIFF ? 2 : 6;
  constexpr int KT = DIFF ? 64 : 32;
  constexpr int NS = KT / 16;
  constexpr int NU = KT / 32;
  constexpr int KCH = KW / 8;
  constexpr int NKL = (KT * KCH) / 256;
  constexpr int VCH = KT / 8;
  constexpr int NVL = (128 * VCH) / 256;
  constexpr int VLD = KT + 8;
  constexpr int STAGE = KT * KLD + 128 * VLD;
  const int tid = tidx(), lane = tid & 63, w = tid >> 6, g = lane >> 4, li = lane & 15;

  bf16x8 qf[2][NKK];
#pragma unroll
  for (int s = 0; s < 2; ++s) {
    const int qrow = DIFF ? (qrow0 + w * 16 + li) : (qrow0 + w * 32 + s * 16 + li);
    const int qcol = DIFF ? (h * 128 + s * 64) : (h * 192);
#pragma unroll
    for (int kk = 0; kk < NKK; ++kk)
      qf[s][kk] = *(const bf16x8*)(Qb + (size_t)qrow * ldq + qcol + kk * 32 + g * 8);
  }
  f32x4 oacc[2][8];
#pragma unroll
  for (int s = 0; s < 2; ++s)
#pragma unroll
    for (int et = 0; et < 8; ++et) oacc[s][et] = (f32x4){0.f, 0.f, 0.f, 0.f};
  float mrow[2] = {0.f, 0.f}, lrow[2] = {0.f, 0.f};

  u32x4 rk[NKL], rv[NVL];
  auto gload = [&](int key0) {
#pragma unroll
    for (int i = 0; i < NKL; ++i) {
      const int c = tid + 256 * i, r = c / KCH, cc = c % KCH;
      rk[i] = *(const u32x4*)(Kb + (size_t)(key0 + r) * ldk + cc * 8);
    }
#pragma unroll
    for (int i = 0; i < NVL; ++i) {
      const int c = tid + 256 * i, r = c / VCH, cc = c % VCH;
      rv[i] = *(const u32x4*)(Vt + (size_t)r * Sk + key0 + cc * 8);
    }
  };
  auto sstore = [&](int buf) {
    u16* Kw = smem + buf * STAGE;
    u16* Vw = Kw + KT * KLD;
#pragma unroll
    for (int i = 0; i < NKL; ++i) {
      const int c = tid + 256 * i, r = c / KCH, cc = c % KCH;
      *(u32x4*)(Kw + r * KLD + cc * 8) = rk[i];
    }
#pragma unroll
    for (int i = 0; i < NVL; ++i) {
      const int c = tid + 256 * i, r = c / VCH, cc = c % VCH;
      *(u32x4*)(Vw + r * VLD + cc * 8) = rv[i];
    }
  };
  const int NT = Sk / KT;
  gload(0);
  __syncthreads();
  sstore(0);
  gload(NT > 1 ? KT : 0);
  __syncthreads();
  for (int kt0 = 0; kt0 < NT; ++kt0) {
    const u16* Ks = smem + (kt0 & 1) * STAGE;
    const u16* Vs = Ks + KT * KLD;
    if (kt0 + 1 < NT) {
      sstore((kt0 + 1) & 1);
      gload((kt0 + 2 < NT ? kt0 + 2 : NT - 1) * KT);
    }

    f32x4 st[2][NS];
#pragma unroll
    for (int s = 0; s < 2; ++s)
#pragma unroll
      for (int kt = 0; kt < NS; ++kt) { const float ni = -mrow[s]; st[s][kt] = (f32x4){ni, ni, ni, ni}; }
    {
      constexpr int NF = DIFF ? NKK * NS * 2 : NKK * NS;
      auto kaddr = [&](int f) -> const u16* {
        if (DIFF) { const int s2 = f & 1, kt = (f >> 1) % NS, kk = (f >> 1) / NS; return Ks + (kt * 16 + li) * KLD + s2 * 64 + kk * 32 + g * 8; }
        else { const int kt = f % NS, kk = f / NS; return Ks + (kt * 16 + li) * KLD + kk * 32 + g * 8; }
      };
      bf16x8 kf[3];
      kf[0] = *(const bf16x8*)kaddr(0);
      kf[1] = *(const bf16x8*)kaddr(1);
#pragma unroll
      for (int f = 0; f < NF; ++f) {
        if (f + 2 < NF) kf[(f + 2) % 3] = *(const bf16x8*)kaddr(f + 2);
        __builtin_amdgcn_sched_barrier(0);
        if (DIFF) {
          const int s2 = f & 1, kt = (f >> 1) % NS, kk = (f >> 1) / NS;
          st[s2][kt] = mfma16(kf[f % 3], qf[s2][kk], st[s2][kt]);
        } else {
          const int kt = f % NS, kk = f / NS;
          st[0][kt] = mfma16(kf[f % 3], qf[0][kk], st[0][kt]);
          st[1][kt] = mfma16(kf[f % 3], qf[1][kk], st[1][kt]);
        }
        __builtin_amdgcn_sched_barrier(0);
      }
    }
    bf16x8 pf[2][NU];
#pragma unroll
    for (int s = 0; s < 2; ++s) {
      float mx = st[s][0][0];
#pragma unroll
      for (int kt = 0; kt < NS; ++kt)
#pragma unroll
        for (int jj = 0; jj < 4; ++jj) mx = fmaxf(mx, st[s][kt][jj]);
      mx = fmaxf(mx, xshfl(mx, 16));
      mx = fmaxf(mx, xshfl(mx, 32));
      const bool first = (kt0 == 0);
      const bool need = first || (mx > 8.f);
      if (__builtin_amdgcn_ballot_w64(need) != 0ull) {
        const float d = need ? mx : 0.f;
        mrow[s] += d;
        if (!first) {
          const float alpha = __builtin_amdgcn_exp2f(-d);
          lrow[s] *= alpha;
#pragma unroll
          for (int et = 0; et < 8; ++et) oacc[s][et] *= alpha;
        }
#pragma unroll
        for (int kt = 0; kt < NS; ++kt) st[s][kt] -= d;
      }
      float ps = 0.f;
#pragma unroll
      for (int kt = 0; kt < NS; ++kt)
#pragma unroll
        for (int jj = 0; jj < 4; ++jj) {
          const float p = __builtin_amdgcn_exp2f(st[s][kt][jj]);
          st[s][kt][jj] = p;
          ps += p;
        }
      lrow[s] += ps;
#pragma unroll
      for (int u = 0; u < NU; ++u) {
        union { bf16x8 v; unsigned d[4]; } pu;
        pu.d[0] = pk2(st[s][2 * u][0], st[s][2 * u][1]);
        pu.d[1] = pk2(st[s][2 * u][2], st[s][2 * u][3]);
        pu.d[2] = pk2(st[s][2 * u + 1][0], st[s][2 * u + 1][1]);
        pu.d[3] = pk2(st[s][2 * u + 1][2], st[s][2 * u + 1][3]);
        pf[s][u] = pu.v;
      }
    }
    {
      constexpr int NF = NU * 8;
      union VU { bf16x8 v; u32x2 d[2]; };
      VU vf[3];
      auto vload = [&](VU& o, int f) {
        const int u = f >> 3, et = f & 7;
        o.d[0] = *(const u32x2*)(Vs + (et * 16 + li) * VLD + (2 * u) * 16 + g * 4);
        o.d[1] = *(const u32x2*)(Vs + (et * 16 + li) * VLD + (2 * u + 1) * 16 + g * 4);
      };
      vload(vf[0], 0);
      vload(vf[1], 1);
#pragma unroll
      for (int f = 0; f < NF; ++f) {
        if (f + 2 < NF) vload(vf[(f + 2) % 3], f + 2);
        __builtin_amdgcn_sched_barrier(0);
        const int u = f >> 3, et = f & 7;
        oacc[0][et] = mfma16(vf[f % 3].v, pf[0][u], oacc[0][et]);
        oacc[1][et] = mfma16(vf[f % 3].v, pf[1][u], oacc[1][et]);
        __builtin_amdgcn_sched_barrier(0);
      }
    }
    __syncthreads();
  }
#pragma unroll
  for (int s = 0; s < 2; ++s) {
    lrow[s] += xshfl(lrow[s], 16);
    lrow[s] += xshfl(lrow[s], 32);
  }
  const u16* G = (const u16*)(P.ws + WS_G);
  u16* O = (u16*)(P.ws + WS_O);
  if (DIFF) {
    const float i0 = 1.f / lrow[0], i1 = lam / lrow[1];
    float ss = 0.f;
#pragma unroll
    for (int et = 0; et < 8; ++et) {
      oacc[0][et] = oacc[0][et] * i0 - oacc[1][et] * i1;
#pragma unroll
      for (int jj = 0; jj < 4; ++jj) ss += oacc[0][et][jj] * oacc[0][et][jj];
    }
    ss += xshfl(ss, 16);
    ss += xshfl(ss, 32);
    const float rr = rsqrtf(ss * (1.f / 128.f) + EPS) * (1.f - lam_init);
    const size_t tok = (size_t)(qrow0 + w * 16 + li);
#pragma unroll
    for (int et = 0; et < 8; ++et) {
      const int e = et * 16 + g * 4;
      const float4 gs = *(const float4*)(gsub + e);
      const uint2 gg = *(const uint2*)(G + tok * 1024 + h * 128 + e);
      f32x4 v = oacc[0][et] * rr;
      v[0] *= gs.x * bf2f(gg.x & 0xffffu);
      v[1] *= gs.y * bf2f(gg.x >> 16);
      v[2] *= gs.z * bf2f(gg.y & 0xffffu);
      v[3] *= gs.w * bf2f(gg.y >> 16);
      st_bf4(O + tok * 1024 + h * 128 + e, v);
    }
  } else {
#pragma unroll
    for (int s = 0; s < 2; ++s) {
      const float inv = 1.f / lrow[s];
      const size_t tok = (size_t)(qrow0 + w * 32 + s * 16 + li);
#pragma unroll
      for (int et = 0; et < 8; ++et) {
        const int e = et * 16 + g * 4;
        const uint2 gg = *(const uint2*)(G + tok * 1024 + h * 128 + e);
        f32x4 v = oacc[s][et] * inv;
        v[0] *= bf2f(gg.x & 0xffffu);
        v[1] *= bf2f(gg.x >> 16);
        v[2] *= bf2f(gg.y & 0xffffu);
        v[3] *= bf2f(gg.y >> 16);
        st_bf4(O + tok * 1024 + h * 128 + e, v);
      }
    }
  }
}

DEVI void attn_diff_phase(const Params& P, int j, u16* smem) {
  const float* lamv = (const float*)(P.ws + WS_MISC);
  const float lam = lamv[j * 2], lam_init = lamv[j * 2 + 1];
  const float* gsub = P.in[I_GSUB] + j * 128;
  const u16* Q = (const u16*)(P.ws + WS_Q);
  for (int it = blockIdx.x; it < 1024; it += gridDim.x) {
    if (it < 512) {
      const int iv = xcd_remap(it, 512);
      const int bl = iv >> 7, h = (iv >> 4) & 7, qt = iv & 15;
      const u16* Kb = (const u16*)(P.ws + WS_KDLAT) + (size_t)j * KDLAT_J + (size_t)bl * 1280 * 1024 + h * 128;
      const u16* Vt = (const u16*)(P.ws + WS_VTLATD) + (size_t)j * VTLATD_J + (size_t)(bl * 8 + h) * 128 * 1280;
      attn_item<true>(P, Q, 1024, 4096 + bl * 1024 + qt * 64, Kb, 1024, Vt, 1280, h, lam, lam_init, gsub, smem);
    } else {
      const int i2 = xcd_remap(it - 512, 512), b = i2 >> 5, h = (i2 >> 2) & 7, qt = i2 & 3;
      const u16* Kb = (const u16*)(P.ws + WS_CTXK) + (size_t)b * 256 * 1024 + h * 128;
      const u16* Vt = (const u16*)(P.ws + WS_VTCTX) + (size_t)(b * 8 + h) * 128 * 256;
      attn_item<true>(P, Q, 1024, b * 256 + qt * 64, Kb, 1024, Vt, 256, h, lam, lam_init, gsub, smem);
    }
  }
}

DEVI void attn_mla_phase(const Params& P, int j, u16* smem) {
  const u16* Q = (const u16*)(P.ws + WS_Q);
  for (int it = blockIdx.x; it < 512; it += gridDim.x) {
    if (it < 256) {
      const int iv = xcd_remap(it, 256);
      const int bl = iv >> 6, h = (iv >> 3) & 7, qt = iv & 7;
      const u16* Kb = (const u16*)(P.ws + WS_KMLAT) + (size_t)j * KMLAT_J + (size_t)(bl * 8 + h) * 1280 * 192;
      const u16* Vt = (const u16*)(P.ws + WS_VTLATM) + (size_t)(bl * 8 + h) * 128 * 1280;
      attn_item<false>(P, Q, 1536, 4096 + bl * 1024 + qt * 128, Kb, 192, Vt, 1280, h, 0.f, 0.f, nullptr, smem);
    } else {
      const int i2 = xcd_remap(it - 256, 256), b = i2 >> 4, h = (i2 >> 1) & 7, qt = i2 & 1;
      const u16* Kb = (const u16*)(P.ws + WS_CTXK) + (size_t)(b * 8 + h) * 256 * 192;
      const u16* Vt = (const u16*)(P.ws + WS_VTCTX) + (size_t)(b * 8 + h) * 128 * 256;
      attn_item<false>(P, Q, 1536, b * 256 + qt * 128, Kb, 192, Vt, 256, h, 0.f, 0.f, nullptr, smem);
    }
  }
}

DEVI float wave_sum(float v) {
  v += xshfl(v, 1); v += xshfl(v, 2); v += xshfl(v, 4); v += xshfl(v, 8); v += xshfl(v, 16); v += xshfl(v, 32);
  return v;
}

DEVI void ew_phase(const Params& P, int layer) {
  const int lane = tidx() & 63, w = tidx() >> 6;
  const float* ada = (const float*)(P.ws + WS_ADA);
  const u16* T = (const u16*)(P.ws + WS_T);
  u16* H = (u16*)(P.ws + WS_H);
  const int nl = layer + 1;
  for (int gw = blockIdx.x * 4 + w; gw < 2048; gw += gridDim.x * 4) {
    const int row0 = gw * 4;
    const int cond = row0 < 4096 ? 0 : 1 + ((row0 - 4096) >> 10);
    const float* xsrc = (layer <= 0) ? (row0 < 4096 ? P.in[I_XP] + (size_t)row0 * 1024 : P.in[I_XS] + (size_t)(row0 - 4096) * 1024)
                                     : P.out + OUT_Y + (size_t)row0 * 1024;
    float4 x[4][4];
    u32x2 tb[4][4];
#pragma unroll
    for (int q = 0; q < 4; ++q)
#pragma unroll
      for (int i = 0; i < 4; ++i) x[q][i] = *(const float4*)(xsrc + (size_t)q * 1024 + lane * 4 + i * 256);
    if (layer >= 0) {
#pragma unroll
      for (int q = 0; q < 4; ++q)
#pragma unroll
        for (int i = 0; i < 4; ++i) tb[q][i] = *(const u32x2*)(T + (size_t)(row0 + q) * 1024 + lane * 4 + i * 256);
      float4 ga[4];
      const float* gate = ada + (size_t)(layer * 5 + cond) * 3072 + 2048;
#pragma unroll
      for (int i = 0; i < 4; ++i) ga[i] = *(const float4*)(gate + lane * 4 + i * 256);
#pragma unroll
      for (int q = 0; q < 4; ++q) {
        float4 t[4];
        float ss = 0.f;
#pragma unroll
        for (int i = 0; i < 4; ++i) {
          t[i] = make_float4(bf2f(tb[q][i][0] & 0xffffu), bf2f(tb[q][i][0] >> 16), bf2f(tb[q][i][1] & 0xffffu), bf2f(tb[q][i][1] >> 16));
          ss += t[i].x * t[i].x + t[i].y * t[i].y + t[i].z * t[i].z + t[i].w * t[i].w;
        }
        ss = wave_sum(ss);
        const float rt = rsqrtf(ss * (1.f / 1024.f) + EPS);
#pragma unroll
        for (int i = 0; i < 4; ++i) {
          x[q][i].x += ga[i].x * (t[i].x * rt);
          x[q][i].y += ga[i].y * (t[i].y * rt);
          x[q][i].z += ga[i].z * (t[i].z * rt);
          x[q][i].w += ga[i].w * (t[i].w * rt);
          *(float4*)(P.out + OUT_Y + (size_t)(row0 + q) * 1024 + lane * 4 + i * 256) = x[q][i];
        }
      }
    }
    if (nl < 4) {
      const float* sh = ada + (size_t)(nl * 5 + cond) * 3072;
      const float* sc = sh + 1024;
      float4 s1[4], s2[4];
#pragma unroll
      for (int i = 0; i < 4; ++i) { s1[i] = *(const float4*)(sh + lane * 4 + i * 256); s2[i] = *(const float4*)(sc + lane * 4 + i * 256); }
#pragma unroll
      for (int q = 0; q < 4; ++q) {
        float ss = 0.f;
#pragma unroll
        for (int i = 0; i < 4; ++i)
          ss += x[q][i].x * x[q][i].x + x[q][i].y * x[q][i].y + x[q][i].z * x[q][i].z + x[q][i].w * x[q][i].w;
        ss = wave_sum(ss);
        const float rx = rsqrtf(ss * (1.f / 1024.f) + EPS);
#pragma unroll
        for (int i = 0; i < 4; ++i) {
          f32x4 hv;
          hv[0] = x[q][i].x * rx * s2[i].x + s1[i].x;
          hv[1] = x[q][i].y * rx * s2[i].y + s1[i].y;
          hv[2] = x[q][i].z * rx * s2[i].z + s1[i].z;
          hv[3] = x[q][i].w * rx * s2[i].w + s1[i].w;
          st_bf4(H + (size_t)(row0 + q) * 1024 + lane * 4 + i * 256, hv);
        }
      }
    }
  }
}

DEVI void tr_tile(const float* __restrict__ src, int lds, int k0, int n0, int nvalid, u16* __restrict__ dst, int ldd,
                  const float* kscale, float* tile) {
  const int tid = tidx();
  float4 v[4];
#pragma unroll
  for (int i = 0; i < 4; ++i) {
    const int idx = tid + 256 * i, kk = idx >> 4, c4 = (idx & 15) * 4;
    v[i] = (n0 + c4 < nvalid) ? *(const float4*)(src + (size_t)(k0 + kk) * lds + n0 + c4) : make_float4(0.f, 0.f, 0.f, 0.f);
    if (kscale) { const float ks = kscale[k0 + kk]; v[i].x *= ks; v[i].y *= ks; v[i].z *= ks; v[i].w *= ks; }
  }
  __syncthreads();
#pragma unroll
  for (int i = 0; i < 4; ++i) {
    const int idx = tid + 256 * i, kk = idx >> 4, c4 = (idx & 15) * 4;
    float* tp = tile + kk * 65 + c4;
    tp[0] = v[i].x; tp[1] = v[i].y; tp[2] = v[i].z; tp[3] = v[i].w;
  }
  __syncthreads();
#pragma unroll
  for (int i = 0; i < 2; ++i) {
    const int c = tid + 256 * i, nn = c >> 3, kc = (c & 7) * 8;
    const float* tp = tile + kc * 65 + nn;
    u32x4 u;
    u[0] = pk2(tp[0], tp[65]); u[1] = pk2(tp[2 * 65], tp[3 * 65]); u[2] = pk2(tp[4 * 65], tp[5 * 65]); u[3] = pk2(tp[6 * 65], tp[7 * 65]);
    *(u32x4*)(dst + (size_t)(n0 + nn) * ldd + k0 + kc) = u;
  }
}

constexpr int N_ADA = 384;
constexpr int N_TWOUT = 1024, N_TDAIN = 2048, N_TMLAIN = 896, N_TQB = 288, N_TKVB = 256, N_TCV = 512;
constexpr int N_ROPE = 128, N_LAM = 1, N_CDK = 1024, N_CCKV = 256, N_CKPE = 64;
constexpr int P0_ITEMS = N_ADA + N_TWOUT + N_TDAIN + N_TMLAIN + N_TQB + N_TKVB + N_TCV + N_ROPE + N_LAM + N_CDK + N_CCKV + N_CKPE;

constexpr int PI_A = N_ADA, PI_D = PI_A + N_TWOUT, PI_M = PI_D + N_TDAIN, PI_Q = PI_M + N_TMLAIN, PI_K = PI_Q + N_TQB, PI_C = PI_K + N_TKVB;
DEVI int prep_map(int set, int n) {
  int lo[4], hi[4];
  if (set == 0)      { lo[0] = 0;          hi[0] = PI_A;        lo[1] = PI_A;       hi[1] = PI_A + 256;  lo[2] = PI_D;        hi[2] = PI_D + 1024; lo[3] = PI_C;       hi[3] = P0_ITEMS; }
  else if (set == 1) { lo[0] = PI_M;       hi[0] = PI_M + 448;  lo[1] = PI_Q;       hi[1] = PI_Q + 144;  lo[2] = PI_K;        hi[2] = PI_K + 128;  lo[3] = PI_A + 256; hi[3] = PI_A + 512; }
  else if (set == 2) { lo[0] = PI_D + 1024; hi[0] = PI_D + 2048; lo[1] = PI_A + 512; hi[1] = PI_A + 768;  lo[2] = 0;           hi[2] = 0;           lo[3] = 0;          hi[3] = 0; }
  else               { lo[0] = PI_M + 448; hi[0] = PI_M + 896;  lo[1] = PI_Q + 144; hi[1] = PI_Q + 288;  lo[2] = PI_K + 128;  hi[2] = PI_K + 256;  lo[3] = PI_A + 768; hi[3] = PI_A + 1024; }
#pragma unroll
  for (int r = 0; r < 4; ++r) {
    const int c = hi[r] - lo[r];
    if (n < c) return lo[r] + n;
    n -= c;
  }
  return -1;
}

DEVI void prep_phase(const Params& P, u16* smem, int set, int bid, int nb) {
  float* fs = (float*)smem;
  const int tid = tidx();
  for (int n = bid; ; n += nb) {
    const int item = prep_map(set, n);
    if (item < 0) break;
    int it = item;
    if (it < N_ADA) {
      const int layer = it / 96, r96 = it % 96, cgp = r96 >> 3, ks = r96 & 7;
      float* sc = fs;
      float* red = fs + 640;
      __syncthreads();
      for (int idx = tid; idx < 640; idx += 256) {
        const int cnd = idx >> 7, k = ks * 128 + (idx & 127);
        const float v = cnd == 0 ? P.in[I_CCTX][k] : P.in[I_C][(cnd - 1) * 1024 + k];
        sc[idx] = silu(v);
      }
      __syncthreads();
      const int c4 = tid & 63, wv_ = tid >> 6;
      const float* wp = P.in[I_WADA] + (size_t)layer * 1024 * 3072 + (size_t)(ks * 128 + wv_ * 32) * 3072 + cgp * 256 + c4 * 4;
      float a[5][4];
#pragma unroll
      for (int c = 0; c < 5; ++c)
#pragma unroll
        for (int q = 0; q < 4; ++q) a[c][q] = 0.f;
#pragma unroll 8
      for (int i = 0; i < 32; ++i) {
        const float4 wv = *(const float4*)(wp + (size_t)i * 3072);
#pragma unroll
        for (int c = 0; c < 5; ++c) {
          const float sv = sc[c * 128 + wv_ * 32 + i];
          a[c][0] += sv * wv.x; a[c][1] += sv * wv.y; a[c][2] += sv * wv.z; a[c][3] += sv * wv.w;
        }
      }
#pragma unroll
      for (int c = 0; c < 5; ++c)
#pragma unroll
        for (int q = 0; q < 4; ++q) red[(wv_ * 5 + c) * 256 + c4 * 4 + q] = a[c][q];
      __syncthreads();
      float* part = (float*)(P.ws + WS_ADAP) + (size_t)((layer * 12 + cgp) * 8) * 1280;
#pragma unroll
      for (int c = 0; c < 5; ++c) {
        const float v = ((red[(0 * 5 + c) * 256 + tid] + red[(1 * 5 + c) * 256 + tid]) + red[(2 * 5 + c) * 256 + tid]) + red[(3 * 5 + c) * 256 + tid];
        part[(size_t)ks * 1280 + c * 256 + tid] = v;
      }
      continue;
    }
    it -= N_ADA;
    if (it < N_TWOUT) {
      const int l = it >> 8, kt = (it >> 4) & 15, nt = it & 15;
      tr_tile(P.in[I_WOUT] + (size_t)l * 1024 * 1024, 1024, kt * 64, nt * 64, 1024,
              (u16*)(P.ws + WS_WOUT) + (size_t)l * 1024 * 1024, 1024, nullptr, fs);
      continue;
    }
    it -= N_TWOUT;
    if (it < N_TDAIN) {
      const int l = it >> 10, kt = (it >> 6) & 15, nt = it & 63;
      tr_tile(P.in[I_DAWIN] + (size_t)l * 1024 * 4096, 4096, kt * 64, nt * 64, 4096,
              (u16*)(P.ws + WS_WDAIN) + (size_t)l * 4096 * 1024, 1024, nullptr, fs);
      continue;
    }
    it -= N_TDAIN;
    if (it < N_TMLAIN) {
      const int l = it / 448, r = it % 448, kt = r / 28, nt = r % 28;
      tr_tile(P.in[I_MWIN] + (size_t)l * 1024 * 1728, 1728, kt * 64, nt * 64, 1728,
              (u16*)(P.ws + WS_WMLAIN) + (size_t)l * 1792 * 1024, 1024, nullptr, fs);
      continue;
    }
    it -= N_TMLAIN;
    if (it < N_TQB) {
      const int l = it / 144, r = it % 144, kt = r / 24, nt = r % 24;
      tr_tile(P.in[I_WQB] + (size_t)l * 384 * 1536, 1536, kt * 64, nt * 64, 1536,
              (u16*)(P.ws + WS_WQB) + (size_t)l * 1536 * 384, 384, P.in[I_GQA] + l * 384, fs);
      continue;
    }
    it -= N_TQB;
    if (it < N_TKVB) {
      const int l = it >> 7, kt = (it >> 5) & 3, nt = it & 31;
      tr_tile(P.in[I_WKVB] + (size_t)l * 256 * 2048, 2048, kt * 64, nt * 64, 2048,
              (u16*)(P.ws + WS_WKVB) + (size_t)l * 2048 * 256, 256, nullptr, fs);
      tr_tile(P.in[I_WKVB] + (size_t)l * 256 * 2048, 2048, kt * 64, nt * 64, 2048,
              (u16*)(P.ws + WS_WKVBG) + (size_t)l * 2048 * 256, 256, P.in[I_GKVA] + l * 256, fs);
      continue;
    }
    it -= N_TKVB;
    if (it < N_TCV) {
      const int grp = it >> 3, sub = it & 7, bl = grp >> 4, jj = (grp >> 3) & 1, h = grp & 7, pt = sub >> 1, et = sub & 1;
      const float* src = P.in[I_CDV] + ((size_t)(bl * 2 + jj) * 256) * 1024 + h * 128;
      u16* dst = (u16*)(P.ws + WS_VTLATD) + (size_t)jj * VTLATD_J + (size_t)(bl * 8 + h) * 128 * 1280 + 1024;
      tr_tile(src, 1024, pt * 64, et * 64, 128, dst, 1280, nullptr, fs);
      continue;
    }
    it -= N_TCV;
    if (it < N_ROPE) {
      const int idx = it * 256 + tid, t = idx >> 5, p = idx & 31, f = p & 15;
      const float inv = exp2f(-(float)f * (13.287712379549449f / 16.f));
      const float pos = (p < 16) ? (float)(t >> 6) : (float)(t & 63);
      float sn, cs;
      sincosf(pos * inv, &sn, &cs);
      float* rc = (float*)(P.ws + WS_ROPE);
      rc[idx] = cs;
      rc[1024 * 32 + idx] = sn;
      continue;
    }
    it -= N_ROPE;
    if (it < N_LAM) {
      if (tid < 2) {
        const int jd = tid;
        float s1 = 0.f, s2 = 0.f;
        for (int d = 0; d < 64; ++d) {
          s1 += P.in[I_LQ1][jd * 64 + d] * P.in[I_LK1][jd * 64 + d];
          s2 += P.in[I_LQ2][jd * 64 + d] * P.in[I_LK2][jd * 64 + d];
        }
        const float li = 0.8f - 0.6f * expf(-0.3f * (float)(2 * jd));
        float* lamv = (float*)(P.ws + WS_MISC);
        lamv[jd * 2] = expf(s1) - expf(s2) + li;
        lamv[jd * 2 + 1] = li;
      }
      continue;
    }
    it -= N_LAM;
    if (it < N_CDK) {
      const size_t e0 = ((size_t)it * 256 + tid) * 8;
      const int col = e0 & 1023, p = (e0 >> 10) & 255, jj = (e0 >> 18) & 1, bl = (int)(e0 >> 19);
      const float4 a = *(const float4*)(P.in[I_CDK] + e0);
      const float4 b = *(const float4*)(P.in[I_CDK] + e0 + 4);
      uint4 u; u.x = pk2(a.x, a.y); u.y = pk2(a.z, a.w); u.z = pk2(b.x, b.y); u.w = pk2(b.z, b.w);
      *(uint4*)((u16*)(P.ws + WS_KDLAT) + (size_t)jj * KDLAT_J + ((size_t)(bl * 1280 + 1024 + p)) * 1024 + col) = u;
      continue;
    }
    it -= N_CDK;
    if (it < N_CCKV) {
      const size_t e0 = ((size_t)it * 256 + tid) * 8;
      const int col = e0 & 255, p = (e0 >> 8) & 255, jj = (e0 >> 16) & 1, bl = (int)(e0 >> 17);
      const float4 a = *(const float4*)(P.in[I_CCKV] + e0);
      const float4 b = *(const float4*)(P.in[I_CCKV] + e0 + 4);
      uint4 u; u.x = pk2(a.x, a.y); u.y = pk2(a.z, a.w); u.z = pk2(b.x, b.y); u.w = pk2(b.z, b.w);
      *(uint4*)((u16*)(P.ws + WS_CKVA) + (size_t)jj * CKVA_J + ((size_t)(4096 + bl * 1280 + 1024 + p)) * 256 + col) = u;
      continue;
    }
    it -= N_CCKV;
    {
      const size_t e0 = ((size_t)it * 256 + tid) * 8;
      const int d = e0 & 63, p = (e0 >> 6) & 255, jj = (e0 >> 14) & 1, bl = (int)(e0 >> 15);
      const float4 a = *(const float4*)(P.in[I_CKPE] + e0);
      const float4 b = *(const float4*)(P.in[I_CKPE] + e0 + 4);
      uint4 u; u.x = pk2(a.x, a.y); u.y = pk2(a.z, a.w); u.z = pk2(b.x, b.y); u.w = pk2(b.z, b.w);
      u16* dst = (u16*)(P.ws + WS_KMLAT) + (size_t)jj * KMLAT_J + ((size_t)(bl * 8) * 1280 + 1024 + p) * 192 + 128 + d;
#pragma unroll
      for (int h = 0; h < 8; ++h) *(uint4*)(dst + (size_t)h * 1280 * 192) = u;
    }
  }
}

DEVI void mla_b_phase(const Params& P, int j, u16* smem) {
  constexpr int NQ = 32 * 12, NKV = 36 * 16, NNORM = 64;
  for (int it = blockIdx.x; it < NKV + NQ + NNORM; it += gridDim.x) {
    if (it < NKV) tile_kvb(P, j, it, smem);
    else if (it < NKV + NQ) tile_qb(P, j, it - NKV, smem);
    else {
      const int lane = tidx() & 63, w = tidx() >> 6;
      const float* ssq = (const float*)(P.ws + WS_SSQKV);
      const float4 gk = *(const float4*)(P.in[I_GKVA] + j * 256 + lane * 4);
      for (int r = w; r < 64; r += 4) {
        const int row = (it - NKV - NQ) * 64 + r;
        const float4 s4 = *(const float4*)(ssq + (size_t)row * 4);
        const float rr = rsqrtf((s4.x + s4.y + s4.z + s4.w) * (1.f / 256.f) + EPS);
        float* p = P.out + OUT_CKV + ((size_t)(((row >> 8) * 2 + j) * 256 + (row & 255))) * 256 + lane * 4;
        float4 v = *(const float4*)((const float*)(P.ws + WS_KVRAW) + (size_t)row * 256 + lane * 4);
        v.x *= rr * gk.x; v.y *= rr * gk.y; v.z *= rr * gk.z; v.w *= rr * gk.w;
        *(float4*)p = v;
      }
    }
  }
}


#define XB_TMO      128
#define XB_XCNT(j)  (256  + 64 * (j))
#define XB_XSUB(j)  (1280 + 64 * (j))
#define XB_XGEN(j)  (2304 + 64 * (j))
#define XB_TOP      3328
#define XB_TOPGEN   3392
#define XCD_BAR_WORDS 3456
#define XB_SPIN_CAP (1u << 22)
#define LAS __attribute__((address_space(3)))
DEVI unsigned xb_ld(unsigned* p) { return __hip_atomic_load(p, __ATOMIC_RELAXED, __HIP_MEMORY_SCOPE_AGENT); }
DEVI unsigned xb_add(unsigned* p, unsigned v) { return __hip_atomic_fetch_add(p, v, __ATOMIC_RELAXED, __HIP_MEMORY_SCOPE_AGENT); }
DEVI unsigned xb_xcc_id() { return (unsigned)__builtin_amdgcn_s_getreg((3 << 11) | 20) & 0xFu; }
#define XB_SPIN(cond, bar) do { unsigned _sp = 0; while (cond) { __builtin_amdgcn_s_sleep(1); \
    if ((++_sp & 255u) == 0u) { if (xb_ld(&(bar)[XB_TMO])) break; if (_sp > XB_SPIN_CAP) { atomicAdd(&(bar)[XB_TMO], 1u); break; } } } } while (0)
struct XcdBarrier { unsigned* bar; unsigned x; volatile LAS unsigned* st; };
DEVI XcdBarrier xcd_barrier_post(unsigned* bar, volatile LAS unsigned* st) {
  XcdBarrier b; b.bar = bar; b.x = xb_xcc_id(); b.st = st;
  if (threadIdx.x == 0) (void)xb_add(&bar[XB_XCNT(b.x)], 1u);
  return b;
}
DEVI void xcd_barrier_complete(unsigned* bar, unsigned x, unsigned& nloc, unsigned& nx) {
  const unsigned G = gridDim.x * gridDim.y * gridDim.z;
  unsigned sum, cnt, mine, sp = 0u;
  for (;;) {
    sum = 0u; cnt = 0u; mine = 0u;
#pragma unroll
    for (unsigned j = 0; j < 16; ++j) { const unsigned c = xb_ld(&bar[XB_XCNT(j)]); sum += c; cnt += (c > 0u) ? 1u : 0u; mine = (j == x) ? c : mine; }
    if (sum == G) break;
    __builtin_amdgcn_s_sleep(1);
    if ((++sp & 255u) == 0u) { if (xb_ld(&bar[XB_TMO])) break; if (sp > XB_SPIN_CAP) { atomicAdd(&bar[XB_TMO], 1u); break; } }
  }
  nloc = mine > 0u ? mine : 1u; nx = cnt > 0u ? cnt : 1u;
}
DEVI void xcd_barrier(const XcdBarrier& b) {
  asm volatile("s_waitcnt vmcnt(0)" ::: "memory");
  __syncthreads();
  if (threadIdx.x == 0) {
    unsigned* bar = b.bar;
    __builtin_amdgcn_s_waitcnt(0);
    unsigned nloc = b.st[0], nx = b.st[1];
    if (nloc == 0u) { xcd_barrier_complete(bar, b.x, nloc, nx); b.st[0] = nloc; b.st[1] = nx; }
    const unsigned old = xb_add(&bar[XB_XSUB(b.x)], 1u);
    const unsigned gen = old / nloc;
    if (old + 1u == (gen + 1u) * nloc) {
      __builtin_amdgcn_fence(__ATOMIC_RELEASE, "agent");
      asm volatile("s_waitcnt vmcnt(0)" ::: "memory");
      const unsigned og = xb_add(&bar[XB_TOP], 1u);
      const unsigned tg = og / nx;
      if (og + 1u == (tg + 1u) * nx) xb_add(&bar[XB_TOPGEN], 1u);
      else XB_SPIN(xb_ld(&bar[XB_TOPGEN]) == tg, bar);
      __builtin_amdgcn_fence(__ATOMIC_ACQUIRE, "agent");
      xb_add(&bar[XB_XGEN(b.x)], 1u);
      asm volatile("s_waitcnt vmcnt(0)" ::: "memory");
    } else {
      XB_SPIN(xb_ld(&bar[XB_XGEN(b.x)]) == gen, bar);
      __builtin_amdgcn_fence(__ATOMIC_ACQUIRE, "agent");
      asm volatile("s_waitcnt vmcnt(0)" ::: "memory");
    }
  }
  __syncthreads();
}

DEVI void ada_reduce_phase(const Params& P) {
  const float* part = (const float*)(P.ws + WS_ADAP);
  float* ada = (float*)(P.ws + WS_ADA);
  for (int i = blockIdx.x * 256 + tidx(); i < 4 * 5 * 768; i += gridDim.x * 256) {
    const int n4 = i % 768, lc = i / 768, c = lc % 5, layer = lc / 5, n = n4 * 4, cgp = n >> 8, col = n & 255;
    float4 sum = *(const float4*)(P.in[I_BADA] + layer * 3072 + n);
    const float* pp = part + (size_t)((layer * 12 + cgp) * 8) * 1280 + c * 256 + col;
#pragma unroll
    for (int q = 0; q < 8; ++q) {
      const float4 v = *(const float4*)(pp + (size_t)q * 1280);
      sum.x += v.x; sum.y += v.y; sum.z += v.z; sum.w += v.w;
    }
    if (n >= 2048) {
      const float4 gp = *(const float4*)(P.in[I_GPOST] + layer * 1024 + (n - 2048));
      sum.x *= gp.x; sum.y *= gp.y; sum.z *= gp.z; sum.w *= gp.w;
    } else if (n >= 1024) {
      const float4 gq = *(const float4*)(P.in[I_GPRE] + layer * 1024 + (n - 1024));
      sum.x = gq.x * (1.f + sum.x); sum.y = gq.y * (1.f + sum.y); sum.z = gq.z * (1.f + sum.z); sum.w = gq.w * (1.f + sum.w);
    }
    *(float4*)(ada + (size_t)(layer * 5 + c) * 3072 + n) = sum;
  }
}

#ifndef EN
#define EN 0xFF
#endif
DEVI void run_phase(const Params& P, int ph, u16* smem) {
  if (ph == 0) { if (EN & 1) prep_phase(P, smem, 0, blockIdx.x, gridDim.x); return; }
  if (ph == 1) { ada_reduce_phase(P); return; }
  if (ph == 2) { if (EN & 2) ew_phase(P, -1); return; }
  ph -= 1;
  int layer, sub;
  if (ph < 6) { layer = 0; sub = ph - 2; }
  else if (ph < 11) { layer = 1; sub = ph - 6; }
  else if (ph < 15) { layer = 2; sub = ph - 11; }
  else { layer = 3; sub = ph - 15; }
  const int j = layer >> 1;
  if ((layer & 1) == 0) {
    if (sub == 0) { if (EN & 4) for (int t = blockIdx.x; t < 32 * 32; t += gridDim.x) tile_diff_in(P, j, t, smem); }
    else if (sub == 1) { if (EN & 8) attn_diff_phase(P, j, smem); }
    else if (sub == 2) {
      if (EN & 16) for (int t = blockIdx.x; t < 32 * 8; t += gridDim.x) tile_out(P, layer, t, smem);
      const int pset = layer == 0 ? 1 : 3;
      if (gridDim.x >= 512) { if (blockIdx.x >= 256) prep_phase(P, smem, pset, blockIdx.x - 256, gridDim.x - 256); }
      else prep_phase(P, smem, pset, blockIdx.x, gridDim.x);
    }
    else { if (EN & 2) ew_phase(P, layer); }
  } else {
    if (sub == 0) { if (EN & 32) for (int t = blockIdx.x; t < 32 * 14; t += gridDim.x) tile_mla_in(P, j, t, smem); }
    else if (sub == 1) { if (EN & 64) mla_b_phase(P, j, smem); }
    else if (sub == 2) { if (EN & 128) attn_mla_phase(P, j, smem); }
    else if (sub == 3) {
      if (EN & 16) for (int t = blockIdx.x; t < 32 * 8; t += gridDim.x) tile_out(P, layer, t, smem);
      if (layer == 1) {
        if (gridDim.x >= 512) { if (blockIdx.x >= 256) prep_phase(P, smem, 2, blockIdx.x - 256, gridDim.x - 256); }
        else prep_phase(P, smem, 2, blockIdx.x, gridDim.x);
      }
    }
    else { if (EN & 2) ew_phase(P, layer); }
  }
}

constexpr int N_PHASES = 21;

__global__ void __launch_bounds__(256, 2) fwd_megakernel(Params P) {
  __shared__ __attribute__((aligned(16))) u16 smem[SMEM_BYTES / 2];
  __shared__ uint4 xb_words;
  if (threadIdx.x == 0) xb_words = make_uint4(0u, 0u, 0u, 0u);
  __syncthreads();
  XcdBarrier xb = xcd_barrier_post((unsigned*)(P.ws + WS_BAR), (volatile LAS unsigned*)&xb_words);
  for (int ph = P.ph_lo; ph < P.ph_hi; ++ph) {
    Params Pl = P;
    {
      size_t zoff = 0;
      asm volatile("" : "+s"(zoff));
      Pl.ws = P.ws + zoff;
      Pl.out = P.out + zoff;
    }
    run_phase(Pl, ph, smem);
#ifdef REP_MASK
    {
      int kind;
      if (ph == 0) kind = 1; else if (ph == 1) kind = 2;
      else { int layer, sub; if (ph < 6) { layer = 0; sub = ph - 2; } else if (ph < 11) { layer = 1; sub = ph - 6; } else if (ph < 15) { layer = 2; sub = ph - 11; } else { layer = 3; sub = ph - 15; }
        if ((layer & 1) == 0) kind = sub == 0 ? 4 : sub == 1 ? 8 : sub == 2 ? 16 : 2;
        else kind = sub == 0 ? 32 : sub == 1 ? 64 : sub == 2 ? 128 : sub == 3 ? 16 : 2; }
      if (kind & REP_MASK) { xcd_barrier(xb); run_phase(Pl, ph, smem); }
    }
#endif
    if (ph + 1 < P.ph_hi) {
      if (P.ph_hi > 1000) cg::this_grid().sync();
      xcd_barrier(xb);
    }
#ifdef EXTRA_SYNCS
    for (int q = 0; q < EXTRA_SYNCS; ++q) xcd_barrier(xb);
#endif
  }
}

extern "C" void kernel_launch(void* const* d_in, const int* in_sizes, int n_in, void* d_out, int out_size, void* d_ws,
                              size_t ws_size, hipStream_t stream) {
  static int grid_blocks = 0;
  if (!grid_blocks) {
    int dev = 0, cus = 0, per_cu = 0;
    (void)hipGetDevice(&dev);
    (void)hipDeviceGetAttribute(&cus, hipDeviceAttributeMultiprocessorCount, dev);
    (void)hipOccupancyMaxActiveBlocksPerMultiprocessor(&per_cu, fwd_megakernel, 256, 0);
    if (per_cu < 1) per_cu = 1;
    if (per_cu > 2) per_cu = 2;
    grid_blocks = cus * per_cu;
  }
  if (hipMemsetAsync((unsigned char*)d_ws + WS_BAR, 0, 16384, stream) != hipSuccess) { fprintf(stderr, "memset failed\n"); return; }
  Params p{};
  for (int i = 0; i < 24; ++i) p.in[i] = (const float*)d_in[i];
  p.out = (float*)d_out;
  p.ws = (unsigned char*)d_ws;
#if MULTI_LAUNCH
  for (int ph = 0; ph < N_PHASES; ++ph) {
    p.ph_lo = ph; p.ph_hi = ph + 1;
    hipLaunchKernelGGL(fwd_megakernel, dim3(grid_blocks), dim3(256), 0, stream, p);
  }
#else
  p.ph_lo = 0; p.ph_hi = N_PHASES;
  void* args[] = {&p};
  hipError_t e = hipLaunchCooperativeKernel((void*)fwd_megakernel, dim3(grid_blocks), dim3(256), args, 0, stream);
  if (e != hipSuccess) fprintf(stderr, "cooperative launch failed: %s (grid %d)\n", hipGetErrorString(e), grid_blocks);
#endif
}
```

```cpp
#include <hip/hip_runtime.h>
#include <hip/hip_cooperative_groups.h>
#include <cstdio>
namespace cg = cooperative_groups;

#ifndef MULTI_LAUNCH
#define MULTI_LAUNCH 0
#endif

typedef unsigned short u16;
typedef __attribute__((ext_vector_type(8))) short bf16x8;
typedef __attribute__((ext_vector_type(4))) float f32x4;
typedef __attribute__((ext_vector_type(4))) unsigned u32x4;
typedef __attribute__((ext_vector_type(2))) unsigned u32x2;

#define DEVI __device__ __forceinline__

struct Params {
  const float* in[24];
  float* out;
  unsigned char* ws;
  int ph_lo, ph_hi;
};

constexpr size_t MBy = 1u << 20;
constexpr size_t WS_WOUT = 0;
constexpr size_t WS_WDAIN = 8 * MBy;
constexpr size_t WS_WMLAIN = 24 * MBy;
constexpr size_t WS_WQB = 31 * MBy;
constexpr size_t WS_WKVB = 34 * MBy;
constexpr size_t WS_WKVBG = 36 * MBy;
constexpr size_t WS_ADA = 38 * MBy;
constexpr size_t WS_ROPE = 39 * MBy;
constexpr size_t WS_MISC = 40 * MBy;
constexpr size_t WS_H = 41 * MBy;
constexpr size_t WS_O = WS_H;
constexpr size_t WS_Q = 57 * MBy;
constexpr size_t WS_T = WS_Q;
constexpr size_t WS_CTXK = 81 * MBy;
constexpr size_t WS_KDLAT = 93 * MBy;
constexpr size_t WS_VTCTX = 113 * MBy;
constexpr size_t WS_VTLATD = 121 * MBy;
constexpr size_t WS_VTLATM = 141 * MBy;
constexpr size_t WS_G = 151 * MBy;
constexpr size_t WS_QA = 167 * MBy;
constexpr size_t WS_CKVA = 173 * MBy;
constexpr size_t WS_SSQQ = 183 * MBy;
constexpr size_t WS_SSQKV = 184 * MBy;
constexpr size_t WS_KMLAT = 185 * MBy;
constexpr size_t WS_KVRAW = 215 * MBy;
constexpr size_t WS_BAR = WS_MISC + 65536;
constexpr size_t WS_ADAP = 219 * MBy;
constexpr size_t KDLAT_J = (size_t)4 * 1280 * 1024;
constexpr size_t VTLATD_J = (size_t)4 * 8 * 128 * 1280;
constexpr size_t CKVA_J = (size_t)9216 * 256;
constexpr size_t KMLAT_J = (size_t)4 * 8 * 1280 * 192;

constexpr size_t OUT_Y = 0;
constexpr size_t OUT_SK = 8388608;
constexpr size_t OUT_SV = 16777216;
constexpr size_t OUT_CKV = 25165824;
constexpr size_t OUT_KPE = 27262976;

constexpr float EPS = 1e-6f;
constexpr float LOG2E = 1.4426950408889634f;

enum { I_XP = 0, I_XS, I_CDK, I_CDV, I_CCKV, I_CKPE, I_C, I_CCTX, I_WADA, I_BADA, I_GPRE, I_GPOST, I_WOUT,
       I_DAWIN, I_LQ1, I_LK1, I_LQ2, I_LK2, I_GSUB, I_MWIN, I_GQA, I_WQB, I_GKVA, I_WKVB };

DEVI int tidx() { int t = threadIdx.x; asm volatile("" : "+v"(t)); return t; }
DEVI u16 f2bf(float f) {
  unsigned u = __float_as_uint(f);
  u += 0x7fffu + ((u >> 16) & 1u);
  return (u16)(u >> 16);
}
typedef __attribute__((ext_vector_type(2))) float f32x2_t;
typedef __attribute__((ext_vector_type(2))) __bf16 bf16x2_t;
DEVI unsigned pk2(float a, float b) {
  f32x2_t v = {a, b};
  bf16x2_t r = __builtin_convertvector(v, bf16x2_t);
  return __builtin_bit_cast(unsigned, r);
}
DEVI float bf2f(unsigned v) { return __uint_as_float(v << 16); }
DEVI void st_bf4(u16* p, f32x4 v) {
  uint2 u; u.x = pk2(v[0], v[1]); u.y = pk2(v[2], v[3]);
  *(uint2*)p = u;
}
DEVI void st_pair(u16* p, int g, f32x4 a, f32x4 b) {
  const bool odd = g & 1;
  f32x4 send, recv;
#pragma unroll
  for (int i = 0; i < 4; ++i) send[i] = odd ? a[i] : b[i];
#pragma unroll
  for (int i = 0; i < 4; ++i) recv[i] = __shfl_xor(send[i], 16, 64);
  f32x4 lo, hi;
#pragma unroll
  for (int i = 0; i < 4; ++i) { lo[i] = odd ? recv[i] : a[i]; hi[i] = odd ? b[i] : recv[i]; }
  u32x4 u;
  u[0] = pk2(lo[0], lo[1]); u[1] = pk2(lo[2], lo[3]); u[2] = pk2(hi[0], hi[1]); u[3] = pk2(hi[2], hi[3]);
  *(u32x4*)(p + (odd ? 16 : 0) + (g >> 1) * 8) = u;
}
DEVI void st_f4(float* p, f32x4 v) { *(float4*)p = make_float4(v[0], v[1], v[2], v[3]); }
DEVI f32x4 mfma16(bf16x8 a, bf16x8 b, f32x4 c) { return __builtin_amdgcn_mfma_f32_16x16x32_bf16(a, b, c, 0, 0, 0); }
DEVI float silu(float x) { return x * __builtin_amdgcn_rcpf(1.f + __builtin_amdgcn_exp2f(-1.4426950408889634f * x)); }
DEVI float xshfl(float v, int m) { return __shfl_xor(v, m, 64); }

DEVI void rope4(f32x4& x1, f32x4& x2, const float* cs, const float* sn) {
  float4 c = *(const float4*)cs; float4 s = *(const float4*)sn;
  f32x4 a = x1, b = x2;
  x1[0] = a[0] * c.x - b[0] * s.x; x2[0] = a[0] * s.x + b[0] * c.x;
  x1[1] = a[1] * c.y - b[1] * s.y; x2[1] = a[1] * s.y + b[1] * c.y;
  x1[2] = a[2] * c.z - b[2] * s.z; x2[2] = a[2] * s.z + b[2] * c.z;
  x1[3] = a[3] * c.w - b[3] * s.w; x2[3] = a[3] * s.w + b[3] * c.w;
}

constexpr int LDT = 64;
constexpr int TILE_ELEMS = 128 * LDT;
constexpr int SMEM_BYTES = 2 * (64 * 144 + 128 * 72) * 2;

template <bool SWAP>
DEVI void gemm_core(const u16* __restrict__ A, int lda, const u16* __restrict__ B, int ldb, int K,
                    int m0, int n0, u16* smem, f32x4 (&acc)[8][4]) {
  const int tid = tidx(), lane = tid & 63, w = tid >> 6;
  const int wm = w >> 1, wn = w & 1;
  const int g = lane >> 4, li = lane & 15;
  u16* As = smem;
  u16* Bs = smem + 256 * 64;
  const int lr = tid >> 3, lc = (tid & 7) * 8;
  const u16* ap = A + (size_t)(m0 + lr) * lda + lc;
  const u16* bp = B + (size_t)(n0 + lr) * ldb + lc;
  const int wsw = (((tid & 7) ^ (lr & 7)) * 8);
  u16* sa = As + lr * 64 + wsw;
  u16* sb = Bs + lr * 64 + wsw;
  const int rs0 = ((g ^ (li & 7)) * 8), rs1 = (((4 + g) ^ (li & 7)) * 8);
  const u16* Ard = As + (wm * 128 + li) * 64;
  const u16* Brd = Bs + (wn * 64 + li) * 64;
  u32x4 ra[8], rb[4];
#define GLOAD(KT_) { const int k0_ = (KT_) << 6; \
    _Pragma("unroll") for (int i = 0; i < 8; ++i) ra[i] = *(const u32x4*)(ap + (size_t)i * 32 * lda + k0_); \
    _Pragma("unroll") for (int i = 0; i < 4; ++i) rb[i] = *(const u32x4*)(bp + (size_t)i * 32 * ldb + k0_); }
#define SSTORE() { _Pragma("unroll") for (int i = 0; i < 8; ++i) *(u32x4*)(sa + 32 * i * 64) = ra[i]; \
    _Pragma("unroll") for (int i = 0; i < 4; ++i) *(u32x4*)(sb + 32 * i * 64) = rb[i]; }
#define FRAGS(RS) { _Pragma("unroll") for (int t = 0; t < 8; ++t) fa[t] = *(const bf16x8*)(Ard + t * 16 * 64 + (RS)); \
    _Pragma("unroll") for (int t = 0; t < 4; ++t) fb[t] = *(const bf16x8*)(Brd + t * 16 * 64 + (RS)); }
#define MMA() _Pragma("unroll") for (int mt = 0; mt < 8; ++mt) _Pragma("unroll") for (int nt = 0; nt < 4; ++nt) \
      acc[mt][nt] = SWAP ? mfma16(fb[nt], fa[mt], acc[mt][nt]) : mfma16(fa[mt], fb[nt], acc[mt][nt]);
  const int KT = K >> 6;
  bf16x8 fa[8], fb[4];
  GLOAD(0);
  for (int kt = 0; kt < KT; ++kt) {
    __syncthreads();
    SSTORE();
    __syncthreads();
    GLOAD((kt + 1 < KT ? kt + 1 : KT - 1));
    FRAGS(rs0);
    __builtin_amdgcn_sched_barrier(0);
    MMA();
    __builtin_amdgcn_sched_barrier(0);
    FRAGS(rs1);
    __builtin_amdgcn_sched_barrier(0);
    MMA();
  }
#undef GLOAD
#undef SSTORE
#undef FRAGS
#undef MMA
}

DEVI void zero_acc(f32x4 (&acc)[8][4]) {
#pragma unroll
  for (int i = 0; i < 8; ++i)
#pragma unroll
    for (int k = 0; k < 4; ++k) acc[i][k] = (f32x4){0.f, 0.f, 0.f, 0.f};
}


DEVI int xcd_remap(int l, int total) {
  int q = l >> 3;
  if ((q | 63) < (total >> 3))
    q = (q & ~63) | ((((q & 63) / 8) >> 1) * 16) | (((q & 63) % 8) << 1) | (((q & 63) / 8) & 1);
  return (l & 7) * (total >> 3) + q;
}
DEVI void patch_tile(int v, int NT, int PN, int& mt, int& nt) {
  const int psz = 4 * PN, p = v / psz, i = v - p * psz, npn = NT / PN;
  const int pm = p / npn, pn = p - pm * npn;
  const int im = i / PN, in = i - im * PN;
  mt = pm * 4 + im;
  nt = pn * PN + in;
}

DEVI void tile_diff_in(const Params& P, int j, int tile, u16* smem) {
  int tm_, tn_; patch_tile(xcd_remap(tile, 1024), 32, 8, tm_, tn_);
  const int m0 = tm_ * 256, n0 = tn_ * 128;
  const int region = n0 >> 10;
  const u16* A = (const u16*)(P.ws + WS_H);
  const u16* B = (const u16*)(P.ws + WS_WDAIN) + (size_t)j * 4096 * 1024;
  f32x4 acc[8][4];
  zero_acc(acc);
  if (region == 2) gemm_core<false>(A, 1024, B, 1024, 1024, m0, n0, smem, acc);
  else gemm_core<true>(A, 1024, B, 1024, 1024, m0, n0, smem, acc);

  const int lane = tidx() & 63, w = tidx() >> 6, wm = w >> 1, wn = w & 1, g = lane >> 4, li = lane & 15;
  const int mb = m0 + wm * 128, nb = n0 + wn * 64;
  const bool isLat = mb >= 4096;
  const int b = mb >> 8, sb = mb & 255, bl = (mb - 4096) >> 10, tb = (mb - 4096) & 1023;
  const float* ropeC = (const float*)(P.ws + WS_ROPE);
  const float* ropeS = ropeC + 1024 * 32;
  if (region == 2) {
    const int cbase = nb - 2048;
    u16* vtc = (u16*)(P.ws + WS_VTCTX);
    u16* vtl = (u16*)(P.ws + WS_VTLATD) + (size_t)j * VTLATD_J;
#pragma unroll
    for (int mt = 0; mt < 8; ++mt) {
      const int r0 = mt * 16 + g * 4;
#pragma unroll
      for (int nt = 0; nt < 4; ++nt) {
        const int col = cbase + nt * 16 + li, h = col >> 7, e = col & 127;
        if (!isLat) {
          const int s = sb + r0;
          float* sv = P.out + OUT_SV + ((size_t)((b * 2 + j) * 256 + s)) * 1024 + col;
#pragma unroll
          for (int jj = 0; jj < 4; ++jj) sv[(size_t)jj * 1024] = acc[mt][nt][jj];
          st_bf4(vtc + ((size_t)((b * 8 + h) * 128 + e)) * 256 + s, acc[mt][nt]);
        } else {
          const int t = tb + r0;
          st_bf4(vtl + ((size_t)((bl * 8 + h) * 128 + e)) * 1280 + t, acc[mt][nt]);
        }
      }
    }
  } else {
    const float qs = 0.125f * LOG2E;
#pragma unroll
    for (int mt = 0; mt < 8; ++mt) {
      const int rl = mt * 16 + li, row = mb + rl;
      if (region <= 1 && isLat) {
        const int t = tb + rl;
#pragma unroll
        for (int nt = 0; nt < 2; ++nt)
          rope4(acc[mt][nt], acc[mt][nt + 2], ropeC + t * 32 + nt * 16 + g * 4, ropeS + t * 32 + nt * 16 + g * 4);
      }
      if (region == 1 && !isLat) {
#pragma unroll
        for (int nt = 0; nt < 4; ++nt)
          st_f4(P.out + OUT_SK + ((size_t)((b * 2 + j) * 256 + sb + rl)) * 1024 + (nb - 1024) + nt * 16 + g * 4, acc[mt][nt]);
      }
      u16* dst;
      if (region == 0) dst = (u16*)(P.ws + WS_Q) + (size_t)row * 1024 + nb;
      else if (region == 1) dst = isLat ? (u16*)(P.ws + WS_KDLAT) + (size_t)j * KDLAT_J + ((size_t)(bl * 1280 + tb + rl)) * 1024 + (nb - 1024)
                                        : (u16*)(P.ws + WS_CTXK) + (size_t)row * 1024 + (nb - 1024);
      else dst = (u16*)(P.ws + WS_G) + (size_t)row * 1024 + (nb - 3072);
#pragma unroll
      for (int np = 0; np < 2; ++np) {
        f32x4 va = acc[mt][2 * np], vb = acc[mt][2 * np + 1];
        if (region == 0) { va *= qs; vb *= qs; }
        else if (region == 3) {
#pragma unroll
          for (int jj = 0; jj < 4; ++jj) { va[jj] = silu(va[jj]); vb[jj] = silu(vb[jj]); }
        }
        st_pair(dst + np * 32, g, va, vb);
      }
    }
  }
}

DEVI void tile_mla_in(const Params& P, int j, int tile, u16* smem) {
  int tm_, tn_; patch_tile(xcd_remap(tile, 448), 14, 7, tm_, tn_);
  const int m0 = tm_ * 256, n0 = tn_ * 128;
  const u16* A = (const u16*)(P.ws + WS_H);
  const u16* B = (const u16*)(P.ws + WS_WMLAIN) + (size_t)j * 1792 * 1024;
  f32x4 acc[8][4];
  zero_acc(acc);
  gemm_core<true>(A, 1024, B, 1024, 1024, m0, n0, smem, acc);

  const int lane = tidx() & 63, w = tidx() >> 6, wm = w >> 1, wn = w & 1, g = lane >> 4, li = lane & 15;
  const int mb = m0 + wm * 128, nb = n0 + wn * 64;
  const bool isLat = mb >= 4096;
  const int b = mb >> 8, sb = mb & 255, bl = (mb - 4096) >> 10, tb = (mb - 4096) & 1023;
  const float* ropeC = (const float*)(P.ws + WS_ROPE);
  const float* ropeS = ropeC + 1024 * 32;
  if (nb >= 1728) return;
#pragma unroll
  for (int mt = 0; mt < 8; ++mt) {
    const int rl = mt * 16 + li, row = mb + rl;
    if (nb < 640) {
      float ss = 0.f;
#pragma unroll
      for (int nt = 0; nt < 4; ++nt)
#pragma unroll
        for (int jj = 0; jj < 4; ++jj) ss += acc[mt][nt][jj] * acc[mt][nt][jj];
      ss += xshfl(ss, 16);
      ss += xshfl(ss, 32);
      if (nb < 384) {
        if (g == 0) ((float*)(P.ws + WS_SSQQ))[row * 8 + (nb >> 6)] = ss;
#pragma unroll
        for (int np = 0; np < 2; ++np)
          st_pair((u16*)(P.ws + WS_QA) + (size_t)row * 384 + nb + np * 32, g, acc[mt][2 * np], acc[mt][2 * np + 1]);
      } else {
        if (g == 0) ((float*)(P.ws + WS_SSQKV))[row * 4 + ((nb - 384) >> 6)] = ss;
        const int arow = isLat ? (4096 + bl * 1280 + tb + rl) : row;
#pragma unroll
        for (int nt = 0; nt < 4; ++nt) {
          const int c2 = nb - 384 + nt * 16 + g * 4;
          if (!isLat) st_f4((float*)(P.ws + WS_KVRAW) + (size_t)row * 256 + c2, acc[mt][nt]);
        }
#pragma unroll
        for (int np = 0; np < 2; ++np)
          st_pair((u16*)(P.ws + WS_CKVA) + (size_t)j * CKVA_J + (size_t)arow * 256 + (nb - 384) + np * 32, g, acc[mt][2 * np], acc[mt][2 * np + 1]);
      }
    } else if (nb == 640) {
      if (isLat) {
        const int t = tb + rl;
#pragma unroll
        for (int nt = 0; nt < 2; ++nt)
          rope4(acc[mt][nt], acc[mt][nt + 2], ropeC + t * 32 + nt * 16 + g * 4, ropeS + t * 32 + nt * 16 + g * 4);
      }
#pragma unroll
      for (int nt = 0; nt < 4; ++nt) {
        const int d = nt * 16 + g * 4;
        if (!isLat) {
          st_f4(P.out + OUT_KPE + ((size_t)((b * 2 + j) * 256 + sb + rl)) * 64 + d, acc[mt][nt]);
          u16* kd = (u16*)(P.ws + WS_CTXK) + ((size_t)(b * 8) * 256 + sb + rl) * 192 + 128 + d;
#pragma unroll
          for (int h = 0; h < 8; ++h) st_bf4(kd + (size_t)h * 256 * 192, acc[mt][nt]);
        } else {
          u16* kd = (u16*)(P.ws + WS_KMLAT) + (size_t)j * KMLAT_J + ((size_t)(bl * 8) * 1280 + tb + rl) * 192 + 128 + d;
#pragma unroll
          for (int h = 0; h < 8; ++h) st_bf4(kd + (size_t)h * 1280 * 192, acc[mt][nt]);
        }
      }
    } else {
#pragma unroll
      for (int np = 0; np < 2; ++np) {
        f32x4 va = acc[mt][2 * np], vb = acc[mt][2 * np + 1];
#pragma unroll
        for (int jj = 0; jj < 4; ++jj) { va[jj] = silu(va[jj]); vb[jj] = silu(vb[jj]); }
        st_pair((u16*)(P.ws + WS_G) + (size_t)row * 1024 + (nb - 704) + np * 32, g, va, vb);
      }
    }
  }
}

DEVI void tile_qb(const Params& P, int j, int tile, u16* smem) {
  int tm_, tn_; patch_tile(xcd_remap(tile, 384), 12, 6, tm_, tn_);
  const int m0 = tm_ * 256, n0 = tn_ * 128;
  const u16* A = (const u16*)(P.ws + WS_QA);
  const u16* B = (const u16*)(P.ws + WS_WQB) + (size_t)j * 1536 * 384;
  f32x4 acc[8][4];
  zero_acc(acc);
  gemm_core<true>(A, 384, B, 384, 384, m0, n0, smem, acc);
  const int lane = tidx() & 63, w = tidx() >> 6, wm = w >> 1, wn = w & 1, g = lane >> 4, li = lane & 15;
  const int mb = m0 + wm * 128, nb = n0 + wn * 64;
  const bool isLat = mb >= 4096;
  const int tb = (mb - 4096) & 1023;
  const float* ropeC = (const float*)(P.ws + WS_ROPE);
  const float* ropeS = ropeC + 1024 * 32;
  const float* ssq = (const float*)(P.ws + WS_SSQQ);
  const bool isRope = (nb % 192) == 128;
  const float qs = 0.07216878364870322f * LOG2E;
#pragma unroll
  for (int mt = 0; mt < 8; ++mt) {
    const int rl = mt * 16 + li, row = mb + rl;
    float ss = 0.f;
#pragma unroll
    for (int i = 0; i < 6; ++i) ss += ssq[row * 8 + i];
    const float r = rsqrtf(ss * (1.f / 384.f) + EPS) * qs;
    if (isRope && isLat) {
      const int t = tb + rl;
#pragma unroll
      for (int nt = 0; nt < 2; ++nt)
        rope4(acc[mt][nt], acc[mt][nt + 2], ropeC + t * 32 + nt * 16 + g * 4, ropeS + t * 32 + nt * 16 + g * 4);
    }
#pragma unroll
    for (int np = 0; np < 2; ++np)
      st_pair((u16*)(P.ws + WS_Q) + (size_t)row * 1536 + nb + np * 32, g, acc[mt][2 * np] * r, acc[mt][2 * np + 1] * r);
  }
}

DEVI void tile_kvb(const Params& P, int j, int tile, u16* smem) {
  int tm_, tn_; patch_tile(xcd_remap(tile, 576), 16, 8, tm_, tn_);
  const int m0 = tm_ * 256, n0 = tn_ * 128;
  const bool tileLat = m0 >= 4096;
  const bool fresh = !tileLat || ((m0 - 4096) % 1280) < 1024;
  const u16* A = (const u16*)(P.ws + WS_CKVA) + (size_t)j * CKVA_J;
  const u16* B = (const u16*)(P.ws + (fresh ? WS_WKVBG : WS_WKVB)) + (size_t)j * 2048 * 256;
  const bool isV = (n0 >> 7) & 1;
  const int h = n0 >> 8;
  f32x4 acc[8][4];
  zero_acc(acc);
  if (isV) gemm_core<false>(A, 256, B, 256, 256, m0, n0, smem, acc);
  else gemm_core<true>(A, 256, B, 256, 256, m0, n0, smem, acc);
  const int lane = tidx() & 63, w = tidx() >> 6, wm = w >> 1, wn = w & 1, g = lane >> 4, li = lane & 15;
  const int mb = m0 + wm * 128;
  int b, keyb, Sk, tokb;
  u16 *Kd, *Vd;
  if (!tileLat) {
    b = mb >> 8; keyb = mb & 255; Sk = 256; tokb = mb;
    Kd = (u16*)(P.ws + WS_CTXK); Vd = (u16*)(P.ws + WS_VTCTX);
  } else {
    const int r2 = mb - 4096;
    b = r2 / 1280; keyb = r2 % 1280; Sk = 1280; tokb = 4096 + b * 1024 + keyb;
    Kd = (u16*)(P.ws + WS_KMLAT) + (size_t)j * KMLAT_J; Vd = (u16*)(P.ws + WS_VTLATM);
  }
  const float* ssq = (const float*)(P.ws + WS_SSQKV);
  if (!isV) {
#pragma unroll
    for (int mt = 0; mt < 8; ++mt) {
      const int rl = mt * 16 + li;
      float r = 1.f;
      if (fresh) {
        const float4 s4 = *(const float4*)(ssq + (size_t)(tokb + rl) * 4);
        r = rsqrtf((s4.x + s4.y + s4.z + s4.w) * (1.f / 256.f) + EPS);
      }
#pragma unroll
      for (int np = 0; np < 2; ++np)
        st_pair(Kd + ((size_t)((b * 8 + h) * Sk + keyb + rl)) * 192 + wn * 64 + np * 32, g, acc[mt][2 * np] * r, acc[mt][2 * np + 1] * r);
    }
  } else {
#pragma unroll
    for (int mt = 0; mt < 8; ++mt) {
      const int r0 = mt * 16 + g * 4;
      f32x4 rr = {1.f, 1.f, 1.f, 1.f};
      if (fresh) {
#pragma unroll
        for (int jj = 0; jj < 4; ++jj) {
          const float4 s4 = *(const float4*)(ssq + (size_t)(tokb + r0 + jj) * 4);
          rr[jj] = rsqrtf((s4.x + s4.y + s4.z + s4.w) * (1.f / 256.f) + EPS);
        }
      }
#pragma unroll
      for (int nt = 0; nt < 4; ++nt) {
        const int e = wn * 64 + nt * 16 + li;
        st_bf4(Vd + ((size_t)((b * 8 + h) * 128 + e)) * Sk + keyb + r0, acc[mt][nt] * rr);
      }
    }
  }
}

DEVI void tile_out(const Params& P, int layer, int tile, u16* smem) {
  int tm_, tn_; patch_tile(xcd_remap(tile, 256), 8, 8, tm_, tn_);
  const int m0 = tm_ * 256, n0 = tn_ * 128;
  const u16* A = (const u16*)(P.ws + WS_O);
  const u16* B = (const u16*)(P.ws + WS_WOUT) + (size_t)layer * 1024 * 1024;
  f32x4 acc[8][4];
  zero_acc(acc);
  gemm_core<true>(A, 1024, B, 1024, 1024, m0, n0, smem, acc);
  const int lane = tidx() & 63, w = tidx() >> 6, wm = w >> 1, wn = w & 1, g = lane >> 4, li = lane & 15;
  const int mb = m0 + wm * 128, nb = n0 + wn * 64;
  u16* T = (u16*)(P.ws + WS_T);
#pragma unroll
  for (int mt = 0; mt < 8; ++mt)
#pragma unroll
    for (int np = 0; np < 2; ++np)
      st_pair(T + (size_t)(mb + mt * 16 + li) * 1024 + nb + np * 32, g, acc[mt][2 * np], acc[mt][2 * np + 1]);
}

template <bool DIFF>
DEVI void attn_item(const Params& P, const u16* __restrict__ Qb, int ldq, int qrow0,
                    const u16* __restrict__ Kb, int ldk, const u16* __restrict__ Vt, int Sk,
                    int h, float lam, float lam_init, const float* gsub, u16* smem) {
  constexpr int KW = DIFF ? 128 : 192;
  constexpr int KLD = KW + 16;
  constexpr int NKK = DIFF ? 2 : 6;
  constexpr int KT = DIFF ? 64 : 32;
  constexpr int NS = KT / 16;
  constexpr int NU = KT / 32;
  constexpr int KCH = KW / 8;
  constexpr int NKL = (KT * KCH) / 256;
  constexpr int VCH = KT / 8;
  constexpr int NVL = (128 * VCH) / 256;
  constexpr int VLD = KT + 8;
  constexpr int STAGE = KT * KLD + 128 * VLD;
  const int tid = tidx(), lane = tid & 63, w = tid >> 6, g = lane >> 4, li = lane & 15;

  bf16x8 qf[2][NKK];
#pragma unroll
  for (int s = 0; s < 2; ++s) {
    const int qrow = DIFF ? (qrow0 + w * 16 + li) : (qrow0 + w * 32 + s * 16 + li);
    const int qcol = DIFF ? (h * 128 + s * 64) : (h * 192);
#pragma unroll
    for (int kk = 0; kk < NKK; ++kk)
      qf[s][kk] = *(const bf16x8*)(Qb + (size_t)qrow * ldq + qcol + kk * 32 + g * 8);
  }
  f32x4 oacc[2][8];
#pragma unroll
  for (int s = 0; s < 2; ++s)
#pragma unroll
    for (int et = 0; et < 8; ++et) oacc[s][et] = (f32x4){0.f, 0.f, 0.f, 0.f};
  float mrow[2] = {0.f, 0.f}, lrow[2] = {0.f, 0.f};

  u32x4 rk[NKL], rv[NVL];
  auto gload = [&](int key0) {
#pragma unroll
    for (int i = 0; i < NKL; ++i) {
      const int c = tid + 256 * i, r = c / KCH, cc = c % KCH;
      rk[i] = *(const u32x4*)(Kb + (size_t)(key0 + r) * ldk + cc * 8);
    }
#pragma unroll
    for (int i = 0; i < NVL; ++i) {
      const int c = tid + 256 * i, r = c / VCH, cc = c % VCH;
      rv[i] = *(const u32x4*)(Vt + (size_t)r * Sk + key0 + cc * 8);
    }
  };
  auto sstore = [&](int buf) {
    u16* Kw = smem + buf * STAGE;
    u16* Vw = Kw + KT * KLD;
#pragma unroll
    for (int i = 0; i < NKL; ++i) {
      const int c = tid + 256 * i, r = c / KCH, cc = c % KCH;
      *(u32x4*)(Kw + r * KLD + cc * 8) = rk[i];
    }
#pragma unroll
    for (int i = 0; i < NVL; ++i) {
      const int c = tid + 256 * i, r = c / VCH, cc = c % VCH;
      *(u32x4*)(Vw + r * VLD + cc * 8) = rv[i];
    }
  };
  const int NT = Sk / KT;
  gload(0);
  __syncthreads();
  sstore(0);
  gload(NT > 1 ? KT : 0);
  __syncthreads();
  for (int kt0 = 0; kt0 < NT; ++kt0) {
    const u16* Ks = smem + (kt0 & 1) * STAGE;
    const u16* Vs = Ks + KT * KLD;
    if (kt0 + 1 < NT) {
      sstore((kt0 + 1) & 1);
      gload((kt0 + 2 < NT ? kt0 + 2 : NT - 1) * KT);
    }

    f32x4 st[2][NS];
#pragma unroll
    for (int s = 0; s < 2; ++s)
#pragma unroll
      for (int kt = 0; kt < NS; ++kt) { const float ni = -mrow[s]; st[s][kt] = (f32x4){ni, ni, ni, ni}; }
    {
      constexpr int NF = DIFF ? NKK * NS * 2 : NKK * NS;
      auto kaddr = [&](int f) -> const u16* {
        if (DIFF) { const int s2 = f & 1, kt = (f >> 1) % NS, kk = (f >> 1) / NS; return Ks + (kt * 16 + li) * KLD + s2 * 64 + kk * 32 + g * 8; }
        else { const int kt = f % NS, kk = f / NS; return Ks + (kt * 16 + li) * KLD + kk * 32 + g * 8; }
      };
      bf16x8 kf[3];
      kf[0] = *(const bf16x8*)kaddr(0);
      kf[1] = *(const bf16x8*)kaddr(1);
#pragma unroll
      for (int f = 0; f < NF; ++f) {
        if (f + 2 < NF) kf[(f + 2) % 3] = *(const bf16x8*)kaddr(f + 2);
        __builtin_amdgcn_sched_barrier(0);
        if (DIFF) {
          const int s2 = f & 1, kt = (f >> 1) % NS, kk = (f >> 1) / NS;
          st[s2][kt] = mfma16(kf[f % 3], qf[s2][kk], st[s2][kt]);
        } else {
          const int kt = f % NS, kk = f / NS;
          st[0][kt] = mfma16(kf[f % 3], qf[0][kk], st[0][kt]);
          st[1][kt] = mfma16(kf[f % 3], qf[1][kk], st[1][kt]);
        }
        __builtin_amdgcn_sched_barrier(0);
      }
    }
    bf16x8 pf[2][NU];
#pragma unroll
    for (int s = 0; s < 2; ++s) {
      float mx = st[s][0][0];
#pragma unroll
      for (int kt = 0; kt < NS; ++kt)
#pragma unroll
        for (int jj = 0; jj < 4; ++jj) mx = fmaxf(mx, st[s][kt][jj]);
      mx = fmaxf(mx, xshfl(mx, 16));
      mx = fmaxf(mx, xshfl(mx, 32));
      const bool first = (kt0 == 0);
      const bool need = first || (mx > 8.f);
      if (__builtin_amdgcn_ballot_w64(need) != 0ull) {
        const float d = need ? mx : 0.f;
        mrow[s] += d;
        if (!first) {
          const float alpha = __builtin_amdgcn_exp2f(-d);
          lrow[s] *= alpha;
#pragma unroll
          for (int et = 0; et < 8; ++et) oacc[s][et] *= alpha;
        }
#pragma unroll
        for (int kt = 0; kt < NS; ++kt) st[s][kt] -= d;
      }
      float ps = 0.f;
#pragma unroll
      for (int kt = 0; kt < NS; ++kt)
#pragma unroll
        for (int jj = 0; jj < 4; ++jj) {
          const float p = __builtin_amdgcn_exp2f(st[s][kt][jj]);
          st[s][kt][jj] = p;
          ps += p;
        }
      lrow[s] += ps;
#pragma unroll
      for (int u = 0; u < NU; ++u) {
        union { bf16x8 v; unsigned d[4]; } pu;
        pu.d[0] = pk2(st[s][2 * u][0], st[s][2 * u][1]);
        pu.d[1] = pk2(st[s][2 * u][2], st[s][2 * u][3]);
        pu.d[2] = pk2(st[s][2 * u + 1][0], st[s][2 * u + 1][1]);
        pu.d[3] = pk2(st[s][2 * u + 1][2], st[s][2 * u + 1][3]);
        pf[s][u] = pu.v;
      }
    }
    {
      constexpr int NF = NU * 8;
      union VU { bf16x8 v; u32x2 d[2]; };
      VU vf[3];
      auto vload = [&](VU& o, int f) {
        const int u = f >> 3, et = f & 7;
        o.d[0] = *(const u32x2*)(Vs + (et * 16 + li) * VLD + (2 * u) * 16 + g * 4);
        o.d[1] = *(const u32x2*)(Vs + (et * 16 + li) * VLD + (2 * u + 1) * 16 + g * 4);
      };
      vload(vf[0], 0);
      vload(vf[1], 1);
#pragma unroll
      for (int f = 0; f < NF; ++f) {
        if (f + 2 < NF) vload(vf[(f + 2) % 3], f + 2);
        __builtin_amdgcn_sched_barrier(0);
        const int u = f >> 3, et = f & 7;
        oacc[0][et] = mfma16(vf[f % 3].v, pf[0][u], oacc[0][et]);
        oacc[1][et] = mfma16(vf[f % 3].v, pf[1][u], oacc[1][et]);
        __builtin_amdgcn_sched_barrier(0);
      }
    }
    __syncthreads();
  }
#pragma unroll
  for (int s = 0; s < 2; ++s) {
    lrow[s] += xshfl(lrow[s], 16);
    lrow[s] += xshfl(lrow[s], 32);
  }
  const u16* G = (const u16*)(P.ws + WS_G);
  u16* O = (u16*)(P.ws + WS_O);
  if (DIFF) {
    const float i0 = 1.f / lrow[0], i1 = lam / lrow[1];
    float ss = 0.f;
#pragma unroll
    for (int et = 0; et < 8; ++et) {
      oacc[0][et] = oacc[0][et] * i0 - oacc[1][et] * i1;
#pragma unroll
      for (int jj = 0; jj < 4; ++jj) ss += oacc[0][et][jj] * oacc[0][et][jj];
    }
    ss += xshfl(ss, 16);
    ss += xshfl(ss, 32);
    const float rr = rsqrtf(ss * (1.f / 128.f) + EPS) * (1.f - lam_init);
    const size_t tok = (size_t)(qrow0 + w * 16 + li);
#pragma unroll
    for (int et = 0; et < 8; ++et) {
      const int e = et * 16 + g * 4;
      const float4 gs = *(const float4*)(gsub + e);
      const uint2 gg = *(const uint2*)(G + tok * 1024 + h * 128 + e);
      f32x4 v = oacc[0][et] * rr;
      v[0] *= gs.x * bf2f(gg.x & 0xffffu);
      v[1] *= gs.y * bf2f(gg.x >> 16);
      v[2] *= gs.z * bf2f(gg.y & 0xffffu);
      v[3] *= gs.w * bf2f(gg.y >> 16);
      st_bf4(O + tok * 1024 + h * 128 + e, v);
    }
  } else {
#pragma unroll
    for (int s = 0; s < 2; ++s) {
      const float inv = 1.f / lrow[s];
      const size_t tok = (size_t)(qrow0 + w * 32 + s * 16 + li);
#pragma unroll
      for (int et = 0; et < 8; ++et) {
        const int e = et * 16 + g * 4;
        const uint2 gg = *(const uint2*)(G + tok * 1024 + h * 128 + e);
        f32x4 v = oacc[s][et] * inv;
        v[0] *= bf2f(gg.x & 0xffffu);
        v[1] *= bf2f(gg.x >> 16);
        v[2] *= bf2f(gg.y & 0xffffu);
        v[3] *= bf2f(gg.y >> 16);
        st_bf4(O + tok * 1024 + h * 128 + e, v);
      }
    }
  }
}

DEVI void attn_diff_phase(const Params& P, int j, u16* smem) {
  const float* lamv = (const float*)(P.ws + WS_MISC);
  const float lam = lamv[j * 2], lam_init = lamv[j * 2 + 1];
  const float* gsub = P.in[I_GSUB] + j * 128;
  const u16* Q = (const u16*)(P.ws + WS_Q);
  for (int it = blockIdx.x; it < 1024; it += gridDim.x) {
    if (it < 512) {
      const int iv = xcd_remap(it, 512);
      const int bl = iv >> 7, h = (iv >> 4) & 7, qt = iv & 15;
      const u16* Kb = (const u16*)(P.ws + WS_KDLAT) + (size_t)j * KDLAT_J + (size_t)bl * 1280 * 1024 + h * 128;
      const u16* Vt = (const u16*)(P.ws + WS_VTLATD) + (size_t)j * VTLATD_J + (size_t)(bl * 8 + h) * 128 * 1280;
      attn_item<true>(P, Q, 1024, 4096 + bl * 1024 + qt * 64, Kb, 1024, Vt, 1280, h, lam, lam_init, gsub, smem);
    } else {
      const int i2 = xcd_remap(it - 512, 512), b = i2 >> 5, h = (i2 >> 2) & 7, qt = i2 & 3;
      const u16* Kb = (const u16*)(P.ws + WS_CTXK) + (size_t)b * 256 * 1024 + h * 128;
      const u16* Vt = (const u16*)(P.ws + WS_VTCTX) + (size_t)(b * 8 + h) * 128 * 256;
      attn_item<true>(P, Q, 1024, b * 256 + qt * 64, Kb, 1024, Vt, 256, h, lam, lam_init, gsub, smem);
    }
  }
}

DEVI void attn_mla_phase(const Params& P, int j, u16* smem) {
  const u16* Q = (const u16*)(P.ws + WS_Q);
  for (int it = blockIdx.x; it < 512; it += gridDim.x) {
    if (it < 256) {
      const int iv = xcd_remap(it, 256);
      const int bl = iv >> 6, h = (iv >> 3) & 7, qt = iv & 7;
      const u16* Kb = (const u16*)(P.ws + WS_KMLAT) + (size_t)j * KMLAT_J + (size_t)(bl * 8 + h) * 1280 * 192;
      const u16* Vt = (const u16*)(P.ws + WS_VTLATM) + (size_t)(bl * 8 + h) * 128 * 1280;
      attn_item<false>(P, Q, 1536, 4096 + bl * 1024 + qt * 128, Kb, 192, Vt, 1280, h, 0.f, 0.f, nullptr, smem);
    } else {
      const int i2 = xcd_remap(it - 256, 256), b = i2 >> 4, h = (i2 >> 1) & 7, qt = i2 & 1;
      const u16* Kb = (const u16*)(P.ws + WS_CTXK) + (size_t)(b * 8 + h) * 256 * 192;
      const u16* Vt = (const u16*)(P.ws + WS_VTCTX) + (size_t)(b * 8 + h) * 128 * 256;
      attn_item<false>(P, Q, 1536, b * 256 + qt * 128, Kb, 192, Vt, 256, h, 0.f, 0.f, nullptr, smem);
    }
  }
}

DEVI float wave_sum(float v) {
  v += xshfl(v, 1); v += xshfl(v, 2); v += xshfl(v, 4); v += xshfl(v, 8); v += xshfl(v, 16); v += xshfl(v, 32);
  return v;
}

DEVI void ew_phase(const Params& P, int layer, u16* smem) {
  const int lane = tidx() & 63, w = tidx() >> 6;
  float* sC = (float*)smem;
  float* sB = sC + 1024;
  int cur_cond = -1;
  const float* ada = (const float*)(P.ws + WS_ADA);
  const u16* T = (const u16*)(P.ws + WS_T);
  u16* H = (u16*)(P.ws + WS_H);
  const int nl = layer + 1;
  for (int gw = blockIdx.x * 4 + w; gw < 2048; gw += gridDim.x * 4) {
    const int row0 = gw * 4;
    const int cond = row0 < 4096 ? 0 : 1 + ((row0 - 4096) >> 10);
    if (layer < 0 && cond != cur_cond) {
      __syncthreads();
      const float* part = (const float*)(P.ws + WS_ADAP);
      const int t4 = tidx() * 4;
#pragma unroll
      for (int third = 0; third < 2; ++third) {
        const int n = third * 1024 + t4, cgp = n >> 8, col = n & 255;
        float4 sum = *(const float4*)(P.in[I_BADA] + n);
        const float* pp = part + (size_t)(cgp * 8) * 1280 + cond * 256 + col;
#pragma unroll
        for (int q = 0; q < 8; ++q) {
          const float4 v = *(const float4*)(pp + (size_t)q * 1280);
          sum.x += v.x; sum.y += v.y; sum.z += v.z; sum.w += v.w;
        }
        if (third == 0) *(float4*)(sC + t4) = sum;
        else {
          const float4 gq = *(const float4*)(P.in[I_GPRE] + t4);
          *(float4*)(sB + t4) = make_float4(gq.x * (1.f + sum.x), gq.y * (1.f + sum.y), gq.z * (1.f + sum.z), gq.w * (1.f + sum.w));
        }
      }
      cur_cond = cond;
      __syncthreads();
    }
    const float* xsrc = (layer <= 0) ? (row0 < 4096 ? P.in[I_XP] + (size_t)row0 * 1024 : P.in[I_XS] + (size_t)(row0 - 4096) * 1024)
                                     : P.out + OUT_Y + (size_t)row0 * 1024;
    float4 x[4][4];
    u32x2 tb[4][4];
#pragma unroll
    for (int q = 0; q < 4; ++q)
#pragma unroll
      for (int i = 0; i < 4; ++i) x[q][i] = *(const float4*)(xsrc + (size_t)q * 1024 + lane * 4 + i * 256);
    if (layer >= 0) {
#pragma unroll
      for (int q = 0; q < 4; ++q)
#pragma unroll
        for (int i = 0; i < 4; ++i) tb[q][i] = *(const u32x2*)(T + (size_t)(row0 + q) * 1024 + lane * 4 + i * 256);
      float4 ga[4];
      const float* gate = ada + (size_t)(layer * 5 + cond) * 3072 + 2048;
#pragma unroll
      for (int i = 0; i < 4; ++i) ga[i] = *(const float4*)(gate + lane * 4 + i * 256);
#pragma unroll
      for (int q = 0; q < 4; ++q) {
        float4 t[4];
        float ss = 0.f;
#pragma unroll
        for (int i = 0; i < 4; ++i) {
          t[i] = make_float4(bf2f(tb[q][i][0] & 0xffffu), bf2f(tb[q][i][0] >> 16), bf2f(tb[q][i][1] & 0xffffu), bf2f(tb[q][i][1] >> 16));
          ss += t[i].x * t[i].x + t[i].y * t[i].y + t[i].z * t[i].z + t[i].w * t[i].w;
        }
        ss = wave_sum(ss);
        const float rt = rsqrtf(ss * (1.f / 1024.f) + EPS);
#pragma unroll
        for (int i = 0; i < 4; ++i) {
          x[q][i].x += ga[i].x * (t[i].x * rt);
          x[q][i].y += ga[i].y * (t[i].y * rt);
          x[q][i].z += ga[i].z * (t[i].z * rt);
          x[q][i].w += ga[i].w * (t[i].w * rt);
          *(float4*)(P.out + OUT_Y + (size_t)(row0 + q) * 1024 + lane * 4 + i * 256) = x[q][i];
        }
      }
    }
    if (nl < 4) {
      const float* sh = ada + (size_t)(nl * 5 + cond) * 3072;
      const float* sc = sh + 1024;
      float4 s1[4], s2[4];
#pragma unroll
      for (int i = 0; i < 4; ++i) {
        if (layer < 0) { s1[i] = *(const float4*)(sC + lane * 4 + i * 256); s2[i] = *(const float4*)(sB + lane * 4 + i * 256); }
        else { s1[i] = *(const float4*)(sh + lane * 4 + i * 256); s2[i] = *(const float4*)(sc + lane * 4 + i * 256); }
      }
#pragma unroll
      for (int q = 0; q < 4; ++q) {
        float ss = 0.f;
#pragma unroll
        for (int i = 0; i < 4; ++i)
          ss += x[q][i].x * x[q][i].x + x[q][i].y * x[q][i].y + x[q][i].z * x[q][i].z + x[q][i].w * x[q][i].w;
        ss = wave_sum(ss);
        const float rx = rsqrtf(ss * (1.f / 1024.f) + EPS);
#pragma unroll
        for (int i = 0; i < 4; ++i) {
          f32x4 hv;
          hv[0] = x[q][i].x * rx * s2[i].x + s1[i].x;
          hv[1] = x[q][i].y * rx * s2[i].y + s1[i].y;
          hv[2] = x[q][i].z * rx * s2[i].z + s1[i].z;
          hv[3] = x[q][i].w * rx * s2[i].w + s1[i].w;
          st_bf4(H + (size_t)(row0 + q) * 1024 + lane * 4 + i * 256, hv);
        }
      }
    }
  }
}

DEVI void tr_tile(const float* __restrict__ src, int lds, int k0, int n0, int nvalid, u16* __restrict__ dst, int ldd,
                  const float* kscale, float* tile) {
  const int tid = tidx();
  float4 v[4];
#pragma unroll
  for (int i = 0; i < 4; ++i) {
    const int idx = tid + 256 * i, kk = idx >> 4, c4 = (idx & 15) * 4;
    v[i] = (n0 + c4 < nvalid) ? *(const float4*)(src + (size_t)(k0 + kk) * lds + n0 + c4) : make_float4(0.f, 0.f, 0.f, 0.f);
    if (kscale) { const float ks = kscale[k0 + kk]; v[i].x *= ks; v[i].y *= ks; v[i].z *= ks; v[i].w *= ks; }
  }
  __syncthreads();
#pragma unroll
  for (int i = 0; i < 4; ++i) {
    const int idx = tid + 256 * i, kk = idx >> 4, c4 = (idx & 15) * 4;
    float* tp = tile + kk * 65 + c4;
    tp[0] = v[i].x; tp[1] = v[i].y; tp[2] = v[i].z; tp[3] = v[i].w;
  }
  __syncthreads();
#pragma unroll
  for (int i = 0; i < 2; ++i) {
    const int c = tid + 256 * i, nn = c >> 3, kc = (c & 7) * 8;
    const float* tp = tile + kc * 65 + nn;
    u32x4 u;
    u[0] = pk2(tp[0], tp[65]); u[1] = pk2(tp[2 * 65], tp[3 * 65]); u[2] = pk2(tp[4 * 65], tp[5 * 65]); u[3] = pk2(tp[6 * 65], tp[7 * 65]);
    *(u32x4*)(dst + (size_t)(n0 + nn) * ldd + k0 + kc) = u;
  }
}

constexpr int N_ADA = 384;
constexpr int N_TWOUT = 1024, N_TDAIN = 2048, N_TMLAIN = 896, N_TQB = 288, N_TKVB = 256, N_TCV = 512;
constexpr int N_ROPE = 128, N_LAM = 1, N_CDK = 1024, N_CCKV = 256, N_CKPE = 64;
constexpr int P0_ITEMS = N_ADA + N_TWOUT + N_TDAIN + N_TMLAIN + N_TQB + N_TKVB + N_TCV + N_ROPE + N_LAM + N_CDK + N_CCKV + N_CKPE;

constexpr int PI_A = N_ADA, PI_D = PI_A + N_TWOUT, PI_M = PI_D + N_TDAIN, PI_Q = PI_M + N_TMLAIN, PI_K = PI_Q + N_TQB, PI_C = PI_K + N_TKVB;
DEVI int prep_map(int set, int n) {
  int lo[4], hi[4];
  if (set == 0)      { lo[0] = 0;          hi[0] = PI_A;        lo[1] = PI_A;       hi[1] = PI_A + 256;  lo[2] = PI_D;        hi[2] = PI_D + 1024; lo[3] = PI_C;       hi[3] = P0_ITEMS; }
  else if (set == 1) { lo[0] = PI_M;       hi[0] = PI_M + 448;  lo[1] = PI_Q;       hi[1] = PI_Q + 144;  lo[2] = PI_K;        hi[2] = PI_K + 128;  lo[3] = PI_A + 256; hi[3] = PI_A + 512; }
  else if (set == 2) { lo[0] = PI_D + 1024; hi[0] = PI_D + 2048; lo[1] = PI_A + 512; hi[1] = PI_A + 768;  lo[2] = 0;           hi[2] = 0;           lo[3] = 0;          hi[3] = 0; }
  else               { lo[0] = PI_M + 448; hi[0] = PI_M + 896;  lo[1] = PI_Q + 144; hi[1] = PI_Q + 288;  lo[2] = PI_K + 128;  hi[2] = PI_K + 256;  lo[3] = PI_A + 768; hi[3] = PI_A + 1024; }
#pragma unroll
  for (int r = 0; r < 4; ++r) {
    const int c = hi[r] - lo[r];
    if (n < c) return lo[r] + n;
    n -= c;
  }
  return -1;
}

DEVI void prep_phase(const Params& P, u16* smem, int set, int bid, int nb) {
  float* fs = (float*)smem;
  const int tid = tidx();
  for (int n = bid; ; n += nb) {
    const int item = prep_map(set, n);
    if (item < 0) break;
    int it = item;
    if (it < N_ADA) {
      const int layer = it / 96, r96 = it % 96, cgp = r96 >> 3, ks = r96 & 7;
      float* sc = fs;
      float* red = fs + 640;
      __syncthreads();
      for (int idx = tid; idx < 640; idx += 256) {
        const int cnd = idx >> 7, k = ks * 128 + (idx & 127);
        const float v = cnd == 0 ? P.in[I_CCTX][k] : P.in[I_C][(cnd - 1) * 1024 + k];
        sc[idx] = silu(v);
      }
      __syncthreads();
      const int c4 = tid & 63, wv_ = tid >> 6;
      const float* wp = P.in[I_WADA] + (size_t)layer * 1024 * 3072 + (size_t)(ks * 128 + wv_ * 32) * 3072 + cgp * 256 + c4 * 4;
      float a[5][4];
#pragma unroll
      for (int c = 0; c < 5; ++c)
#pragma unroll
        for (int q = 0; q < 4; ++q) a[c][q] = 0.f;
#pragma unroll 8
      for (int i = 0; i < 32; ++i) {
        const float4 wv = *(const float4*)(wp + (size_t)i * 3072);
#pragma unroll
        for (int c = 0; c < 5; ++c) {
          const float sv = sc[c * 128 + wv_ * 32 + i];
          a[c][0] += sv * wv.x; a[c][1] += sv * wv.y; a[c][2] += sv * wv.z; a[c][3] += sv * wv.w;
        }
      }
#pragma unroll
      for (int c = 0; c < 5; ++c)
#pragma unroll
        for (int q = 0; q < 4; ++q) red[(wv_ * 5 + c) * 256 + c4 * 4 + q] = a[c][q];
      __syncthreads();
      float* part = (float*)(P.ws + WS_ADAP) + (size_t)((layer * 12 + cgp) * 8) * 1280;
#pragma unroll
      for (int c = 0; c < 5; ++c) {
        const float v = ((red[(0 * 5 + c) * 256 + tid] + red[(1 * 5 + c) * 256 + tid]) + red[(2 * 5 + c) * 256 + tid]) + red[(3 * 5 + c) * 256 + tid];
        part[(size_t)ks * 1280 + c * 256 + tid] = v;
      }
      continue;
    }
    it -= N_ADA;
    if (it < N_TWOUT) {
      const int l = it >> 8, kt = (it >> 4) & 15, nt = it & 15;
      tr_tile(P.in[I_WOUT] + (size_t)l * 1024 * 1024, 1024, kt * 64, nt * 64, 1024,
              (u16*)(P.ws + WS_WOUT) + (size_t)l * 1024 * 1024, 1024, nullptr, fs);
      continue;
    }
    it -= N_TWOUT;
    if (it < N_TDAIN) {
      const int l = it >> 10, kt = (it >> 6) & 15, nt = it & 63;
      tr_tile(P.in[I_DAWIN] + (size_t)l * 1024 * 4096, 4096, kt * 64, nt * 64, 4096,
              (u16*)(P.ws + WS_WDAIN) + (size_t)l * 4096 * 1024, 1024, nullptr, fs);
      continue;
    }
    it -= N_TDAIN;
    if (it < N_TMLAIN) {
      const int l = it / 448, r = it % 448, kt = r / 28, nt = r % 28;
      tr_tile(P.in[I_MWIN] + (size_t)l * 1024 * 1728, 1728, kt * 64, nt * 64, 1728,
              (u16*)(P.ws + WS_WMLAIN) + (size_t)l * 1792 * 1024, 1024, nullptr, fs);
      continue;
    }
    it -= N_TMLAIN;
    if (it < N_TQB) {
      const int l = it / 144, r = it % 144, kt = r / 24, nt = r % 24;
      tr_tile(P.in[I_WQB] + (size_t)l * 384 * 1536, 1536, kt * 64, nt * 64, 1536,
              (u16*)(P.ws + WS_WQB) + (size_t)l * 1536 * 384, 384, P.in[I_GQA] + l * 384, fs);
      continue;
    }
    it -= N_TQB;
    if (it < N_TKVB) {
      const int l = it >> 7, kt = (it >> 5) & 3, nt = it & 31;
      tr_tile(P.in[I_WKVB] + (size_t)l * 256 * 2048, 2048, kt * 64, nt * 64, 2048,
              (u16*)(P.ws + WS_WKVB) + (size_t)l * 2048 * 256, 256, nullptr, fs);
      tr_tile(P.in[I_WKVB] + (size_t)l * 256 * 2048, 2048, kt * 64, nt * 64, 2048,
              (u16*)(P.ws + WS_WKVBG) + (size_t)l * 2048 * 256, 256, P.in[I_GKVA] + l * 256, fs);
      continue;
    }
    it -= N_TKVB;
    if (it < N_TCV) {
      const int grp = it >> 3, sub = it & 7, bl = grp >> 4, jj = (grp >> 3) & 1, h = grp & 7, pt = sub >> 1, et = sub & 1;
      const float* src = P.in[I_CDV] + ((size_t)(bl * 2 + jj) * 256) * 1024 + h * 128;
      u16* dst = (u16*)(P.ws + WS_VTLATD) + (size_t)jj * VTLATD_J + (size_t)(bl * 8 + h) * 128 * 1280 + 1024;
      tr_tile(src, 1024, pt * 64, et * 64, 128, dst, 1280, nullptr, fs);
      continue;
    }
    it -= N_TCV;
    if (it < N_ROPE) {
      const int idx = it * 256 + tid, t = idx >> 5, p = idx & 31, f = p & 15;
      const float inv = exp2f(-(float)f * (13.287712379549449f / 16.f));
      const float pos = (p < 16) ? (float)(t >> 6) : (float)(t & 63);
      float sn, cs;
      sincosf(pos * inv, &sn, &cs);
      float* rc = (float*)(P.ws + WS_ROPE);
      rc[idx] = cs;
      rc[1024 * 32 + idx] = sn;
      continue;
    }
    it -= N_ROPE;
    if (it < N_LAM) {
      if (tid < 2) {
        const int jd = tid;
        float s1 = 0.f, s2 = 0.f;
        for (int d = 0; d < 64; ++d) {
          s1 += P.in[I_LQ1][jd * 64 + d] * P.in[I_LK1][jd * 64 + d];
          s2 += P.in[I_LQ2][jd * 64 + d] * P.in[I_LK2][jd * 64 + d];
        }
        const float li = 0.8f - 0.6f * expf(-0.3f * (float)(2 * jd));
        float* lamv = (float*)(P.ws + WS_MISC);
        lamv[jd * 2] = expf(s1) - expf(s2) + li;
        lamv[jd * 2 + 1] = li;
      }
      continue;
    }
    it -= N_LAM;
    if (it < N_CDK) {
      const size_t e0 = ((size_t)it * 256 + tid) * 8;
      const int col = e0 & 1023, p = (e0 >> 10) & 255, jj = (e0 >> 18) & 1, bl = (int)(e0 >> 19);
      const float4 a = *(const float4*)(P.in[I_CDK] + e0);
      const float4 b = *(const float4*)(P.in[I_CDK] + e0 + 4);
      uint4 u; u.x = pk2(a.x, a.y); u.y = pk2(a.z, a.w); u.z = pk2(b.x, b.y); u.w = pk2(b.z, b.w);
      *(uint4*)((u16*)(P.ws + WS_KDLAT) + (size_t)jj * KDLAT_J + ((size_t)(bl * 1280 + 1024 + p)) * 1024 + col) = u;
      continue;
    }
    it -= N_CDK;
    if (it < N_CCKV) {
      const size_t e0 = ((size_t)it * 256 + tid) * 8;
      const int col = e0 & 255, p = (e0 >> 8) & 255, jj = (e0 >> 16) & 1, bl = (int)(e0 >> 17);
      const float4 a = *(const float4*)(P.in[I_CCKV] + e0);
      const float4 b = *(const float4*)(P.in[I_CCKV] + e0 + 4);
      uint4 u; u.x = pk2(a.x, a.y); u.y = pk2(a.z, a.w); u.z = pk2(b.x, b.y); u.w = pk2(b.z, b.w);
      *(uint4*)((u16*)(P.ws + WS_CKVA) + (size_t)jj * CKVA_J + ((size_t)(4096 + bl * 1280 + 1024 + p)) * 256 + col) = u;
      continue;
    }
    it -= N_CCKV;
    {
      const size_t e0 = ((size_t)it * 256 + tid) * 8;
      const int d = e0 & 63, p = (e0 >> 6) & 255, jj = (e0 >> 14) & 1, bl = (int)(e0 >> 15);
      const float4 a = *(const float4*)(P.in[I_CKPE] + e0);
      const float4 b = *(const float4*)(P.in[I_CKPE] + e0 + 4);
      uint4 u; u.x = pk2(a.x, a.y); u.y = pk2(a.z, a.w); u.z = pk2(b.x, b.y); u.w = pk2(b.z, b.w);
      u16* dst = (u16*)(P.ws + WS_KMLAT) + (size_t)jj * KMLAT_J + ((size_t)(bl * 8) * 1280 + 1024 + p) * 192 + 128 + d;
#pragma unroll
      for (int h = 0; h < 8; ++h) *(uint4*)(dst + (size_t)h * 1280 * 192) = u;
    }
  }
}

DEVI void mla_b_phase(const Params& P, int j, u16* smem) {
  constexpr int NQ = 32 * 12, NKV = 36 * 16, NNORM = 64;
  for (int it = blockIdx.x; it < NKV + NQ + NNORM; it += gridDim.x) {
    if (it < NKV) tile_kvb(P, j, it, smem);
    else if (it < NKV + NQ) tile_qb(P, j, it - NKV, smem);
    else {
      const int lane = tidx() & 63, w = tidx() >> 6;
      const float* ssq = (const float*)(P.ws + WS_SSQKV);
      const float4 gk = *(const float4*)(P.in[I_GKVA] + j * 256 + lane * 4);
      for (int r = w; r < 64; r += 4) {
        const int row = (it - NKV - NQ) * 64 + r;
        const float4 s4 = *(const float4*)(ssq + (size_t)row * 4);
        const float rr = rsqrtf((s4.x + s4.y + s4.z + s4.w) * (1.f / 256.f) + EPS);
        float* p = P.out + OUT_CKV + ((size_t)(((row >> 8) * 2 + j) * 256 + (row & 255))) * 256 + lane * 4;
        float4 v = *(const float4*)((const float*)(P.ws + WS_KVRAW) + (size_t)row * 256 + lane * 4);
        v.x *= rr * gk.x; v.y *= rr * gk.y; v.z *= rr * gk.z; v.w *= rr * gk.w;
        *(float4*)p = v;
      }
    }
  }
}


#define XB_TMO      128
#define XB_XCNT(j)  (256  + 64 * (j))
#define XB_XSUB(j)  (1280 + 64 * (j))
#define XB_XGEN(j)  (2304 + 64 * (j))
#define XB_TOP      3328
#define XB_TOPGEN   3392
#define XCD_BAR_WORDS 3456
#define XB_SPIN_CAP (1u << 22)
#define LAS __attribute__((address_space(3)))
DEVI unsigned xb_ld(unsigned* p) { return __hip_atomic_load(p, __ATOMIC_RELAXED, __HIP_MEMORY_SCOPE_AGENT); }
DEVI unsigned xb_add(unsigned* p, unsigned v) { return __hip_atomic_fetch_add(p, v, __ATOMIC_RELAXED, __HIP_MEMORY_SCOPE_AGENT); }
DEVI unsigned xb_xcc_id() { return (unsigned)__builtin_amdgcn_s_getreg((3 << 11) | 20) & 0xFu; }
#define XB_SPIN(cond, bar) do { unsigned _sp = 0; while (cond) { __builtin_amdgcn_s_sleep(1); \
    if ((++_sp & 255u) == 0u) { if (xb_ld(&(bar)[XB_TMO])) break; if (_sp > XB_SPIN_CAP) { atomicAdd(&(bar)[XB_TMO], 1u); break; } } } } while (0)
struct XcdBarrier { unsigned* bar; unsigned x; volatile LAS unsigned* st; };
DEVI XcdBarrier xcd_barrier_post(unsigned* bar, volatile LAS unsigned* st) {
  XcdBarrier b; b.bar = bar; b.x = xb_xcc_id(); b.st = st;
  if (threadIdx.x == 0) (void)xb_add(&bar[XB_XCNT(b.x)], 1u);
  return b;
}
DEVI void xcd_barrier_complete(unsigned* bar, unsigned x, unsigned& nloc, unsigned& nx) {
  const unsigned G = gridDim.x * gridDim.y * gridDim.z;
  unsigned sum, cnt, mine, sp = 0u;
  for (;;) {
    sum = 0u; cnt = 0u; mine = 0u;
#pragma unroll
    for (unsigned j = 0; j < 16; ++j) { const unsigned c = xb_ld(&bar[XB_XCNT(j)]); sum += c; cnt += (c > 0u) ? 1u : 0u; mine = (j == x) ? c : mine; }
    if (sum == G) break;
    __builtin_amdgcn_s_sleep(1);
    if ((++sp & 255u) == 0u) { if (xb_ld(&bar[XB_TMO])) break; if (sp > XB_SPIN_CAP) { atomicAdd(&bar[XB_TMO], 1u); break; } }
  }
  nloc = mine > 0u ? mine : 1u; nx = cnt > 0u ? cnt : 1u;
}
DEVI void xcd_barrier(const XcdBarrier& b) {
  asm volatile("s_waitcnt vmcnt(0)" ::: "memory");
  __syncthreads();
  if (threadIdx.x == 0) {
    unsigned* bar = b.bar;
    __builtin_amdgcn_s_waitcnt(0);
    unsigned nloc = b.st[0], nx = b.st[1];
    if (nloc == 0u) { xcd_barrier_complete(bar, b.x, nloc, nx); b.st[0] = nloc; b.st[1] = nx; }
    const unsigned old = xb_add(&bar[XB_XSUB(b.x)], 1u);
    const unsigned gen = old / nloc;
    if (old + 1u == (gen + 1u) * nloc) {
      __builtin_amdgcn_fence(__ATOMIC_RELEASE, "agent");
      asm volatile("s_waitcnt vmcnt(0)" ::: "memory");
      const unsigned og = xb_add(&bar[XB_TOP], 1u);
      const unsigned tg = og / nx;
      if (og + 1u == (tg + 1u) * nx) xb_add(&bar[XB_TOPGEN], 1u);
      else XB_SPIN(xb_ld(&bar[XB_TOPGEN]) == tg, bar);
      __builtin_amdgcn_fence(__ATOMIC_ACQUIRE, "agent");
      xb_add(&bar[XB_XGEN(b.x)], 1u);
      asm volatile("s_waitcnt vmcnt(0)" ::: "memory");
    } else {
      XB_SPIN(xb_ld(&bar[XB_XGEN(b.x)]) == gen, bar);
      __builtin_amdgcn_fence(__ATOMIC_ACQUIRE, "agent");
      asm volatile("s_waitcnt vmcnt(0)" ::: "memory");
    }
  }
  __syncthreads();
}

DEVI void ada_reduce_phase(const Params& P) {
  const float* part = (const float*)(P.ws + WS_ADAP);
  float* ada = (float*)(P.ws + WS_ADA);
  for (int i = blockIdx.x * 256 + tidx(); i < 4 * 5 * 768; i += gridDim.x * 256) {
    const int n4 = i % 768, lc = i / 768, c = lc % 5, layer = lc / 5, n = n4 * 4, cgp = n >> 8, col = n & 255;
    float4 sum = *(const float4*)(P.in[I_BADA] + layer * 3072 + n);
    const float* pp = part + (size_t)((layer * 12 + cgp) * 8) * 1280 + c * 256 + col;
#pragma unroll
    for (int q = 0; q < 8; ++q) {
      const float4 v = *(const float4*)(pp + (size_t)q * 1280);
      sum.x += v.x; sum.y += v.y; sum.z += v.z; sum.w += v.w;
    }
    if (n >= 2048) {
      const float4 gp = *(const float4*)(P.in[I_GPOST] + layer * 1024 + (n - 2048));
      sum.x *= gp.x; sum.y *= gp.y; sum.z *= gp.z; sum.w *= gp.w;
    } else if (n >= 1024) {
      const float4 gq = *(const float4*)(P.in[I_GPRE] + layer * 1024 + (n - 1024));
      sum.x = gq.x * (1.f + sum.x); sum.y = gq.y * (1.f + sum.y); sum.z = gq.z * (1.f + sum.z); sum.w = gq.w * (1.f + sum.w);
    }
    *(float4*)(ada + (size_t)(layer * 5 + c) * 3072 + n) = sum;
  }
}

#ifndef EN
#define EN 0xFF
#endif
DEVI void run_phase(const Params& P, int ph, u16* smem) {
  if (ph == 0) { if (EN & 1) prep_phase(P, smem, 0, blockIdx.x, gridDim.x); return; }
  if (ph == 1) { if (EN & 2) ew_phase(P, -1, smem); ada_reduce_phase(P); return; }
  int layer, sub;
  if (ph < 6) { layer = 0; sub = ph - 2; }
  else if (ph < 11) { layer = 1; sub = ph - 6; }
  else if (ph < 15) { layer = 2; sub = ph - 11; }
  else { layer = 3; sub = ph - 15; }
  const int j = layer >> 1;
  if ((layer & 1) == 0) {
    if (sub == 0) { if (EN & 4) for (int t = blockIdx.x; t < 32 * 32; t += gridDim.x) tile_diff_in(P, j, t, smem); }
    else if (sub == 1) { if (EN & 8) attn_diff_phase(P, j, smem); }
    else if (sub == 2) {
      if (EN & 16) for (int t = blockIdx.x; t < 32 * 8; t += gridDim.x) tile_out(P, layer, t, smem);
      const int pset = layer == 0 ? 1 : 3;
      if (gridDim.x >= 512) { if (blockIdx.x >= 256) prep_phase(P, smem, pset, blockIdx.x - 256, gridDim.x - 256); }
      else prep_phase(P, smem, pset, blockIdx.x, gridDim.x);
    }
    else { if (EN & 2) ew_phase(P, layer, smem); }
  } else {
    if (sub == 0) { if (EN & 32) for (int t = blockIdx.x; t < 32 * 14; t += gridDim.x) tile_mla_in(P, j, t, smem); }
    else if (sub == 1) { if (EN & 64) mla_b_phase(P, j, smem); }
    else if (sub == 2) { if (EN & 128) attn_mla_phase(P, j, smem); }
    else if (sub == 3) {
      if (EN & 16) for (int t = blockIdx.x; t < 32 * 8; t += gridDim.x) tile_out(P, layer, t, smem);
      if (layer == 1) {
        if (gridDim.x >= 512) { if (blockIdx.x >= 256) prep_phase(P, smem, 2, blockIdx.x - 256, gridDim.x - 256); }
        else prep_phase(P, smem, 2, blockIdx.x, gridDim.x);
      }
    }
    else { if (EN & 2) ew_phase(P, layer, smem); }
  }
}

constexpr int N_PHASES = 20;

__global__ void __launch_bounds__(256, 2) fwd_megakernel(Params P) {
  __shared__ __attribute__((aligned(16))) u16 smem[SMEM_BYTES / 2];
  __shared__ uint4 xb_words;
  if (threadIdx.x == 0) xb_words = make_uint4(0u, 0u, 0u, 0u);
  __syncthreads();
  XcdBarrier xb = xcd_barrier_post((unsigned*)(P.ws + WS_BAR), (volatile LAS unsigned*)&xb_words);
  for (int ph = P.ph_lo; ph < P.ph_hi; ++ph) {
    Params Pl = P;
    {
      size_t zoff = 0;
      asm volatile("" : "+s"(zoff));
      Pl.ws = P.ws + zoff;
      Pl.out = P.out + zoff;
    }
    run_phase(Pl, ph, smem);
#ifdef REP_MASK
    {
      int kind;
      if (ph == 0) kind = 1; else if (ph == 1) kind = 2;
      else { int layer, sub; if (ph < 6) { layer = 0; sub = ph - 2; } else if (ph < 11) { layer = 1; sub = ph - 6; } else if (ph < 15) { layer = 2; sub = ph - 11; } else { layer = 3; sub = ph - 15; }
        if ((layer & 1) == 0) kind = sub == 0 ? 4 : sub == 1 ? 8 : sub == 2 ? 16 : 2;
        else kind = sub == 0 ? 32 : sub == 1 ? 64 : sub == 2 ? 128 : sub == 3 ? 16 : 2; }
      if (kind & REP_MASK) { xcd_barrier(xb); run_phase(Pl, ph, smem); }
    }
#endif
    if (ph + 1 < P.ph_hi) {
      if (P.ph_hi > 1000) cg::this_grid().sync();
      xcd_barrier(xb);
    }
#ifdef EXTRA_SYNCS
    for (int q = 0; q < EXTRA_SYNCS; ++q) xcd_barrier(xb);
#endif
  }
}

extern "C" void kernel_launch(void* const* d_in, const int* in_sizes, int n_in, void* d_out, int out_size, void* d_ws,
                              size_t ws_size, hipStream_t stream) {
  static int grid_blocks = 0;
  if (!grid_blocks) {
    int dev = 0, cus = 0, per_cu = 0;
    (void)hipGetDevice(&dev);
    (void)hipDeviceGetAttribute(&cus, hipDeviceAttributeMultiprocessorCount, dev);
    (void)hipOccupancyMaxActiveBlocksPerMultiprocessor(&per_cu, fwd_megakernel, 256, 0);
    if (per_cu < 1) per_cu = 1;
    if (per_cu > 2) per_cu = 2;
    grid_blocks = cus * per_cu;
  }
  if (hipMemsetAsync((unsigned char*)d_ws + WS_BAR, 0, 16384, stream) != hipSuccess) { fprintf(stderr, "memset failed\n"); return; }
  Params p{};
  for (int i = 0; i < 24; ++i) p.in[i] = (const float*)d_in[i];
  p.out = (float*)d_out;
  p.ws = (unsigned char*)d_ws;
#if MULTI_LAUNCH
  for (int ph = 0; ph < N_PHASES; ++ph) {
    p.ph_lo = ph; p.ph_hi = ph + 1;
    hipLaunchKernelGGL(fwd_megakernel, dim3(grid_blocks), dim3(256), 0, stream, p);
  }
#else
  p.ph_lo = 0; p.ph_hi = N_PHASES;
  void* args[] = {&p};
  hipError_t e = hipLaunchCooperativeKernel((void*)fwd_megakernel, dim3(grid_blocks), dim3(256), args, 0, stream);
  if (e != hipSuccess) fprintf(stderr, "cooperative launch failed: %s (grid %d)\n", hipGetErrorString(e), grid_blocks);
#endif
}
```
